# Optimizing an MI355X kernel written in HIP

```python
import math
import jax, jax.numpy as jnp
from jax import lax
import numpy as np

D_MODEL = 1024
BATCH = 8
SEQ = 4096
DEPTH = 1

HEAD_DIM = 64
A_HEADS = 8
A_WIDTH = A_HEADS * HEAD_DIM
CHUNK = 128
B_HEADS = 8
B_KV_GROUPS = 2
B_HPG = B_HEADS // B_KV_GROUPS
B_WIDTH = B_HEADS * HEAD_DIM
KV_WIDTH = B_KV_GROUPS * HEAD_DIM
CMP_LEN = 32
CMP_STRIDE = 16
CMP_HIDDEN = 256
SEL_BLOCK = 64
SEL_TOPK = 16
WINDOW = 512
Q_BLOCK = 128
N_BUCKETS = 32
MAX_DISTANCE = 128
D_FF = 2816
MIX_WIDTH = A_WIDTH + B_WIDTH
SPLIT_WIDTHS = (2 * A_WIDTH, B_WIDTH, KV_WIDTH, KV_WIDTH, KV_WIDTH, KV_WIDTH, KV_WIDTH, KV_WIDTH, 3 * B_HEADS)
IN_COLS = sum(SPLIT_WIDTHS)
SPLIT_OFFSETS = tuple(int(v) for v in np.cumsum(SPLIT_WIDTHS)[:-1])
EPS = 1e-6
NEG = -1e30
FORCE = 1e6
SCALE = HEAD_DIM ** -0.5

kernel_name = "hymba_gmlp_nsa_macaron_layer"


def rms_norm(x, g):
    xf = x.astype(jnp.float32)
    y = xf * lax.rsqrt(jnp.mean(xf * xf, axis=-1, keepdims=True) + EPS)
    return (y * g.astype(jnp.float32)).astype(x.dtype)


def swiglu(x, w_gate, w_up, w_down):
    return (jax.nn.silu(x @ w_gate) * (x @ w_up)) @ w_down


def t5_bucket(dist):
    n = jnp.maximum(dist, 0)
    max_exact = N_BUCKETS // 2
    nf = jnp.maximum(n, 1).astype(jnp.float32)
    large = max_exact + (jnp.log(nf / max_exact) / math.log(MAX_DISTANCE / max_exact)
                         * (N_BUCKETS - max_exact)).astype(jnp.int32)
    large = jnp.minimum(large, N_BUCKETS - 1)
    return jnp.where(n < max_exact, n, large)


def gmlp_mixer(z, v_norm_g, w_s, b_s):
    u, v = jnp.split(z, 2, axis=-1)
    v = rms_norm(v, v_norm_g)
    bsz, t, _ = v.shape
    vc = v.reshape(bsz, t // CHUNK, CHUNK, A_HEADS, HEAD_DIM)
    mask = jnp.tril(jnp.ones((CHUNK, CHUNK), dtype=bool))
    w = jnp.where(mask, w_s, 0.0)
    sv = jnp.einsum('hts,bcshd->bcthd', w, vc) + b_s.T[None, None, :, :, None]
    return u * sv.reshape(bsz, t, A_WIDTH)


def compress(kv, pe, w1, b1, w2, b2):
    bsz, g, t, dh = kv.shape
    r = CMP_LEN // CMP_STRIDE
    seg = kv.reshape(bsz, g, t // CMP_STRIDE, CMP_STRIDE, dh)
    n_cmp = t // CMP_STRIDE - r + 1
    blocks = jnp.concatenate([seg[:, :, i:i + n_cmp] for i in range(r)], axis=3)
    blocks = (blocks + pe).reshape(bsz, g, n_cmp, CMP_LEN * dh)
    return jax.nn.gelu(blocks @ w1 + b1) @ w2 + b2


def nsa_mixer(q, k_c, v_c, k_s, v_s, k_w, v_w, gate_logits, q_norm_g, k_norm_g,
              cmp_pe, cmp_w1, cmp_b1, cmp_w2, cmp_b2, rel_bias):
    bsz, t, _ = q.shape
    G, Hg, dh = B_KV_GROUPS, B_HPG, HEAD_DIM
    q = rms_norm(q.reshape(bsz, t, G, Hg, dh), q_norm_g).transpose(0, 2, 3, 1, 4)

    def kv_heads(a):
        return a.reshape(bsz, t, G, dh).transpose(0, 2, 1, 3)

    kc = rms_norm(compress(kv_heads(k_c), cmp_pe[0], cmp_w1[0], cmp_b1[0], cmp_w2[0], cmp_b2[0]), k_norm_g[0])
    vc = compress(kv_heads(v_c), cmp_pe[1], cmp_w1[1], cmp_b1[1], cmp_w2[1], cmp_b2[1])
    nsb = t // SEL_BLOCK
    ks_blocks = rms_norm(kv_heads(k_s), k_norm_g[1]).reshape(bsz, G, nsb, SEL_BLOCK, dh)
    vs_blocks = kv_heads(v_s).reshape(bsz, G, nsb, SEL_BLOCK, dh)
    pad = ((0, 0), (0, 0), (WINDOW, 0), (0, 0))
    kw_pad = jnp.pad(rms_norm(kv_heads(k_w), k_norm_g[2]), pad)
    vw_pad = jnp.pad(kv_heads(v_w), pad)
    gates = jax.nn.sigmoid(gate_logits.reshape(bsz, t, 3, G, Hg)).transpose(0, 3, 4, 1, 2)
    rb = rel_bias.reshape(G, Hg, N_BUCKETS)

    n_cmp = kc.shape[2]
    cmp_end = jnp.arange(n_cmp) * CMP_STRIDE + CMP_LEN - 1
    sel_start = jnp.arange(nsb) * SEL_BLOCK
    overlap = (((cmp_end[:, None] - (CMP_LEN - 1)) <= (sel_start[None, :] + SEL_BLOCK - 1))
               & (cmp_end[:, None] >= sel_start[None, :])).astype(jnp.float32)
    n_top = min(SEL_TOPK, nsb)
    bi = jnp.arange(bsz)[:, None, None, None]
    gi = jnp.arange(G)[None, :, None, None]
    g6 = jnp.arange(G)[None, :, None, None, None, None]
    h6 = jnp.arange(Hg)[None, None, :, None, None, None]
    blk = jnp.arange(nsb)

    def attend_block(c):
        t0 = c * Q_BLOCK
        tpos = t0 + jnp.arange(Q_BLOCK)
        qb = lax.dynamic_slice_in_dim(q, t0, Q_BLOCK, axis=3)
        dist_c = tpos[:, None] - cmp_end[None, :]
        valid_c = dist_c >= 0
        s_c = (jnp.einsum('bghqd,bgnd->bghqn', qb, kc, preferred_element_type=jnp.float32) * SCALE
               + rb[:, :, t5_bucket(dist_c)])
        p_c = jax.nn.softmax(jnp.where(valid_c, s_c, NEG), axis=-1) * valid_c
        o_c = jnp.einsum('bghqn,bgnd->bghqd', p_c, vc)
        imp = jnp.einsum('bghqn,nj->bgqj', p_c, overlap)
        cur = (tpos // SEL_BLOCK)[:, None]
        forced = (blk == 0) | (blk == cur) | (blk == cur - 1)
        eligible = sel_start[None, :] <= tpos[:, None]
        imp = jnp.where(eligible, jnp.where(forced, FORCE, imp), -1.0)
        _, idx = lax.top_k(imp, n_top)
        kb = ks_blocks[bi, gi, idx]
        vb = vs_blocks[bi, gi, idx]
        dist_s = tpos[:, None, None] - (idx[..., None] * SEL_BLOCK + jnp.arange(SEL_BLOCK))
        valid_s = (dist_s >= 0)[:, :, None]
        s_s = (jnp.einsum('bghqd,bgqksd->bghqks', qb, kb, preferred_element_type=jnp.float32) * SCALE
               + rb[g6, h6, t5_bucket(dist_s)[:, :, None]])
        s_s = jnp.where(valid_s, s_s, NEG)
        p_s = jax.nn.softmax(s_s.reshape(bsz, G, Hg, Q_BLOCK, -1), axis=-1).reshape(s_s.shape)
        o_s = jnp.einsum('bghqks,bgqksd->bghqd', p_s, vb)
        kwb = lax.dynamic_slice_in_dim(kw_pad, t0, WINDOW + Q_BLOCK, axis=2)
        vwb = lax.dynamic_slice_in_dim(vw_pad, t0, WINDOW + Q_BLOCK, axis=2)
        kpos = t0 - WINDOW + jnp.arange(WINDOW + Q_BLOCK)
        dist_w = tpos[:, None] - kpos[None, :]
        valid_w = (dist_w >= 0) & (dist_w < WINDOW) & (kpos[None, :] >= 0)
        s_w = (jnp.einsum('bghqd,bgkd->bghqk', qb, kwb, preferred_element_type=jnp.float32) * SCALE
               + rb[:, :, t5_bucket(dist_w)])
        p_w = jax.nn.softmax(jnp.where(valid_w, s_w, NEG), axis=-1)
        o_w = jnp.einsum('bghqk,bgkd->bghqd', p_w, vwb)
        gb = lax.dynamic_slice_in_dim(gates, t0, Q_BLOCK, axis=3)
        o = gb[..., 0:1] * o_c + gb[..., 1:2] * o_s + gb[..., 2:3] * o_w
        return o.astype(q.dtype)

    out = lax.map(attend_block, jnp.arange(t // Q_BLOCK))
    return out.transpose(1, 0, 4, 2, 3, 5).reshape(bsz, t, B_WIDTH)


def setup_inputs(seed: int = 0) -> dict:
    key = jax.random.key(seed)
    ks = jax.random.split(key, 32)
    nrm = lambda k, shape, s: jax.random.normal(k, shape, jnp.float32) * s
    gain = lambda k, shape: 1.0 + 0.05 * jax.random.normal(k, shape, jnp.float32)
    L = DEPTH
    return {
        "x": nrm(ks[0], (BATCH, SEQ, D_MODEL), 1.0),
        "ffn1_norm_g": gain(ks[1], (L, D_MODEL)),
        "ffn1_w_gate": nrm(ks[2], (L, D_MODEL, D_FF), D_MODEL ** -0.5),
        "ffn1_w_up": nrm(ks[3], (L, D_MODEL, D_FF), D_MODEL ** -0.5),
        "ffn1_w_down": nrm(ks[4], (L, D_FF, D_MODEL), D_FF ** -0.5),
        "mix_norm_g": gain(ks[5], (L, D_MODEL)),
        "w_in": nrm(ks[6], (L, D_MODEL, IN_COLS), D_MODEL ** -0.5),
        "gmlp_v_norm_g": gain(ks[7], (L, A_WIDTH)),
        "gmlp_w_s": nrm(ks[8], (L, A_HEADS, CHUNK, CHUNK), 0.5 * CHUNK ** -0.5),
        "gmlp_b_s": gain(ks[9], (L, A_HEADS, CHUNK)),
        "q_norm_g": gain(ks[10], (L, HEAD_DIM)),
        "k_norm_g": gain(ks[11], (L, 3, HEAD_DIM)),
        "cmp_pe": nrm(ks[12], (L, 2, CMP_LEN, HEAD_DIM), 0.1),
        "cmp_w1": nrm(ks[13], (L, 2, CMP_LEN * HEAD_DIM, CMP_HIDDEN), (CMP_LEN * HEAD_DIM) ** -0.5),
        "cmp_b1": nrm(ks[14], (L, 2, CMP_HIDDEN), 0.02),
        "cmp_w2": nrm(ks[15], (L, 2, CMP_HIDDEN, HEAD_DIM), CMP_HIDDEN ** -0.5),
        "cmp_b2": nrm(ks[16], (L, 2, HEAD_DIM), 0.02),
        "rel_bias": nrm(ks[17], (B_HEADS, N_BUCKETS), 0.5),
        "w_out": nrm(ks[18], (L, MIX_WIDTH, D_MODEL), MIX_WIDTH ** -0.5),
        "ffn2_norm_g": gain(ks[19], (L, D_MODEL)),
        "ffn2_w_gate": nrm(ks[20], (L, D_MODEL, D_FF), D_MODEL ** -0.5),
        "ffn2_w_up": nrm(ks[21], (L, D_MODEL, D_FF), D_MODEL ** -0.5),
        "ffn2_w_down": nrm(ks[22], (L, D_FF, D_MODEL), D_FF ** -0.5),
        "final_norm_g": gain(ks[23], (L, D_MODEL)),
    }


def reference(x, ffn1_norm_g, ffn1_w_gate, ffn1_w_up, ffn1_w_down, mix_norm_g, w_in,
              gmlp_v_norm_g, gmlp_w_s, gmlp_b_s, q_norm_g, k_norm_g, cmp_pe, cmp_w1, cmp_b1,
              cmp_w2, cmp_b2, rel_bias, w_out, ffn2_norm_g, ffn2_w_gate, ffn2_w_up, ffn2_w_down,
              final_norm_g):
    for l in range(DEPTH):
        h = rms_norm(x, ffn1_norm_g[l])
        x = x + 0.5 * swiglu(h, ffn1_w_gate[l], ffn1_w_up[l], ffn1_w_down[l])
        h = rms_norm(x, mix_norm_g[l])
        proj = h @ w_in[l]
        z_a, q, k_c, v_c, k_s, v_s, k_w, v_w, g = jnp.split(proj, SPLIT_OFFSETS, axis=-1)
        y_a = gmlp_mixer(jax.nn.gelu(z_a), gmlp_v_norm_g[l], gmlp_w_s[l], gmlp_b_s[l])
        y_b = nsa_mixer(q, k_c, v_c, k_s, v_s, k_w, v_w, g, q_norm_g[l], k_norm_g[l],
                        cmp_pe[l], cmp_w1[l], cmp_b1[l], cmp_w2[l], cmp_b2[l], rel_bias)
        x = x + jnp.concatenate([y_a, y_b], axis=-1) @ w_out[l]
        h = rms_norm(x, ffn2_norm_g[l])
        x = x + 0.5 * swiglu(h, ffn2_w_gate[l], ffn2_w_up[l], ffn2_w_down[l])
        x = rms_norm(x, final_norm_g[l])
    return x
```

```cpp
#include <hip/hip_runtime.h>
#include <cstdio>
#include <cstdint>

#ifndef MK_N_LAUNCHES
#define MK_N_LAUNCHES 1
#endif

namespace pg8 {
#define PG8_LAS __attribute__((address_space(3)))
typedef unsigned short bf16_t;
typedef short bf16x8 __attribute__((ext_vector_type(8)));
typedef float f32x4 __attribute__((ext_vector_type(4)));
typedef unsigned u32x4 __attribute__((ext_vector_type(4)));
typedef unsigned u32x2 __attribute__((ext_vector_type(2)));
constexpr int BM = 256, BK = 64, HALF = 128, HTB = HALF * BK * 2, STAGE_BYTES = 8 * HTB, NXCD = 8, WGM = 8;

__host__ __device__ __forceinline__ int lds_byte(int r, int c) { const int st = (r >> 4) * 2 + (c >> 5), rr = r & 15, cc = c & 31, ob = rr * 64 + cc * 2; return st * 1024 + (ob ^ (((ob >> 9) & 1) << 5)); }
__host__ __device__ __forceinline__ void stage_rc(int b, int& R, int& C) { const int st = b / 1024, sb = b % 1024, swz = sb ^ (((sb >> 9) & 1) << 5); R = (st >> 1) * 16 + swz / 64; C = (st & 1) * 32 + (swz % 64) / 2; }
__host__ __device__ __forceinline__ int perm32(int rho) { const int n = rho >> 4, i = rho & 15; return 8 * (i >> 2) + 4 * n + (i & 3); }

struct Unit { int pm, pn; };
struct Gemm { const bf16_t* A; const bf16_t* Bt; int M, N, K, lda, ldb; };

struct StaticOrder {
    int nM, nN, nwg, G, c;
    __host__ __device__ void init(int M, int N, int G_, int c_) { nM = M / BM; nN = N / BM; nwg = nM * nN; G = G_; c = c_; }
    __host__ __device__ bool next(int i, Unit& u) const {
        const long L = (long)i * G + c; if (L >= nwg) return false;
        int wgid = (int)L; { const int q = nwg / NXCD, r = nwg % NXCD, xcd = wgid % NXCD, off = wgid / NXCD; wgid = (xcd < r ? xcd * (q + 1) : r * (q + 1) + (xcd - r) * q) + off; }
        const int nig = WGM * nN, gid = wgid / nig, fm = gid * WGM, gsz = (nM - fm) < WGM ? (nM - fm) : WGM;
        u.pm = fm + ((wgid % nig) % gsz); u.pn = (wgid % nig) / gsz; return true;
    }
};
struct CmpOrder {
    int c;
    __device__ bool next(int i, Unit& u) const { if (i != 0 || c >= 32) return false; u.pm = c; u.pn = c >> 4; return true; }
};

__device__ __forceinline__ unsigned cvt_pk_bf16(float lo, float hi) { unsigned r; asm volatile("v_cvt_pk_bf16_f32 %0, %1, %2" : "=v"(r) : "v"(lo), "v"(hi)); return r; }

template <class Epi, class Sched, bool ALIGN_EPI = false, bool SP2 = false>
__device__ __forceinline__ void gemm_phase(PG8_LAS unsigned char* lds, const Gemm g, const Sched& S, const Epi& E) {
    const int tid = threadIdx.x, wid = __builtin_amdgcn_readfirstlane(tid >> 6), lane = tid & 63, wr = wid >> 2, wc = wid & 3, fr = lane & 15, fq = lane >> 4;
    const int K = g.K, nt = K / BK;
    unsigned voffA[2], voffB[2];
#pragma unroll
    for (int i = 0; i < 2; ++i) { int R, C; stage_rc(tid * 16 + i * 8192, R, C); const int Rb = Epi::PERM ? ((R & ~31) + perm32(R & 31)) : R;
        voffA[i] = (unsigned)(R * g.lda + C) * 2u; voffB[i] = (unsigned)(Rb * g.ldb + C) * 2u; }
    const size_t kstep = (size_t)(BK * 2);
    const size_t hstepA = (size_t)HALF * g.lda * 2, hstepB = (size_t)HALF * g.ldb * 2;
    const size_t tstepA = 2 * hstepA, tstepB = 2 * hstepB;
    const unsigned ldsw = (unsigned)wid * 1024u;
    const int aoff = lds_byte(wr * 64 + fr, fq * 8), boff = lds_byte(wc * 32 + fr, fq * 8);
#define PG8_SA(b, h) (((b) * 2 + (h)) * HTB)
#define PG8_SB(b, h) ((4 + (b) * 2 + (h)) * HTB)
#define PG8_STAGE(bufoff, gbase, voff) do { _Pragma("unroll") for (int _i = 0; _i < 2; ++_i) \
        __builtin_amdgcn_global_load_lds((const unsigned*)((const char*)(gbase) + (voff)[_i]), (PG8_LAS unsigned*)(lds + (bufoff) + ldsw + _i * 8192), 16, 0, 0); } while (0)
#define PG8_LDA(dst, b, h) do { _Pragma("unroll") for (int m = 0; m < 4; ++m) _Pragma("unroll") for (int k = 0; k < 2; ++k) dst[m][k] = *(const PG8_LAS bf16x8*)(lds + PG8_SA(b, h) + aoff + m * 2048 + k * 1024); } while (0)
#define PG8_LDB(dst, b, h) do { _Pragma("unroll") for (int n = 0; n < 2; ++n) _Pragma("unroll") for (int k = 0; k < 2; ++k) dst[n][k] = *(const PG8_LAS bf16x8*)(lds + PG8_SB(b, h) + boff + n * 2048 + k * 1024); } while (0)
#define PG8_MMA(ai, bj, At, Bt) do { __builtin_amdgcn_s_setprio(1); _Pragma("unroll") for (int m = 0; m < 4; ++m) _Pragma("unroll") for (int n = 0; n < 2; ++n) _Pragma("unroll") for (int k = 0; k < 2; ++k) \
        acc[ai][bj][m][n] = __builtin_amdgcn_mfma_f32_16x16x32_bf16(Bt[n][k], At[m][k], acc[ai][bj][m][n], 0, 0, 0); __builtin_amdgcn_s_setprio(0); } while (0)
#define PG8_WAIT_V(n) asm volatile("s_waitcnt vmcnt(" #n ")" ::: "memory")
#define PG8_WAIT_L(n) asm volatile("s_waitcnt lgkmcnt(" #n ")" ::: "memory")
#define PG8_BAR __builtin_amdgcn_s_barrier()
#define PG8_SCHED __builtin_amdgcn_sched_barrier(0)
    Unit cur, nxt; int ui = 0;
    if (!S.next(0, cur)) return;
    f32x4 acc[2][2][4][2];
#pragma unroll
    for (int a = 0; a < 2; ++a)
#pragma unroll
        for (int b = 0; b < 2; ++b)
#pragma unroll
            for (int m = 0; m < 4; ++m)
#pragma unroll
                for (int n = 0; n < 2; ++n) acc[a][b][m][n] = (f32x4){0.f, 0.f, 0.f, 0.f};
    bf16x8 At[4][2], B0[2][2], B1[2][2];
    const char* cA = (const char*)g.A + (size_t)cur.pm * tstepA; const char* cB = (const char*)g.Bt + (size_t)cur.pn * tstepB;
    if constexpr (SP2) {
        PG8_STAGE(PG8_SB(0, 0), cB, voffB); PG8_STAGE(PG8_SB(0, 1), cB + hstepB, voffB); PG8_STAGE(PG8_SA(0, 0), cA, voffA); PG8_STAGE(PG8_SA(0, 1), cA + hstepA, voffA);
        if (wr == 1) PG8_BAR;
        PG8_WAIT_V(2); PG8_BAR;
        PG8_STAGE(PG8_SB(1, 0), cB + kstep, voffB); PG8_STAGE(PG8_SA(1, 0), cA + kstep, voffA); PG8_STAGE(PG8_SB(1, 1), cB + hstepB + kstep, voffB);
        PG8_WAIT_V(6); PG8_BAR;
    } else {
        PG8_STAGE(PG8_SB(0, 0), cB, voffB); PG8_STAGE(PG8_SA(0, 0), cA, voffA); PG8_STAGE(PG8_SB(0, 1), cB + hstepB, voffB); PG8_STAGE(PG8_SA(0, 1), cA + hstepA, voffA);
        if (wr == 1) PG8_BAR;
        PG8_WAIT_V(4); PG8_BAR;
        PG8_STAGE(PG8_SB(1, 0), cB + kstep, voffB); PG8_STAGE(PG8_SA(1, 0), cA + kstep, voffA); PG8_STAGE(PG8_SB(1, 1), cB + hstepB + kstep, voffB);
        PG8_WAIT_V(6); PG8_BAR;
    }
    for (;;) {
        const bool has_next = S.next(ui + 1, nxt);
        const char* nA = has_next ? (const char*)g.A + (size_t)nxt.pm * tstepA : cA; const char* nB = has_next ? (const char*)g.Bt + (size_t)nxt.pn * tstepB : cB;
        for (int t = 0; t < nt; t += 2) {
            const bool last = (t == nt - 2);
            const char* a1 = cA + (size_t)(t + 1) * kstep;
            const char* a2 = last ? nA : cA + (size_t)(t + 2) * kstep; const char* b2 = last ? nB : cB + (size_t)(t + 2) * kstep;
            const char* a3 = a2 + kstep; const char* b3 = b2 + kstep;
            if constexpr (SP2) {
            PG8_LDB(B0, 0, 0); PG8_LDB(B1, 0, 1); PG8_SCHED; PG8_LDA(At, 0, 0); PG8_STAGE(PG8_SA(1, 1), a1 + hstepA, voffA);
            PG8_WAIT_V(8); PG8_WAIT_L(0); PG8_BAR; PG8_MMA(0, 0, At, B0); PG8_MMA(0, 1, At, B1); PG8_BAR; PG8_SCHED;
            PG8_LDA(At, 0, 1); PG8_STAGE(PG8_SB(0, 0), b2, voffB); PG8_STAGE(PG8_SB(0, 1), b2 + hstepB, voffB); PG8_STAGE(PG8_SA(0, 0), a2, voffA);
            PG8_WAIT_V(8); PG8_WAIT_L(0); PG8_BAR; PG8_MMA(1, 0, At, B0); PG8_MMA(1, 1, At, B1); PG8_BAR; PG8_SCHED;
            PG8_LDB(B0, 1, 0); PG8_LDB(B1, 1, 1); PG8_SCHED; PG8_LDA(At, 1, 0); PG8_STAGE(PG8_SA(0, 1), a2 + hstepA, voffA);
            PG8_WAIT_V(8); PG8_WAIT_L(0); PG8_BAR; PG8_MMA(0, 0, At, B0); PG8_MMA(0, 1, At, B1); PG8_BAR; PG8_SCHED;
            PG8_LDA(At, 1, 1); PG8_STAGE(PG8_SB(1, 0), b3, voffB); PG8_STAGE(PG8_SB(1, 1), b3 + hstepB, voffB); PG8_STAGE(PG8_SA(1, 0), a3, voffA);
            PG8_WAIT_V(8); PG8_WAIT_L(0); PG8_BAR; PG8_MMA(1, 0, At, B0); PG8_MMA(1, 1, At, B1); PG8_BAR; PG8_SCHED;
            } else {
            PG8_LDB(B0, 0, 0); PG8_SCHED; PG8_LDA(At, 0, 0); PG8_STAGE(PG8_SA(1, 1), a1 + hstepA, voffA);
            PG8_WAIT_L(8); PG8_BAR; PG8_WAIT_L(0); PG8_MMA(0, 0, At, B0); PG8_BAR; PG8_SCHED;
            PG8_LDB(B1, 0, 1); PG8_STAGE(PG8_SB(0, 0), b2, voffB);
            PG8_BAR; PG8_WAIT_L(0); PG8_MMA(0, 1, At, B1); PG8_BAR;
            PG8_LDA(At, 0, 1); PG8_STAGE(PG8_SA(0, 0), a2, voffA);
            PG8_BAR; PG8_WAIT_L(0); PG8_MMA(1, 0, At, B0); PG8_BAR; PG8_SCHED;
            PG8_STAGE(PG8_SB(0, 1), b2 + hstepB, voffB);
            PG8_WAIT_V(6); PG8_BAR; PG8_MMA(1, 1, At, B1); PG8_BAR;
            PG8_LDB(B0, 1, 0); PG8_SCHED; PG8_LDA(At, 1, 0); PG8_STAGE(PG8_SA(0, 1), a2 + hstepA, voffA);
            PG8_WAIT_L(8); PG8_BAR; PG8_WAIT_L(0); PG8_MMA(0, 0, At, B0); PG8_BAR; PG8_SCHED;
            PG8_LDB(B1, 1, 1); PG8_STAGE(PG8_SB(1, 0), b3, voffB);
            PG8_BAR; PG8_WAIT_L(0); PG8_MMA(0, 1, At, B1); PG8_BAR;
            PG8_LDA(At, 1, 1); PG8_STAGE(PG8_SA(1, 0), a3, voffA);
            PG8_BAR; PG8_WAIT_L(0); PG8_MMA(1, 0, At, B0); PG8_BAR; PG8_SCHED;
            PG8_STAGE(PG8_SB(1, 1), b3 + hstepB, voffB);
            PG8_WAIT_V(6); PG8_BAR; PG8_MMA(1, 1, At, B1); PG8_BAR;
            }
        }
        if constexpr (ALIGN_EPI) { if (wr == 0) PG8_BAR; }
        E(acc, cur, wr, wc, fr, fq);
        if (!has_next) break;
#pragma unroll
        for (int a = 0; a < 2; ++a)
#pragma unroll
            for (int b = 0; b < 2; ++b)
#pragma unroll
                for (int m = 0; m < 4; ++m)
#pragma unroll
                    for (int n = 0; n < 2; ++n) acc[a][b][m][n] = (f32x4){0.f, 0.f, 0.f, 0.f};
        cur = nxt; cA = nA; cB = nB; ++ui;
        if constexpr (ALIGN_EPI) { if (wr == 1) PG8_BAR; }
    }
    PG8_WAIT_V(0);
    if constexpr (!ALIGN_EPI) { if (wr == 0) PG8_BAR; }
    PG8_BAR;
#undef PG8_SA
#undef PG8_SB
#undef PG8_STAGE
#undef PG8_LDA
#undef PG8_LDB
#undef PG8_MMA
#undef PG8_WAIT_V
#undef PG8_WAIT_L
#undef PG8_BAR
#undef PG8_SCHED
}
}

constexpr int NWAVES = 8;
constexpr int BATCH = 8, SEQ = 4096, DM = 1024, MTOK = BATCH * SEQ;
constexpr int DFF = 2816, NGU = 2 * DFF, INC = 2328, NIN = 2560;
constexpr int HD = 64, NBG = 16, NCMP = 255;
constexpr float EPS = 1e-6f;
constexpr int PER_PHASE = 10;
constexpr int N_LAUNCHES = MK_N_LAUNCHES;

constexpr size_t MiB = 1u << 20;
constexpr size_t WS_CTL = 0, CTL_ZERO_BYTES = 1 * MiB;
constexpr size_t WS_WGU1 = 2 * MiB, WS_WD1 = 13 * MiB, WS_WGU2 = 19 * MiB, WS_WD2 = 30 * MiB, WS_WIN = 36 * MiB, WS_WOUT = 41 * MiB, WS_CW1 = 43 * MiB;
constexpr size_t WS_WSB = 45 * MiB, WS_CB1P = 45 * MiB + 512 * 1024;
constexpr size_t WS_SS0 = 46 * MiB, WS_SS1 = 48 * MiB, WS_SS2 = 50 * MiB, WS_SS3 = 52 * MiB, WS_SSV = 54 * MiB;
constexpr size_t WS_XB = 56 * MiB;
constexpr size_t WS_ACT = 120 * MiB;
constexpr size_t WS_Y = 120 * MiB, WS_GVT = 184 * MiB, WS_KCR = 216 * MiB, WS_VCR = 224 * MiB, WS_KS = 232 * MiB, WS_VST = 240 * MiB, WS_KW = 248 * MiB, WS_VWT = 256 * MiB;
constexpr size_t WS_GATES = 264 * MiB, WS_H1 = 268 * MiB, WS_KCMP = 272 * MiB, WS_VCMPT = 272 * MiB + 512 * 1024;
constexpr size_t WS_END = 296 * MiB;
constexpr int CW_BAR = 4096;

constexpr int RING_OFF = 0, RING_BYTES = 131072;
constexpr int LDSCTL_OFF = RING_BYTES, MISC_OFF = LDSCTL_OFF + 320;
constexpr int TB_OFF = LDSCTL_OFF + 1024;
constexpr int LDS_BYTES = 147456;

#define GAS __attribute__((address_space(1)))
#define LAS __attribute__((address_space(3)))
typedef unsigned short bf16;
typedef unsigned v4u __attribute__((ext_vector_type(4)));
typedef unsigned v2u __attribute__((ext_vector_type(2)));
typedef float f32x4 __attribute__((ext_vector_type(4)));
typedef GAS unsigned gu32;
#define RLX_AGENT __ATOMIC_RELAXED, __HIP_MEMORY_SCOPE_AGENT
#define LDS_WAIT() asm volatile("s_waitcnt lgkmcnt(0)" ::: "memory")
#define VM_WAIT() asm volatile("s_waitcnt vmcnt(0)" ::: "memory")
__device__ __forceinline__ unsigned f2bf(float f) { unsigned u = __builtin_bit_cast(unsigned, f); return (u + 0x7fffu + ((u >> 16) & 1u)) >> 16; }
__device__ __forceinline__ unsigned pk2(float lo, float hi) { return f2bf(lo) | (f2bf(hi) << 16); }
__device__ __forceinline__ float bf2f(unsigned short b) { return __builtin_bit_cast(float, (unsigned)b << 16); }
__device__ __forceinline__ float wave_sum(float v) {
#pragma unroll
    for (int o = 1; o < 64; o <<= 1) v += __shfl_xor(v, o);
    return v;
}
__device__ __forceinline__ float wave_max(float v) {
#pragma unroll
    for (int o = 1; o < 64; o <<= 1) v = fmaxf(v, __shfl_xor(v, o));
    return v;
}
__device__ __forceinline__ float gelu_tanh(float x) { const float u2 = 1.5957691216057308f * (x + 0.044715f * x * x * x); return x / (1.f + __expf(-u2)); }
__device__ __forceinline__ float sigmoidf_(float x) { return 1.f / (1.f + __expf(-x)); }

#define XB_TMO      128
#define XB_XCNT(j)  (256  + 64 * (j))
#define XB_XSUB(j)  (1280 + 64 * (j))
#define XB_XGEN(j)  (2304 + 64 * (j))
#define XB_TOP      3328
#define XB_TOPGEN   3392
#define XCD_BAR_WORDS 3456
#define XB_SPIN_CAP (1u << 22)
__device__ __forceinline__ unsigned xb_ld(unsigned* p)              { return __hip_atomic_load(p, __ATOMIC_RELAXED, __HIP_MEMORY_SCOPE_AGENT); }
__device__ __forceinline__ unsigned xb_add(unsigned* p, unsigned v) { return __hip_atomic_fetch_add(p, v, __ATOMIC_RELAXED, __HIP_MEMORY_SCOPE_AGENT); }
__device__ __forceinline__ unsigned xb_xcc_id() { return (unsigned)__builtin_amdgcn_s_getreg((3 << 11) | 20) & 0xFu; }
#define XB_SPIN(cond, bar) do { unsigned _sp = 0; while (cond) { __builtin_amdgcn_s_sleep(1); \
    if ((++_sp & 255u) == 0u) { if (xb_ld(&(bar)[XB_TMO])) break; if (_sp > XB_SPIN_CAP) { atomicAdd(&(bar)[XB_TMO], 1u); break; } } } } while (0)
struct XcdBarrier { unsigned* bar; unsigned x; volatile LAS unsigned* st; };
__device__ __forceinline__ XcdBarrier xcd_barrier_post(unsigned* bar, volatile LAS unsigned* st) {
    XcdBarrier b; b.bar = bar; b.x = xb_xcc_id(); b.st = st;
    if (threadIdx.x == 0) (void)xb_add(&bar[XB_XCNT(b.x)], 1u);
    return b;
}
__device__ __forceinline__ void xcd_barrier_complete(unsigned* bar, unsigned x, unsigned& nloc, unsigned& nx) {
    const unsigned G = gridDim.x * gridDim.y * gridDim.z;
    unsigned sum, cnt, mine, sp = 0u;
    for (;;) {
        sum = 0u; cnt = 0u; mine = 0u;
#pragma unroll
        for (unsigned j = 0; j < 16; ++j) { const unsigned c = xb_ld(&bar[XB_XCNT(j)]); sum += c; cnt += (c > 0u) ? 1u : 0u; mine = (j == x) ? c : mine; }
        if (sum == G) break;
        __builtin_amdgcn_s_sleep(1);
        if ((++sp & 255u) == 0u) { if (xb_ld(&bar[XB_TMO])) break; if (sp > XB_SPIN_CAP) { atomicAdd(&bar[XB_TMO], 1u); break; } }
    }
    nloc = mine > 0u ? mine : 1u; nx = cnt > 0u ? cnt : 1u;
}
__device__ __forceinline__ void xcd_barrier(const XcdBarrier& b) {
    asm volatile("s_waitcnt vmcnt(0)" ::: "memory");
    __syncthreads();
    if (threadIdx.x == 0) {
        unsigned* bar = b.bar;
        __builtin_amdgcn_s_waitcnt(0);
        unsigned nloc = b.st[0], nx = b.st[1];
        if (nloc == 0u) { xcd_barrier_complete(bar, b.x, nloc, nx); b.st[0] = nloc; b.st[1] = nx; }
        const unsigned old = xb_add(&bar[XB_XSUB(b.x)], 1u);
        const unsigned gen = old / nloc;
        if (old + 1u == (gen + 1u) * nloc) {
            __builtin_amdgcn_fence(__ATOMIC_RELEASE, "agent");
            asm volatile("s_waitcnt vmcnt(0)" ::: "memory");
            const unsigned og = xb_add(&bar[XB_TOP], 1u);
            const unsigned tg = og / nx;
            if (og + 1u == (tg + 1u) * nx) xb_add(&bar[XB_TOPGEN], 1u);
            else XB_SPIN(xb_ld(&bar[XB_TOPGEN]) == tg, bar);
            __builtin_amdgcn_fence(__ATOMIC_ACQUIRE, "agent");
            xb_add(&bar[XB_XGEN(b.x)], 1u);
            asm volatile("s_waitcnt vmcnt(0)" ::: "memory");
        } else {
            XB_SPIN(xb_ld(&bar[XB_XGEN(b.x)]) == gen, bar);
            __builtin_amdgcn_fence(__ATOMIC_ACQUIRE, "agent");
            asm volatile("s_waitcnt vmcnt(0)" ::: "memory");
        }
    }
    __syncthreads();
}

__device__ __forceinline__ float row_rinv(const float* ss, int row, int fq) {
    const f32x4 p = *(const f32x4*)(ss + (size_t)row * 16 + 4 * fq);
    float s = (p[0] + p[1]) + (p[2] + p[3]);
    s += __shfl_xor(s, 16); s += __shfl_xor(s, 32);
    return __builtin_amdgcn_rsqf(s * (1.f / DM) + EPS);
}
__device__ __forceinline__ float rsq_acc(float s, float invn) { return 1.0f / sqrtf(s * invn + EPS); }

struct EpiSwiGLU {
    static constexpr bool PERM = true;
    const float* ss; bf16* act;
    __device__ __forceinline__ void operator()(const f32x4 (&acc)[2][2][4][2], const pg8::Unit& u, int wr, int wc, int fr, int fq) const {
#pragma unroll
        for (int ai = 0; ai < 2; ++ai)
#pragma unroll
            for (int m = 0; m < 4; ++m) {
                const int row = u.pm * 256 + ai * 128 + wr * 64 + m * 16 + fr;
                const float ri = row_rinv(ss, row, fq);
                float o[8];
#pragma unroll
                for (int n = 0; n < 2; ++n)
#pragma unroll
                    for (int i = 0; i < 4; ++i) { const float g = acc[ai][0][m][n][i] * ri, up = acc[ai][1][m][n][i] * ri; o[n * 4 + i] = g * sigmoidf_(g) * up; }
                v4u w; w.x = pk2(o[0], o[1]); w.y = pk2(o[2], o[3]); w.z = pk2(o[4], o[5]); w.w = pk2(o[6], o[7]);
                *(v4u*)(act + (size_t)row * DFF + u.pn * 128 + wc * 32 + fq * 8) = w;
            }
    }
};
struct EpiResid {
    static constexpr bool PERM = false;
    const float* base; float* out; bf16* xb; float* ssp; float scale;
    __device__ __forceinline__ void operator()(const f32x4 (&acc)[2][2][4][2], const pg8::Unit& u, int wr, int wc, int fr, int fq) const {
#pragma unroll
        for (int ai = 0; ai < 2; ++ai)
#pragma unroll
            for (int m = 0; m < 4; ++m) {
                const int row = u.pm * 256 + ai * 128 + wr * 64 + m * 16 + fr;
                float sq = 0.f;
#pragma unroll
                for (int bj = 0; bj < 2; ++bj)
#pragma unroll
                    for (int n = 0; n < 2; ++n) {
                        const size_t off = (size_t)row * DM + u.pn * 256 + bj * 128 + wc * 32 + n * 16 + fq * 4;
                        const f32x4 b = *(const f32x4*)(base + off);
                        const f32x4 o = b + acc[ai][bj][m][n] * scale;
                        *(f32x4*)(out + off) = o;
                        if (xb) { v2u w; w.x = pk2(o[0], o[1]); w.y = pk2(o[2], o[3]); *(v2u*)(xb + off) = w; }
                        sq += (o[0] * o[0] + o[1] * o[1]) + (o[2] * o[2] + o[3] * o[3]);
                    }
                sq += __shfl_xor(sq, 16); sq += __shfl_xor(sq, 32);
                if (fq == 0) ssp[(size_t)row * 16 + u.pn * 4 + wc] = sq;
            }
    }
};
struct EpiMix {
    static constexpr bool PERM = true;
    const float* ss; bf16* Y; bf16* GVT; float* SSV; bf16* KCR; bf16* VCR; bf16* KS; bf16* VST; bf16* KW; bf16* VWT; float* GATES;
    const float* qg; const float* kg;
    __device__ __forceinline__ void operator()(const f32x4 (&acc)[2][2][4][2], const pg8::Unit& u, int wr, int wc, int fr, int fq) const {
        const int pn = u.pn;
        float gn[2][2][4];
        const float* gsrc = nullptr;
        if (pn == 4 || pn == 5) gsrc = qg; else if (pn == 7 && wc < 2) gsrc = kg + 64; else if (pn == 8 && wc < 2) gsrc = kg + 128;
#pragma unroll
        for (int bj = 0; bj < 2; ++bj)
#pragma unroll
            for (int n = 0; n < 2; ++n)
#pragma unroll
                for (int i = 0; i < 4; ++i) gn[bj][n][i] = gsrc ? gsrc[32 * bj + 8 * fq + 4 * n + i] : 1.f;
#pragma unroll
        for (int ai = 0; ai < 2; ++ai)
#pragma unroll
            for (int m = 0; m < 4; ++m) {
                const int row = u.pm * 256 + ai * 128 + wr * 64 + m * 16 + fr;
                const int b = row >> 12, t = row & 4095;
                const float ri = row_rinv(ss, row, fq);
                float v[2][2][4];
#pragma unroll
                for (int bj = 0; bj < 2; ++bj)
#pragma unroll
                    for (int n = 0; n < 2; ++n)
#pragma unroll
                        for (int i = 0; i < 4; ++i) v[bj][n][i] = acc[ai][bj][m][n][i] * ri;
                if (pn < 4) {
                    float sq = 0.f;
#pragma unroll
                    for (int bj = 0; bj < 2; ++bj)
#pragma unroll
                        for (int n = 0; n < 2; ++n)
#pragma unroll
                            for (int i = 0; i < 4; ++i) { const float x = gelu_tanh(v[bj][n][i]); v[bj][n][i] = x; sq += x * x; }
                    if (pn < 2) {
#pragma unroll
                        for (int bj = 0; bj < 2; ++bj) { v4u w; w.x = pk2(v[bj][0][0], v[bj][0][1]); w.y = pk2(v[bj][0][2], v[bj][0][3]); w.z = pk2(v[bj][1][0], v[bj][1][1]); w.w = pk2(v[bj][1][2], v[bj][1][3]);
                            *(v4u*)(Y + (size_t)row * DM + pn * 256 + wc * 64 + bj * 32 + fq * 8) = w; }
                    } else {
                        const int h = (pn - 2) * 4 + wc;
                        bf16* dst = GVT + ((size_t)(b * 8 + h) * 64) * SEQ + t;
#pragma unroll
                        for (int bj = 0; bj < 2; ++bj)
#pragma unroll
                            for (int n = 0; n < 2; ++n)
#pragma unroll
                                for (int i = 0; i < 4; ++i) dst[(size_t)(32 * bj + 8 * fq + 4 * n + i) * SEQ] = (bf16)f2bf(v[bj][n][i]);
                        sq += __shfl_xor(sq, 16); sq += __shfl_xor(sq, 32);
                        if (fq == 0) SSV[(size_t)row * 8 + (pn - 2) * 4 + wc] = sq;
                    }
                } else if (pn < 9) {
                    const bool is_q = (pn == 4 || pn == 5);
                    const bool is_k = (wc < 2);
                    const bool normed = is_q || ((pn == 7 || pn == 8) && is_k);
                    if (normed) {
                        float sq = 0.f;
#pragma unroll
                        for (int bj = 0; bj < 2; ++bj)
#pragma unroll
                            for (int n = 0; n < 2; ++n)
#pragma unroll
                                for (int i = 0; i < 4; ++i) sq += v[bj][n][i] * v[bj][n][i];
                        sq += __shfl_xor(sq, 16); sq += __shfl_xor(sq, 32);
                        const float rh = rsq_acc(sq, 1.f / 64.f) * (is_q ? 0.125f : 1.f);
#pragma unroll
                        for (int bj = 0; bj < 2; ++bj)
#pragma unroll
                            for (int n = 0; n < 2; ++n)
#pragma unroll
                                for (int i = 0; i < 4; ++i) v[bj][n][i] *= rh * gn[bj][n][i];
                    }
                    if (is_q || is_k) {
                        bf16* dst;
                        if (is_q) dst = Y + (size_t)row * DM + 512 + (pn - 4) * 256 + wc * 64;
                        else { bf16* kb = (pn == 6) ? KCR : (pn == 7) ? KS : KW; dst = kb + ((size_t)(b * 2 + wc) * SEQ + t) * 64; }
#pragma unroll
                        for (int bj = 0; bj < 2; ++bj) { v4u w; w.x = pk2(v[bj][0][0], v[bj][0][1]); w.y = pk2(v[bj][0][2], v[bj][0][3]); w.z = pk2(v[bj][1][0], v[bj][1][1]); w.w = pk2(v[bj][1][2], v[bj][1][3]);
                            *(v4u*)(dst + bj * 32 + fq * 8) = w; }
                    } else if (pn == 6) {
                        bf16* dst = VCR + ((size_t)(b * 2 + (wc - 2)) * SEQ + t) * 64;
#pragma unroll
                        for (int bj = 0; bj < 2; ++bj) { v4u w; w.x = pk2(v[bj][0][0], v[bj][0][1]); w.y = pk2(v[bj][0][2], v[bj][0][3]); w.z = pk2(v[bj][1][0], v[bj][1][1]); w.w = pk2(v[bj][1][2], v[bj][1][3]);
                            *(v4u*)(dst + bj * 32 + fq * 8) = w; }
                    } else {
                        bf16* vb = (pn == 7) ? VST : VWT;
                        bf16* dst = vb + ((size_t)(b * 2 + (wc - 2)) * 64) * SEQ + t;
#pragma unroll
                        for (int bj = 0; bj < 2; ++bj)
#pragma unroll
                            for (int n = 0; n < 2; ++n)
#pragma unroll
                                for (int i = 0; i < 4; ++i) dst[(size_t)(32 * bj + 8 * fq + 4 * n + i) * SEQ] = (bf16)f2bf(v[bj][n][i]);
                    }
                } else {
                    if (wc == 0 && fq < 3) {
                        f32x4 g0, g1;
#pragma unroll
                        for (int i = 0; i < 4; ++i) { g0[i] = sigmoidf_(v[0][0][i]); g1[i] = sigmoidf_(v[0][1][i]); }
                        *(f32x4*)(GATES + (size_t)row * 24 + fq * 8) = g0; *(f32x4*)(GATES + (size_t)row * 24 + fq * 8 + 4) = g1;
                    }
                }
            }
    }
};
struct EpiCmp {
    static constexpr bool PERM = true;
    const float* cb1p; bf16* H1;
    __device__ __forceinline__ void operator()(const f32x4 (&acc)[2][2][4][2], const pg8::Unit& u, int wr, int wc, int fr, int fq) const {
        float bias[2][2][4];
#pragma unroll
        for (int bj = 0; bj < 2; ++bj)
#pragma unroll
            for (int n = 0; n < 2; ++n)
#pragma unroll
                for (int i = 0; i < 4; ++i) { const int col = u.pn * 256 + bj * 128 + wc * 32 + fq * 8 + n * 4 + i; float s = 0.f;
#pragma unroll
                    for (int p = 0; p < 8; ++p) s += cb1p[p * 512 + col];
                    bias[bj][n][i] = s; }
#pragma unroll
        for (int ai = 0; ai < 2; ++ai)
#pragma unroll
            for (int m = 0; m < 4; ++m) {
                const int row = u.pm * 256 + ai * 128 + wr * 64 + m * 16 + fr;
#pragma unroll
                for (int bj = 0; bj < 2; ++bj) { float o[8];
#pragma unroll
                    for (int n = 0; n < 2; ++n)
#pragma unroll
                        for (int i = 0; i < 4; ++i) o[n * 4 + i] = gelu_tanh(acc[ai][bj][m][n][i] + bias[bj][n][i]);
                    v4u w; w.x = pk2(o[0], o[1]); w.y = pk2(o[2], o[3]); w.z = pk2(o[4], o[5]); w.w = pk2(o[6], o[7]);
                    *(v4u*)(H1 + (size_t)row * 256 + bj * 128 + wc * 32 + fq * 8) = w; }
            }
    }
};

struct Frame {
    LAS unsigned char* lds; volatile LAS unsigned* MISC; gu32* ctl;
    int tid, lane, wave, vcu, G;
};
struct Args { const float* in[24]; float* out; unsigned char* ws; int ph_lo, ph_hi, li, pad; };

__device__ __forceinline__ void p0_tr_item(const float* W, int ldw, int K, const float* gain, bf16* WT, int n0d, int sc0, int nvalid, int kb, LAS float* scr, int lane) {
    const int k0 = 64 * kb;
#pragma unroll 8
    for (int i = 0; i < 32; ++i) { const int kk = 2 * i + (lane >> 5), c = lane & 31;
        float x = 0.f; if (c < nvalid) { x = W[(size_t)(k0 + kk) * ldw + sc0 + c]; if (gain) x *= gain[k0 + kk]; }
        scr[kk * 33 + c] = x; }
    LDS_WAIT(); asm volatile("" ::: "memory");
    const int c = lane & 7;
#pragma unroll
    for (int j = 0; j < 4; ++j) { const int n = (lane >> 3) + 8 * j; const LAS float* s = scr + (8 * c) * 33 + n;
        v4u o; o.x = pk2(s[0 * 33], s[1 * 33]); o.y = pk2(s[2 * 33], s[3 * 33]); o.z = pk2(s[4 * 33], s[5 * 33]); o.w = pk2(s[6 * 33], s[7 * 33]);
        *(GAS v4u*)(WT + (size_t)(n0d + n) * K + k0 + 8 * c) = o; }
    LDS_WAIT(); asm volatile("" ::: "memory");
}

__device__ __forceinline__ void p0_prologue(Frame& F, const Args& A) {
    unsigned char* ws = A.ws;
    LAS float* scr = (LAS float*)(F.lds + RING_OFF + F.wave * 16384);
    const int gw = F.vcu * NWAVES + F.wave, NGW = F.G * NWAVES, lane = F.lane;
    constexpr int I_GU = (DM / 64) * (NGU / 32), I_D = (DFF / 64) * (DM / 32), I_IN = (DM / 64) * (NIN / 32), I_OUT = (DM / 64) * (DM / 32), I_C1 = 2 * (2048 / 64) * (256 / 32);
    constexpr int I_WS = 8 * 128 * 128 / 64 / 8;
    constexpr int I_CB = 64;
    constexpr int NITEMS = 2 * I_GU + 2 * I_D + I_IN + I_OUT + I_C1 + I_WS + I_CB;
    for (int it = gw; it < NITEMS; it += NGW) {
        int r = it;
        if (r < 2 * I_GU) {
            const int f = r / I_GU; r -= f * I_GU; const int nblk = NGU / 32, kb = r / nblk, nb = r % nblk, n0 = 32 * nb, pn = n0 >> 8, bj = (n0 >> 7) & 1, j = n0 & 127;
            const float* W = f ? (bj ? A.in[21] : A.in[20]) : (bj ? A.in[3] : A.in[2]);
            p0_tr_item(W, DFF, DM, f ? A.in[19] : A.in[1], (bf16*)(ws + (f ? WS_WGU2 : WS_WGU1)), n0, 128 * pn + j, 32, kb, scr, lane); continue; }
        r -= 2 * I_GU;
        if (r < 2 * I_D) {
            const int f = r / I_D; r -= f * I_D; const int nblk = DM / 32, kb = r / nblk, nb = r % nblk;
            p0_tr_item(f ? A.in[22] : A.in[4], DM, DFF, nullptr, (bf16*)(ws + (f ? WS_WD2 : WS_WD1)), 32 * nb, 32 * nb, 32, kb, scr, lane); continue; }
        r -= 2 * I_D;
        if (r < I_IN) {
            const int nblk = NIN / 32, kb = r / nblk, nb = r % nblk, n0 = 32 * nb, pn = n0 >> 8, tc = n0 & 255;
            const int col = 256 * pn + 64 * ((tc >> 5) & 3) + 32 * (tc >> 7);
            int nv = INC - col; nv = nv < 0 ? 0 : (nv > 32 ? 32 : nv);
            p0_tr_item(A.in[6], INC, DM, A.in[5], (bf16*)(ws + WS_WIN), n0, col, nv, kb, scr, lane); continue; }
        r -= I_IN;
        if (r < I_OUT) { const int nblk = DM / 32, kb = r / nblk, nb = r % nblk;
            p0_tr_item(A.in[18], DM, DM, nullptr, (bf16*)(ws + WS_WOUT), 32 * nb, 32 * nb, 32, kb, scr, lane); continue; }
        r -= I_OUT;
        if (r < I_C1) { const int kv = r / (I_C1 / 2); r -= kv * (I_C1 / 2); const int nblk = 256 / 32, kb = r / nblk, nb = r % nblk;
            p0_tr_item(A.in[13] + (size_t)kv * 2048 * 256, 256, 2048, nullptr, (bf16*)(ws + WS_CW1) + (size_t)kv * 256 * 2048, 32 * nb, 32 * nb, 32, kb, scr, lane); continue; }
        r -= I_C1;
        if (r < I_WS) {
            const int e0 = (r * 64 + lane) * 8; const int s0 = e0 & 127, t = (e0 >> 7) & 127;
            const float* src = A.in[8] + e0; unsigned o[4];
#pragma unroll
            for (int i = 0; i < 4; ++i) { const float a = (s0 + 2 * i <= t) ? src[2 * i] : 0.f, b2 = (s0 + 2 * i + 1 <= t) ? src[2 * i + 1] : 0.f; o[i] = pk2(a, b2); }
            *(v4u*)((bf16*)(ws + WS_WSB) + e0) = (v4u){o[0], o[1], o[2], o[3]}; continue; }
        r -= I_WS;
        {
            const int kp = r & 7, jb = (r >> 3) & 3, kv = r >> 5, j = jb * 64 + lane;
            const float* pe = A.in[12] + (size_t)kv * 2048; const float* w1 = A.in[13] + (size_t)kv * 2048 * 256;
            float s = (kp == 0) ? A.in[14][kv * 256 + j] : 0.f;
            for (int k = kp * 256; k < kp * 256 + 256; ++k) s += pe[k] * w1[(size_t)k * 256 + j];
            ((float*)(ws + WS_CB1P))[kp * 512 + kv * 256 + j] = s;
        }
    }
    const float* x = A.in[0]; bf16* XB = (bf16*)(ws + WS_XB); float* SS0 = (float*)(ws + WS_SS0);
    for (int m = gw; m < MTOK; m += NGW) {
        const GAS f32x4* xr = (const GAS f32x4*)(x + (size_t)m * DM) + lane;
        GAS unsigned long long* o8 = (GAS unsigned long long*)(XB + (size_t)m * DM) + lane;
        float s = 0.f;
#pragma unroll
        for (int j = 0; j < 4; ++j) { const f32x4 v = xr[64 * j]; s += (v.x * v.x + v.y * v.y) + (v.z * v.z + v.w * v.w);
            o8[64 * j] = (unsigned long long)pk2(v.x, v.y) | ((unsigned long long)pk2(v.z, v.w) << 32); }
        s = wave_sum(s);
        if (lane < 16) SS0[(size_t)m * 16 + lane] = (lane == 0) ? s : 0.f;
    }
}

__device__ __forceinline__ void gmlp_unit_simple(Frame& F, const Args& A, int unit) {
    unsigned char* ws = A.ws;
    const int b = unit >> 5, c = unit & 31, r0 = b * SEQ + c * 128;
    LAS float* rv = (LAS float*)(F.lds + RING_OFF);
    const float* SSV = (const float*)(ws + WS_SSV);
    if (F.tid < 128) { float s = 0.f;
#pragma unroll
        for (int p = 0; p < 8; ++p) s += SSV[(size_t)(r0 + F.tid) * 8 + p];
        rv[F.tid] = rsq_acc(s, 1.f / 512.f); }
    __syncthreads();
    const bf16* GVT = (const bf16*)(ws + WS_GVT); const bf16* WSB = (const bf16*)(ws + WS_WSB); bf16* Y = (bf16*)(ws + WS_Y);
    const float* gvn = A.in[7]; const float* bs = A.in[9];
    for (int idx = F.tid; idx < 128 * 512; idx += 512) {
        const int tl = idx & 127, hd = idx >> 7, h = hd >> 6, d = hd & 63;
        const bf16* gv = GVT + ((size_t)(b * 8 + h) * 64 + d) * SEQ + c * 128; const bf16* w = WSB + (size_t)(h * 128 + tl) * 128;
        float a = 0.f;
        for (int s = 0; s <= tl; ++s) a += bf2f(w[s]) * bf2f(gv[s]) * rv[s];
        const float sv = a * gvn[h * 64 + d] + bs[h * 128 + tl];
        const size_t yi = (size_t)(r0 + tl) * DM + hd;
        Y[yi] = (bf16)f2bf(bf2f(Y[yi]) * sv);
    }
    __syncthreads();
}
__device__ __forceinline__ void cmp2_unit_simple(Frame& F, const Args& A, int pm) {
    unsigned char* ws = A.ws;
    __threadfence(); __syncthreads();
    const int kv = pm >> 4;
    const bf16* H1 = (const bf16*)(ws + WS_H1);
    const float* w2 = A.in[15] + (size_t)kv * 256 * 64; const float* b2 = A.in[16] + kv * 64; const float* kg0 = A.in[11];
    bf16* KCMP = (bf16*)(ws + WS_KCMP); bf16* VCMPT = (bf16*)(ws + WS_VCMPT);
    const int d = F.lane;
    for (int rr = F.wave; rr < 256; rr += NWAVES) {
        const int row = pm * 256 + rr;
        float a = b2[d];
        for (int j = 0; j < 256; ++j) a += bf2f(H1[(size_t)row * 256 + j]) * w2[j * 64 + d];
        const int n = row & 255, bg = (row & 4095) >> 8;
        if (kv == 0) { const float ssq = wave_sum(a * a); a = a * rsq_acc(ssq, 1.f / 64.f) * kg0[d]; KCMP[((size_t)bg * 256 + n) * 64 + d] = (bf16)f2bf(a); }
        else VCMPT[((size_t)bg * 64 + d) * 256 + n] = (bf16)f2bf(a);
    }
}

__device__ __forceinline__ float dot64(const LAS float* qf, const bf16* krow) {
    float s = 0.f;
#pragma unroll
    for (int c = 0; c < 8; ++c) { const v4u w = *(const v4u*)(krow + 8 * c);
        s += qf[8 * c + 0] * __builtin_bit_cast(float, w.x << 16) + qf[8 * c + 1] * __builtin_bit_cast(float, w.x & 0xffff0000u)
           + qf[8 * c + 2] * __builtin_bit_cast(float, w.y << 16) + qf[8 * c + 3] * __builtin_bit_cast(float, w.y & 0xffff0000u)
           + qf[8 * c + 4] * __builtin_bit_cast(float, w.z << 16) + qf[8 * c + 5] * __builtin_bit_cast(float, w.z & 0xffff0000u)
           + qf[8 * c + 6] * __builtin_bit_cast(float, w.w << 16) + qf[8 * c + 7] * __builtin_bit_cast(float, w.w & 0xffff0000u); }
    return s;
}
__device__ __forceinline__ float branch_simple(int NS, const LAS float* qf, LAS float* sb, const LAS int* kb, const bf16* Kb, const bf16* VT, int ldv, int maxkey,
                                               int t, int lo_key, int step, int stepoff, const float* relh, const LAS unsigned char* tb, int lane) {
    float m = -INFINITY;
#pragma unroll 1
    for (int k = 0; k < NS; ++k) {
        const int kk = kb[k] + lane; float sc = -INFINITY;
        const int pos = kk * step + stepoff;
        if (kb[k] >= 0 && kk >= lo_key && kk <= maxkey && pos <= t) { const int dist = t - pos; sc = dot64(qf, Kb + (size_t)kk * 64) + relh[dist < 128 ? tb[dist] : 31]; }
        sb[k * 64 + lane] = sc; m = fmaxf(m, sc);
    }
    m = wave_max(m);
    if (m == -INFINITY) m = 0.f;
    float l = 0.f;
#pragma unroll 1
    for (int k = 0; k < NS; ++k) { const float pz = __expf(sb[k * 64 + lane] - m); sb[k * 64 + lane] = pz; l += pz; }
    l = wave_sum(l);
    const float inv = l > 0.f ? 1.f / l : 0.f;
#pragma unroll 1
    for (int k = 0; k < NS; ++k) sb[k * 64 + lane] *= inv;
    float res = 0.f;
#pragma unroll 1
    for (int d = 0; d < 64; ++d) {
        float a = 0.f;
#pragma unroll 4
        for (int k = 0; k < NS; ++k) { int kk = kb[k] + lane; kk = kk < 0 ? 0 : (kk > maxkey ? maxkey : kk); a += sb[k * 64 + lane] * bf2f(VT[(size_t)d * ldv + kk]); }
        a = wave_sum(a);
        if (lane == d) res = a;
    }
    return res;
}
__device__ __forceinline__ void attn_unit_simple(Frame& F, const Args& A, int unit) {
    unsigned char* ws = A.ws;
    const int bg = unit & 15, qt = 511 - (unit >> 4), b = bg >> 1, g = bg & 1, lane = F.lane;
    const int t = qt * 8 + F.wave; const size_t row = (size_t)b * SEQ + t;
    LAS float* qf = (LAS float*)(F.lds + RING_OFF + F.wave * 8192);
    LAS float* ps = qf + 64;
    LAS int* kb = (LAS int*)(ps + 256);
    LAS float* sb = ps + 256 + 16;
    const LAS unsigned char* tb = (const LAS unsigned char*)(F.lds + TB_OFF);
    bf16* Y = (bf16*)(ws + WS_Y);
    const float* rel = A.in[17];
    float oc[4], psum[4] = {0.f, 0.f, 0.f, 0.f};
    if (lane < 16) kb[lane] = lane < 4 ? 64 * lane : -1;
#pragma unroll
    for (int hg = 0; hg < 4; ++hg) {
        const int h = g * 4 + hg;
        const bf16* KCMP = (const bf16*)(ws + WS_KCMP) + (size_t)bg * 256 * 64; const bf16* VCMPT = (const bf16*)(ws + WS_VCMPT) + (size_t)bg * 64 * 256;
        LDS_WAIT(); asm volatile("" ::: "memory");
        qf[lane] = bf2f(Y[row * DM + 512 + h * 64 + lane]);
        LDS_WAIT(); asm volatile("" ::: "memory");
        oc[hg] = branch_simple(4, qf, sb, kb, KCMP, VCMPT, 256, NCMP - 1, t, 0, 16, 31, rel + h * 32, tb, lane);
#pragma unroll
        for (int a = 0; a < 4; ++a) psum[a] += sb[a * 64 + lane];
    }
#pragma unroll
    for (int a = 0; a < 4; ++a) ps[64 * a + lane] = psum[a];
    LDS_WAIT(); asm volatile("" ::: "memory");
    const int cur = t >> 6, j = lane;
    float imp = 0.f;
#pragma unroll
    for (int dn = -1; dn <= 3; ++dn) { const int n = 4 * j + dn; if (n >= 0 && n < NCMP) imp += ps[n]; }
    const bool elig = j <= cur, forced = (j == 0) || (j == cur) || (j == cur - 1);
    const float val = elig ? (forced ? 1e6f : imp) : -1.f;
    int rank = 0;
#pragma unroll 4
    for (int jj = 0; jj < 64; ++jj) { const float vj = __shfl(val, jj); rank += ((vj > val) || (vj == val && jj < j)) ? 1 : 0; }
    const unsigned long long mask = __ballot(rank < 16);
#pragma unroll
    for (int hg = 0; hg < 4; ++hg) {
        const int h = g * 4 + hg;
        LDS_WAIT(); asm volatile("" ::: "memory");
        qf[lane] = bf2f(Y[row * DM + 512 + h * 64 + lane]);
        if (lane < 16) { unsigned long long mm = mask; int jb = -1; for (int k = 0; k <= lane; ++k) { jb = -1; if (mm) { jb = __builtin_ctzll(mm); mm &= mm - 1; } } kb[lane] = (jb >= 0 && jb <= cur) ? 64 * jb : -1; }
        LDS_WAIT(); asm volatile("" ::: "memory");
        const bf16* KS = (const bf16*)(ws + WS_KS) + (size_t)bg * SEQ * 64; const bf16* VST = (const bf16*)(ws + WS_VST) + (size_t)bg * 64 * SEQ;
        const float os = branch_simple(16, qf, sb, kb, KS, VST, SEQ, SEQ - 1, t, 0, 1, 0, rel + h * 32, tb, lane);
        LDS_WAIT(); asm volatile("" ::: "memory");
        if (lane < 16) kb[lane] = lane < 8 ? t - 511 + 64 * lane + 4096 : -1;
        LDS_WAIT(); asm volatile("" ::: "memory");
        const bf16* KW = (const bf16*)(ws + WS_KW) + (size_t)bg * SEQ * 64; const bf16* VWT = (const bf16*)(ws + WS_VWT) + (size_t)bg * 64 * SEQ;
        const float ow = branch_simple(8, qf, sb, kb, KW - (size_t)4096 * 64, VWT - 4096, SEQ, SEQ - 1 + 4096, t + 4096, 4096, 1, 0, rel + h * 32, tb, lane);
        const float* GATES = (const float*)(ws + WS_GATES) + row * 24;
        const float o = GATES[0 * 8 + h] * oc[hg] + GATES[1 * 8 + h] * os + GATES[2 * 8 + h] * ow;
        Y[row * DM + 512 + h * 64 + lane] = (bf16)f2bf(o);
    }
}

__global__ void __launch_bounds__(NWAVES * 64, 2) mk_fwd(Args args) {
    extern __shared__ __attribute__((aligned(16))) unsigned char lds[];
    Frame F;
    F.lds = (LAS unsigned char*)lds;
    F.MISC = (volatile LAS unsigned*)(F.lds + MISC_OFF);
    F.tid = threadIdx.x; F.lane = F.tid & 63; F.wave = __builtin_amdgcn_readfirstlane(F.tid >> 6);
    F.G = gridDim.x; { const int bx = blockIdx.x; F.vcu = (F.G % 8 == 0) ? (bx % 8) * (F.G / 8) + bx / 8 : bx; }
    unsigned char* ws = args.ws;
    F.ctl = (gu32*)(ws + WS_CTL);
    for (int u = F.tid; u < (LDS_BYTES - LDSCTL_OFF) / 4; u += NWAVES * 64) ((LAS unsigned*)(F.lds + LDSCTL_OFF))[u] = 0u;
    __syncthreads();
    if (F.tid < 128) { const int n = F.tid; int bkt = n;
        if (n >= 16) { const float nf = (float)n; int large = 16 + (int)(logf(nf / 16.f) / logf(8.f) * 16.f); bkt = large < 31 ? large : 31; }
        ((LAS unsigned char*)(F.lds + TB_OFF))[n] = (unsigned char)bkt; }
    __syncthreads();
    XcdBarrier bar; bar.bar = (unsigned*)(F.ctl + CW_BAR) + args.li * XCD_BAR_WORDS; bar.x = 0; bar.st = nullptr;
    if (N_LAUNCHES != PER_PHASE) bar = xcd_barrier_post((unsigned*)(F.ctl + CW_BAR) + args.li * XCD_BAR_WORDS, F.MISC + 8);
#define GRID_BAR() do { if (N_LAUNCHES != PER_PHASE) xcd_barrier(bar); } while (0)
    const int lo = args.ph_lo, hi = args.ph_hi;
#define IN(k) (lo <= (k) && (k) < hi)
#define BOTH(k) (IN(k) && IN((k) + 1))
    bf16* XB = (bf16*)(ws + WS_XB); bf16* ACT = (bf16*)(ws + WS_ACT); bf16* Y = (bf16*)(ws + WS_Y);
    float* SS0 = (float*)(ws + WS_SS0); float* SS1 = (float*)(ws + WS_SS1); float* SS2 = (float*)(ws + WS_SS2); float* SS3 = (float*)(ws + WS_SS3);

    if (IN(0)) { p0_prologue(F, args); if (BOTH(0)) GRID_BAR(); }
    if (IN(1)) {
        pg8::Gemm g{XB, (const bf16*)(ws + WS_WGU1), MTOK, NGU, DM, DM, DM}; pg8::StaticOrder S; S.init(MTOK, NGU, F.G, (int)blockIdx.x);
        EpiSwiGLU E{SS0, ACT};
        pg8::gemm_phase<EpiSwiGLU, pg8::StaticOrder, true, true>(F.lds + RING_OFF, g, S, E);
        if (BOTH(1)) GRID_BAR();
    }
    if (IN(2)) {
        pg8::Gemm g{ACT, (const bf16*)(ws + WS_WD1), MTOK, DM, DFF, DFF, DFF}; pg8::StaticOrder S; S.init(MTOK, DM, F.G, (int)blockIdx.x);
        EpiResid E{args.in[0], args.out, XB, SS1, 0.5f};
        pg8::gemm_phase<EpiResid, pg8::StaticOrder, true, true>(F.lds + RING_OFF, g, S, E);
        if (BOTH(2)) GRID_BAR();
    }
    if (IN(3)) {
        pg8::Gemm g{XB, (const bf16*)(ws + WS_WIN), MTOK, NIN, DM, DM, DM}; pg8::StaticOrder S; S.init(MTOK, NIN, F.G, (int)blockIdx.x);
        EpiMix E{SS1, Y, (bf16*)(ws + WS_GVT), (float*)(ws + WS_SSV), (bf16*)(ws + WS_KCR), (bf16*)(ws + WS_VCR), (bf16*)(ws + WS_KS), (bf16*)(ws + WS_VST),
                 (bf16*)(ws + WS_KW), (bf16*)(ws + WS_VWT), (float*)(ws + WS_GATES), args.in[10], args.in[11]};
        pg8::gemm_phase<EpiMix, pg8::StaticOrder, true, true>(F.lds + RING_OFF, g, S, E);
        if (BOTH(3)) GRID_BAR();
    }
    if (IN(4)) {
        {
            pg8::Gemm g{(const bf16*)(ws + WS_KCR), (const bf16*)(ws + WS_CW1), 8192, 512, 2048, 1024, 2048}; pg8::CmpOrder S{(int)blockIdx.x};
            EpiCmp E{(const float*)(ws + WS_CB1P), (bf16*)(ws + WS_H1)};
            pg8::gemm_phase<EpiCmp, pg8::CmpOrder, false, true>(F.lds + RING_OFF, g, S, E);
            if (blockIdx.x < 32) cmp2_unit_simple(F, args, (int)blockIdx.x);
            __syncthreads();
        }
        for (int u = F.vcu; u < 256; u += F.G) gmlp_unit_simple(F, args, u);
        if (BOTH(4)) GRID_BAR();
    }
    if (IN(5)) {
        for (int u = (int)blockIdx.x; u < NBG * 512; u += F.G) attn_unit_simple(F, args, u);
        if (BOTH(5)) GRID_BAR();
    }
    if (IN(6)) {
        pg8::Gemm g{Y, (const bf16*)(ws + WS_WOUT), MTOK, DM, DM, DM, DM}; pg8::StaticOrder S; S.init(MTOK, DM, F.G, (int)blockIdx.x);
        EpiResid E{args.out, args.out, XB, SS2, 1.0f};
        pg8::gemm_phase<EpiResid, pg8::StaticOrder, true, true>(F.lds + RING_OFF, g, S, E);
        if (BOTH(6)) GRID_BAR();
    }
    if (IN(7)) {
        pg8::Gemm g{XB, (const bf16*)(ws + WS_WGU2), MTOK, NGU, DM, DM, DM}; pg8::StaticOrder S; S.init(MTOK, NGU, F.G, (int)blockIdx.x);
        EpiSwiGLU E{SS2, ACT};
        pg8::gemm_phase<EpiSwiGLU, pg8::StaticOrder, true, true>(F.lds + RING_OFF, g, S, E);
        if (BOTH(7)) GRID_BAR();
    }
    if (IN(8)) {
        pg8::Gemm g{ACT, (const bf16*)(ws + WS_WD2), MTOK, DM, DFF, DFF, DFF}; pg8::StaticOrder S; S.init(MTOK, DM, F.G, (int)blockIdx.x);
        EpiResid E{args.out, args.out, nullptr, SS3, 0.5f};
        pg8::gemm_phase<EpiResid, pg8::StaticOrder, true, true>(F.lds + RING_OFF, g, S, E);
        if (BOTH(8)) GRID_BAR();
    }
    if (IN(9)) {
        const int gw = F.vcu * NWAVES + F.wave, NGW = F.G * NWAVES; const float* gf = args.in[23];
        for (int m = gw; m < MTOK; m += NGW) {
            float s = (F.lane < 16) ? SS3[(size_t)m * 16 + F.lane] : 0.f; s = wave_sum(s);
            const float ri = rsq_acc(s, 1.f / DM);
            GAS f32x4* xr = (GAS f32x4*)(args.out + (size_t)m * DM) + F.lane;
#pragma unroll
            for (int j = 0; j < 4; ++j) { f32x4 v = xr[64 * j]; const f32x4 gg = *((const f32x4*)gf + F.lane + 64 * j); v = v * ri * gg; xr[64 * j] = v; }
        }
    }
#undef IN
#undef BOTH
#undef GRID_BAR
}

extern "C" void kernel_launch(void* const* d_in, const int* in_sizes, int n_in, void* d_out, int out_size, void* d_ws, size_t ws_size, hipStream_t stream) {
    static int grid = 0;
    if (grid == 0) {
        if (n_in != 24 || in_sizes[0] != MTOK * DM || out_size != MTOK * DM || ws_size < WS_END) { fprintf(stderr, "kernel_launch: unexpected shapes (n_in %d, in0 %d, out %d, ws %zu)\n", n_in, n_in > 0 ? in_sizes[0] : -1, out_size, ws_size); grid = -1; return; }
        int dev = 0, cus = 0, per_cu = 0;
        if (hipGetDevice(&dev) != hipSuccess || hipDeviceGetAttribute(&cus, hipDeviceAttributeMultiprocessorCount, dev) != hipSuccess) { grid = -1; return; }
        if (hipFuncSetAttribute((const void*)mk_fwd, hipFuncAttributeMaxDynamicSharedMemorySize, LDS_BYTES) != hipSuccess) { fprintf(stderr, "kernel_launch: hipFuncSetAttribute failed\n"); grid = -1; return; }
        if (hipOccupancyMaxActiveBlocksPerMultiprocessor(&per_cu, (const void*)mk_fwd, NWAVES * 64, LDS_BYTES) != hipSuccess || per_cu < 1) { fprintf(stderr, "kernel_launch: occupancy query says %d blocks per CU\n", per_cu); (void)hipGetLastError(); grid = -1; return; }
        grid = cus;
    }
    if (grid < 0) return;
    (void)hipMemsetAsync((char*)d_ws + WS_CTL, 0, CTL_ZERO_BYTES, stream);
    Args a{};
    for (int i = 0; i < 24; ++i) a.in[i] = (const float*)d_in[i];
    a.out = (float*)d_out; a.ws = (unsigned char*)d_ws;
    if (N_LAUNCHES == 1) {
        a.ph_lo = 0; a.ph_hi = PER_PHASE; a.li = 0;
        void* kargs[] = {&a};
        hipError_t e = hipLaunchCooperativeKernel((const void*)mk_fwd, dim3(grid), dim3(NWAVES * 64), kargs, LDS_BYTES, stream);
        if (e != hipSuccess) fprintf(stderr, "kernel_launch: cooperative launch failed: %s (grid %d)\n", hipGetErrorString(e), grid);
    } else {
        for (int li = 0; li < PER_PHASE; ++li) { a.ph_lo = li; a.ph_hi = li + 1; a.li = 0;
            hipLaunchKernelGGL(mk_fwd, dim3(grid), dim3(NWAVES * 64), LDS_BYTES, stream, a); }
    }
}
```

```cpp
#include <hip/hip_runtime.h>
#include <cstdio>
#include <cstdint>

#ifndef MK_N_LAUNCHES
#define MK_N_LAUNCHES 1
#endif

namespace pg8 {
#define PG8_LAS __attribute__((address_space(3)))
typedef unsigned short bf16_t;
typedef short bf16x8 __attribute__((ext_vector_type(8)));
typedef float f32x4 __attribute__((ext_vector_type(4)));
typedef unsigned u32x4 __attribute__((ext_vector_type(4)));
typedef unsigned u32x2 __attribute__((ext_vector_type(2)));
constexpr int BM = 256, BK = 64, HALF = 128, HTB = HALF * BK * 2, STAGE_BYTES = 8 * HTB, NXCD = 8, WGM = 8;

__host__ __device__ __forceinline__ int lds_byte(int r, int c) { const int st = (r >> 4) * 2 + (c >> 5), rr = r & 15, cc = c & 31, ob = rr * 64 + cc * 2; return st * 1024 + (ob ^ (((ob >> 9) & 1) << 5)); }
__host__ __device__ __forceinline__ void stage_rc(int b, int& R, int& C) { const int st = b / 1024, sb = b % 1024, swz = sb ^ (((sb >> 9) & 1) << 5); R = (st >> 1) * 16 + swz / 64; C = (st & 1) * 32 + (swz % 64) / 2; }
__host__ __device__ __forceinline__ int perm32(int rho) { const int n = rho >> 4, i = rho & 15; return 8 * (i >> 2) + 4 * n + (i & 3); }

struct Unit { int pm, pn; };
struct Gemm { const bf16_t* A; const bf16_t* Bt; int M, N, K, lda, ldb; };

struct StaticOrder {
    int nM, nN, nwg, G, c;
    __host__ __device__ void init(int M, int N, int G_, int c_) { nM = M / BM; nN = N / BM; nwg = nM * nN; G = G_; c = c_; }
    __host__ __device__ bool next(int i, Unit& u) const {
        const long L = (long)i * G + c; if (L >= nwg) return false;
        int wgid = (int)L; { const int q = nwg / NXCD, r = nwg % NXCD, xcd = wgid % NXCD, off = wgid / NXCD; wgid = (xcd < r ? xcd * (q + 1) : r * (q + 1) + (xcd - r) * q) + off; }
        const int nig = WGM * nN, gid = wgid / nig, fm = gid * WGM, gsz = (nM - fm) < WGM ? (nM - fm) : WGM;
        u.pm = fm + ((wgid % nig) % gsz); u.pn = (wgid % nig) / gsz; return true;
    }
};
struct CmpOrder {
    int c;
    __device__ bool next(int i, Unit& u) const { if (i != 0 || c >= 32) return false; u.pm = c; u.pn = c >> 4; return true; }
};

__device__ __forceinline__ unsigned cvt_pk_bf16(float lo, float hi) { unsigned r; asm volatile("v_cvt_pk_bf16_f32 %0, %1, %2" : "=v"(r) : "v"(lo), "v"(hi)); return r; }

template <class Epi, class Sched, bool ALIGN_EPI = false, bool SP2 = false>
__device__ __forceinline__ void gemm_phase(PG8_LAS unsigned char* lds, const Gemm g, const Sched& S, const Epi& E) {
    const int tid = threadIdx.x, wid = __builtin_amdgcn_readfirstlane(tid >> 6), lane = tid & 63, wr = wid >> 2, wc = wid & 3, fr = lane & 15, fq = lane >> 4;
    const int K = g.K, nt = K / BK;
    unsigned voffA[2], voffB[2];
#pragma unroll
    for (int i = 0; i < 2; ++i) { int R, C; stage_rc(tid * 16 + i * 8192, R, C); const int Rb = Epi::PERM ? ((R & ~31) + perm32(R & 31)) : R;
        voffA[i] = (unsigned)(R * g.lda + C) * 2u; voffB[i] = (unsigned)(Rb * g.ldb + C) * 2u; }
    const size_t kstep = (size_t)(BK * 2);
    const size_t hstepA = (size_t)HALF * g.lda * 2, hstepB = (size_t)HALF * g.ldb * 2;
    const size_t tstepA = 2 * hstepA, tstepB = 2 * hstepB;
    const unsigned ldsw = (unsigned)wid * 1024u;
    const int aoff = lds_byte(wr * 64 + fr, fq * 8), boff = lds_byte(wc * 32 + fr, fq * 8);
#define PG8_SA(b, h) (((b) * 2 + (h)) * HTB)
#define PG8_SB(b, h) ((4 + (b) * 2 + (h)) * HTB)
#define PG8_STAGE(bufoff, gbase, voff) do { _Pragma("unroll") for (int _i = 0; _i < 2; ++_i) \
        __builtin_amdgcn_global_load_lds((const unsigned*)((const char*)(gbase) + (voff)[_i]), (PG8_LAS unsigned*)(lds + (bufoff) + ldsw + _i * 8192), 16, 0, 0); } while (0)
#define PG8_LDA(dst, b, h) do { _Pragma("unroll") for (int m = 0; m < 4; ++m) _Pragma("unroll") for (int k = 0; k < 2; ++k) dst[m][k] = *(const PG8_LAS bf16x8*)(lds + PG8_SA(b, h) + aoff + m * 2048 + k * 1024); } while (0)
#define PG8_LDB(dst, b, h) do { _Pragma("unroll") for (int n = 0; n < 2; ++n) _Pragma("unroll") for (int k = 0; k < 2; ++k) dst[n][k] = *(const PG8_LAS bf16x8*)(lds + PG8_SB(b, h) + boff + n * 2048 + k * 1024); } while (0)
#define PG8_MMA(ai, bj, At, Bt) do { __builtin_amdgcn_s_setprio(1); _Pragma("unroll") for (int m = 0; m < 4; ++m) _Pragma("unroll") for (int n = 0; n < 2; ++n) _Pragma("unroll") for (int k = 0; k < 2; ++k) \
        acc[ai][bj][m][n] = __builtin_amdgcn_mfma_f32_16x16x32_bf16(Bt[n][k], At[m][k], acc[ai][bj][m][n], 0, 0, 0); __builtin_amdgcn_s_setprio(0); } while (0)
#define PG8_WAIT_V(n) asm volatile("s_waitcnt vmcnt(" #n ")" ::: "memory")
#define PG8_WAIT_L(n) asm volatile("s_waitcnt lgkmcnt(" #n ")" ::: "memory")
#define PG8_BAR __builtin_amdgcn_s_barrier()
#define PG8_SCHED __builtin_amdgcn_sched_barrier(0)
    Unit cur, nxt; int ui = 0;
    if (!S.next(0, cur)) return;
    f32x4 acc[2][2][4][2];
#pragma unroll
    for (int a = 0; a < 2; ++a)
#pragma unroll
        for (int b = 0; b < 2; ++b)
#pragma unroll
            for (int m = 0; m < 4; ++m)
#pragma unroll
                for (int n = 0; n < 2; ++n) acc[a][b][m][n] = (f32x4){0.f, 0.f, 0.f, 0.f};
    bf16x8 At[4][2], B0[2][2], B1[2][2];
    const char* cA = (const char*)g.A + (size_t)cur.pm * tstepA; const char* cB = (const char*)g.Bt + (size_t)cur.pn * tstepB;
    if constexpr (SP2) {
        PG8_STAGE(PG8_SB(0, 0), cB, voffB); PG8_STAGE(PG8_SB(0, 1), cB + hstepB, voffB); PG8_STAGE(PG8_SA(0, 0), cA, voffA); PG8_STAGE(PG8_SA(0, 1), cA + hstepA, voffA);
        if (wr == 1) PG8_BAR;
        PG8_WAIT_V(2); PG8_BAR;
        PG8_STAGE(PG8_SB(1, 0), cB + kstep, voffB); PG8_STAGE(PG8_SA(1, 0), cA + kstep, voffA); PG8_STAGE(PG8_SB(1, 1), cB + hstepB + kstep, voffB);
        PG8_WAIT_V(6); PG8_BAR;
    } else {
        PG8_STAGE(PG8_SB(0, 0), cB, voffB); PG8_STAGE(PG8_SA(0, 0), cA, voffA); PG8_STAGE(PG8_SB(0, 1), cB + hstepB, voffB); PG8_STAGE(PG8_SA(0, 1), cA + hstepA, voffA);
        if (wr == 1) PG8_BAR;
        PG8_WAIT_V(4); PG8_BAR;
        PG8_STAGE(PG8_SB(1, 0), cB + kstep, voffB); PG8_STAGE(PG8_SA(1, 0), cA + kstep, voffA); PG8_STAGE(PG8_SB(1, 1), cB + hstepB + kstep, voffB);
        PG8_WAIT_V(6); PG8_BAR;
    }
    for (;;) {
        const bool has_next = S.next(ui + 1, nxt);
        const char* nA = has_next ? (const char*)g.A + (size_t)nxt.pm * tstepA : cA; const char* nB = has_next ? (const char*)g.Bt + (size_t)nxt.pn * tstepB : cB;
        for (int t = 0; t < nt; t += 2) {
            const bool last = (t == nt - 2);
            const char* a1 = cA + (size_t)(t + 1) * kstep;
            const char* a2 = last ? nA : cA + (size_t)(t + 2) * kstep; const char* b2 = last ? nB : cB + (size_t)(t + 2) * kstep;
            const char* a3 = a2 + kstep; const char* b3 = b2 + kstep;
            if constexpr (SP2) {
            PG8_LDB(B0, 0, 0); PG8_LDB(B1, 0, 1); PG8_SCHED; PG8_LDA(At, 0, 0); PG8_STAGE(PG8_SA(1, 1), a1 + hstepA, voffA);
            PG8_WAIT_V(8); PG8_WAIT_L(0); PG8_BAR; PG8_MMA(0, 0, At, B0); PG8_MMA(0, 1, At, B1); PG8_BAR; PG8_SCHED;
            PG8_LDA(At, 0, 1); PG8_STAGE(PG8_SB(0, 0), b2, voffB); PG8_STAGE(PG8_SB(0, 1), b2 + hstepB, voffB); PG8_STAGE(PG8_SA(0, 0), a2, voffA);
            PG8_WAIT_V(8); PG8_WAIT_L(0); PG8_BAR; PG8_MMA(1, 0, At, B0); PG8_MMA(1, 1, At, B1); PG8_BAR; PG8_SCHED;
            PG8_LDB(B0, 1, 0); PG8_LDB(B1, 1, 1); PG8_SCHED; PG8_LDA(At, 1, 0); PG8_STAGE(PG8_SA(0, 1), a2 + hstepA, voffA);
            PG8_WAIT_V(8); PG8_WAIT_L(0); PG8_BAR; PG8_MMA(0, 0, At, B0); PG8_MMA(0, 1, At, B1); PG8_BAR; PG8_SCHED;
            PG8_LDA(At, 1, 1); PG8_STAGE(PG8_SB(1, 0), b3, voffB); PG8_STAGE(PG8_SB(1, 1), b3 + hstepB, voffB); PG8_STAGE(PG8_SA(1, 0), a3, voffA);
            PG8_WAIT_V(8); PG8_WAIT_L(0); PG8_BAR; PG8_MMA(1, 0, At, B0); PG8_MMA(1, 1, At, B1); PG8_BAR; PG8_SCHED;
            } else {
            PG8_LDB(B0, 0, 0); PG8_SCHED; PG8_LDA(At, 0, 0); PG8_STAGE(PG8_SA(1, 1), a1 + hstepA, voffA);
            PG8_WAIT_L(8); PG8_BAR; PG8_WAIT_L(0); PG8_MMA(0, 0, At, B0); PG8_BAR; PG8_SCHED;
            PG8_LDB(B1, 0, 1); PG8_STAGE(PG8_SB(0, 0), b2, voffB);
            PG8_BAR; PG8_WAIT_L(0); PG8_MMA(0, 1, At, B1); PG8_BAR;
            PG8_LDA(At, 0, 1); PG8_STAGE(PG8_SA(0, 0), a2, voffA);
            PG8_BAR; PG8_WAIT_L(0); PG8_MMA(1, 0, At, B0); PG8_BAR; PG8_SCHED;
            PG8_STAGE(PG8_SB(0, 1), b2 + hstepB, voffB);
            PG8_WAIT_V(6); PG8_BAR; PG8_MMA(1, 1, At, B1); PG8_BAR;
            PG8_LDB(B0, 1, 0); PG8_SCHED; PG8_LDA(At, 1, 0); PG8_STAGE(PG8_SA(0, 1), a2 + hstepA, voffA);
            PG8_WAIT_L(8); PG8_BAR; PG8_WAIT_L(0); PG8_MMA(0, 0, At, B0); PG8_BAR; PG8_SCHED;
            PG8_LDB(B1, 1, 1); PG8_STAGE(PG8_SB(1, 0), b3, voffB);
            PG8_BAR; PG8_WAIT_L(0); PG8_MMA(0, 1, At, B1); PG8_BAR;
            PG8_LDA(At, 1, 1); PG8_STAGE(PG8_SA(1, 0), a3, voffA);
            PG8_BAR; PG8_WAIT_L(0); PG8_MMA(1, 0, At, B0); PG8_BAR; PG8_SCHED;
            PG8_STAGE(PG8_SB(1, 1), b3 + hstepB, voffB);
            PG8_WAIT_V(6); PG8_BAR; PG8_MMA(1, 1, At, B1); PG8_BAR;
            }
        }
        if constexpr (ALIGN_EPI) { if (wr == 0) PG8_BAR; }
        E(acc, cur, wr, wc, fr, fq);
        if (!has_next) break;
#pragma unroll
        for (int a = 0; a < 2; ++a)
#pragma unroll
            for (int b = 0; b < 2; ++b)
#pragma unroll
                for (int m = 0; m < 4; ++m)
#pragma unroll
                    for (int n = 0; n < 2; ++n) acc[a][b][m][n] = (f32x4){0.f, 0.f, 0.f, 0.f};
        cur = nxt; cA = nA; cB = nB; ++ui;
        if constexpr (ALIGN_EPI) { if (wr == 1) PG8_BAR; }
    }
    PG8_WAIT_V(0);
    if constexpr (!ALIGN_EPI) { if (wr == 0) PG8_BAR; }
    PG8_BAR;
#undef PG8_SA
#undef PG8_SB
#undef PG8_STAGE
#undef PG8_LDA
#undef PG8_LDB
#undef PG8_MMA
#undef PG8_WAIT_V
#undef PG8_WAIT_L
#undef PG8_BAR
#undef PG8_SCHED
}
}

constexpr int NWAVES = 8;
constexpr int BATCH = 8, SEQ = 4096, DM = 1024, MTOK = BATCH * SEQ;
constexpr int DFF = 2816, NGU = 2 * DFF, INC = 2328, NIN = 2560;
constexpr int HD = 64, NBG = 16, NCMP = 255;
constexpr float EPS = 1e-6f;
constexpr int PER_PHASE = 10;
constexpr int N_LAUNCHES = MK_N_LAUNCHES;

constexpr size_t MiB = 1u << 20;
constexpr size_t WS_CTL = 0, CTL_ZERO_BYTES = 1 * MiB;
constexpr size_t WS_WGU1 = 2 * MiB, WS_WD1 = 13 * MiB, WS_WGU2 = 19 * MiB, WS_WD2 = 30 * MiB, WS_WIN = 36 * MiB, WS_WOUT = 41 * MiB, WS_CW1 = 43 * MiB;
constexpr size_t WS_WSB = 45 * MiB, WS_CB1P = 45 * MiB + 512 * 1024;
constexpr size_t WS_SS0 = 46 * MiB, WS_SS1 = 48 * MiB, WS_SS2 = 50 * MiB, WS_SS3 = 52 * MiB, WS_SSV = 54 * MiB;
constexpr size_t WS_XB = 56 * MiB;
constexpr size_t WS_ACT = 120 * MiB;
constexpr size_t WS_Y = 120 * MiB, WS_GVT = 184 * MiB, WS_KCR = 216 * MiB, WS_VCR = 224 * MiB, WS_KS = 232 * MiB, WS_VST = 240 * MiB, WS_KW = 248 * MiB, WS_VWT = 256 * MiB;
constexpr size_t WS_GATES = 264 * MiB, WS_H1 = 268 * MiB, WS_KCMP = 272 * MiB, WS_VCMPT = 272 * MiB + 512 * 1024;
constexpr size_t WS_END = 296 * MiB;
constexpr int CW_BAR = 4096;

constexpr int RING_OFF = 0, RING_BYTES = 131072;
constexpr int LDSCTL_OFF = RING_BYTES, MISC_OFF = LDSCTL_OFF + 320;
constexpr int TB_OFF = LDSCTL_OFF + 1024;
constexpr int TBL_OFF = LDSCTL_OFF + 2048;
constexpr int LDS_BYTES = 147456;

#define GAS __attribute__((address_space(1)))
#define LAS __attribute__((address_space(3)))
typedef unsigned short bf16;
typedef unsigned v4u __attribute__((ext_vector_type(4)));
typedef unsigned v2u __attribute__((ext_vector_type(2)));
typedef float f32x4 __attribute__((ext_vector_type(4)));
typedef GAS unsigned gu32;
#define RLX_AGENT __ATOMIC_RELAXED, __HIP_MEMORY_SCOPE_AGENT
#define LDS_WAIT() asm volatile("s_waitcnt lgkmcnt(0)" ::: "memory")
#define VM_WAIT() asm volatile("s_waitcnt vmcnt(0)" ::: "memory")
__device__ __forceinline__ unsigned f2bf(float f) { unsigned u = __builtin_bit_cast(unsigned, f); return (u + 0x7fffu + ((u >> 16) & 1u)) >> 16; }
__device__ __forceinline__ unsigned pk2(float lo, float hi) { return f2bf(lo) | (f2bf(hi) << 16); }
__device__ __forceinline__ float bf2f(unsigned short b) { return __builtin_bit_cast(float, (unsigned)b << 16); }
__device__ __forceinline__ float wave_sum(float v) {
#pragma unroll
    for (int o = 1; o < 64; o <<= 1) v += __shfl_xor(v, o);
    return v;
}
__device__ __forceinline__ float wave_max(float v) {
#pragma unroll
    for (int o = 1; o < 64; o <<= 1) v = fmaxf(v, __shfl_xor(v, o));
    return v;
}
__device__ __forceinline__ float gelu_tanh(float x) { const float u2 = 1.5957691216057308f * (x + 0.044715f * x * x * x); return x / (1.f + __expf(-u2)); }
__device__ __forceinline__ float sigmoidf_(float x) { return 1.f / (1.f + __expf(-x)); }

#define XB_TMO      128
#define XB_XCNT(j)  (256  + 64 * (j))
#define XB_XSUB(j)  (1280 + 64 * (j))
#define XB_XGEN(j)  (2304 + 64 * (j))
#define XB_TOP      3328
#define XB_TOPGEN   3392
#define XCD_BAR_WORDS 3456
#define XB_SPIN_CAP (1u << 22)
__device__ __forceinline__ unsigned xb_ld(unsigned* p)              { return __hip_atomic_load(p, __ATOMIC_RELAXED, __HIP_MEMORY_SCOPE_AGENT); }
__device__ __forceinline__ unsigned xb_add(unsigned* p, unsigned v) { return __hip_atomic_fetch_add(p, v, __ATOMIC_RELAXED, __HIP_MEMORY_SCOPE_AGENT); }
__device__ __forceinline__ unsigned xb_xcc_id() { return (unsigned)__builtin_amdgcn_s_getreg((3 << 11) | 20) & 0xFu; }
#define XB_SPIN(cond, bar) do { unsigned _sp = 0; while (cond) { __builtin_amdgcn_s_sleep(1); \
    if ((++_sp & 255u) == 0u) { if (xb_ld(&(bar)[XB_TMO])) break; if (_sp > XB_SPIN_CAP) { atomicAdd(&(bar)[XB_TMO], 1u); break; } } } } while (0)
struct XcdBarrier { unsigned* bar; unsigned x; volatile LAS unsigned* st; };
__device__ __forceinline__ XcdBarrier xcd_barrier_post(unsigned* bar, volatile LAS unsigned* st) {
    XcdBarrier b; b.bar = bar; b.x = xb_xcc_id(); b.st = st;
    if (threadIdx.x == 0) (void)xb_add(&bar[XB_XCNT(b.x)], 1u);
    return b;
}
__device__ __forceinline__ void xcd_barrier_complete(unsigned* bar, unsigned x, unsigned& nloc, unsigned& nx) {
    const unsigned G = gridDim.x * gridDim.y * gridDim.z;
    unsigned sum, cnt, mine, sp = 0u;
    for (;;) {
        sum = 0u; cnt = 0u; mine = 0u;
#pragma unroll
        for (unsigned j = 0; j < 16; ++j) { const unsigned c = xb_ld(&bar[XB_XCNT(j)]); sum += c; cnt += (c > 0u) ? 1u : 0u; mine = (j == x) ? c : mine; }
        if (sum == G) break;
        __builtin_amdgcn_s_sleep(1);
        if ((++sp & 255u) == 0u) { if (xb_ld(&bar[XB_TMO])) break; if (sp > XB_SPIN_CAP) { atomicAdd(&bar[XB_TMO], 1u); break; } }
    }
    nloc = mine > 0u ? mine : 1u; nx = cnt > 0u ? cnt : 1u;
}
__device__ __forceinline__ void xcd_barrier(const XcdBarrier& b) {
    asm volatile("s_waitcnt vmcnt(0)" ::: "memory");
    __syncthreads();
    if (threadIdx.x == 0) {
        unsigned* bar = b.bar;
        __builtin_amdgcn_s_waitcnt(0);
        unsigned nloc = b.st[0], nx = b.st[1];
        if (nloc == 0u) { xcd_barrier_complete(bar, b.x, nloc, nx); b.st[0] = nloc; b.st[1] = nx; }
        const unsigned old = xb_add(&bar[XB_XSUB(b.x)], 1u);
        const unsigned gen = old / nloc;
        if (old + 1u == (gen + 1u) * nloc) {
            __builtin_amdgcn_fence(__ATOMIC_RELEASE, "agent");
            asm volatile("s_waitcnt vmcnt(0)" ::: "memory");
            const unsigned og = xb_add(&bar[XB_TOP], 1u);
            const unsigned tg = og / nx;
            if (og + 1u == (tg + 1u) * nx) xb_add(&bar[XB_TOPGEN], 1u);
            else XB_SPIN(xb_ld(&bar[XB_TOPGEN]) == tg, bar);
            __builtin_amdgcn_fence(__ATOMIC_ACQUIRE, "agent");
            xb_add(&bar[XB_XGEN(b.x)], 1u);
            asm volatile("s_waitcnt vmcnt(0)" ::: "memory");
        } else {
            XB_SPIN(xb_ld(&bar[XB_XGEN(b.x)]) == gen, bar);
            __builtin_amdgcn_fence(__ATOMIC_ACQUIRE, "agent");
            asm volatile("s_waitcnt vmcnt(0)" ::: "memory");
        }
    }
    __syncthreads();
}

__device__ __forceinline__ float row_rinv(const float* ss, int row, int fq) {
    const f32x4 p = *(const f32x4*)(ss + (size_t)row * 16 + 4 * fq);
    float s = (p[0] + p[1]) + (p[2] + p[3]);
    s += __shfl_xor(s, 16); s += __shfl_xor(s, 32);
    return __builtin_amdgcn_rsqf(s * (1.f / DM) + EPS);
}
__device__ __forceinline__ float rsq_acc(float s, float invn) { return 1.0f / sqrtf(s * invn + EPS); }

struct EpiSwiGLU {
    static constexpr bool PERM = true;
    const float* ss; bf16* act;
    __device__ __forceinline__ void operator()(const f32x4 (&acc)[2][2][4][2], const pg8::Unit& u, int wr, int wc, int fr, int fq) const {
#pragma unroll
        for (int ai = 0; ai < 2; ++ai)
#pragma unroll
            for (int m = 0; m < 4; ++m) {
                const int row = u.pm * 256 + ai * 128 + wr * 64 + m * 16 + fr;
                const float ri = row_rinv(ss, row, fq);
                float o[8];
#pragma unroll
                for (int n = 0; n < 2; ++n)
#pragma unroll
                    for (int i = 0; i < 4; ++i) { const float g = acc[ai][0][m][n][i] * ri, up = acc[ai][1][m][n][i] * ri; o[n * 4 + i] = g * sigmoidf_(g) * up; }
                v4u w; w.x = pk2(o[0], o[1]); w.y = pk2(o[2], o[3]); w.z = pk2(o[4], o[5]); w.w = pk2(o[6], o[7]);
                *(v4u*)(act + (size_t)row * DFF + u.pn * 128 + wc * 32 + fq * 8) = w;
            }
    }
};
struct EpiResid {
    static constexpr bool PERM = false;
    const float* base; float* out; bf16* xb; float* ssp; float scale;
    __device__ __forceinline__ void operator()(const f32x4 (&acc)[2][2][4][2], const pg8::Unit& u, int wr, int wc, int fr, int fq) const {
#pragma unroll
        for (int ai = 0; ai < 2; ++ai)
#pragma unroll
            for (int m = 0; m < 4; ++m) {
                const int row = u.pm * 256 + ai * 128 + wr * 64 + m * 16 + fr;
                float sq = 0.f;
#pragma unroll
                for (int bj = 0; bj < 2; ++bj)
#pragma unroll
                    for (int n = 0; n < 2; ++n) {
                        const size_t off = (size_t)row * DM + u.pn * 256 + bj * 128 + wc * 32 + n * 16 + fq * 4;
                        const f32x4 b = *(const f32x4*)(base + off);
                        const f32x4 o = b + acc[ai][bj][m][n] * scale;
                        *(f32x4*)(out + off) = o;
                        if (xb) { v2u w; w.x = pk2(o[0], o[1]); w.y = pk2(o[2], o[3]); *(v2u*)(xb + off) = w; }
                        sq += (o[0] * o[0] + o[1] * o[1]) + (o[2] * o[2] + o[3] * o[3]);
                    }
                sq += __shfl_xor(sq, 16); sq += __shfl_xor(sq, 32);
                if (fq == 0) ssp[(size_t)row * 16 + u.pn * 4 + wc] = sq;
            }
    }
};
struct EpiMix {
    static constexpr bool PERM = true;
    const float* ss; bf16* Y; bf16* GVT; float* SSV; bf16* KCR; bf16* VCR; bf16* KS; bf16* VST; bf16* KW; bf16* VWT; float* GATES;
    const float* qg; const float* kg;
    __device__ __forceinline__ void operator()(const f32x4 (&acc)[2][2][4][2], const pg8::Unit& u, int wr, int wc, int fr, int fq) const {
        const int pn = u.pn;
        float gn[2][2][4];
        const float* gsrc = nullptr;
        if (pn == 4 || pn == 5) gsrc = qg; else if (pn == 7 && wc < 2) gsrc = kg + 64; else if (pn == 8 && wc < 2) gsrc = kg + 128;
#pragma unroll
        for (int bj = 0; bj < 2; ++bj)
#pragma unroll
            for (int n = 0; n < 2; ++n)
#pragma unroll
                for (int i = 0; i < 4; ++i) gn[bj][n][i] = gsrc ? gsrc[32 * bj + 8 * fq + 4 * n + i] : 1.f;
#pragma unroll
        for (int ai = 0; ai < 2; ++ai)
#pragma unroll
            for (int m = 0; m < 4; ++m) {
                const int row = u.pm * 256 + ai * 128 + wr * 64 + m * 16 + fr;
                const int b = row >> 12, t = row & 4095;
                const float ri = row_rinv(ss, row, fq);
                float v[2][2][4];
#pragma unroll
                for (int bj = 0; bj < 2; ++bj)
#pragma unroll
                    for (int n = 0; n < 2; ++n)
#pragma unroll
                        for (int i = 0; i < 4; ++i) v[bj][n][i] = acc[ai][bj][m][n][i] * ri;
                if (pn < 4) {
                    float sq = 0.f;
#pragma unroll
                    for (int bj = 0; bj < 2; ++bj)
#pragma unroll
                        for (int n = 0; n < 2; ++n)
#pragma unroll
                            for (int i = 0; i < 4; ++i) { const float x = gelu_tanh(v[bj][n][i]); v[bj][n][i] = x; sq += x * x; }
                    if (pn < 2) {
#pragma unroll
                        for (int bj = 0; bj < 2; ++bj) { v4u w; w.x = pk2(v[bj][0][0], v[bj][0][1]); w.y = pk2(v[bj][0][2], v[bj][0][3]); w.z = pk2(v[bj][1][0], v[bj][1][1]); w.w = pk2(v[bj][1][2], v[bj][1][3]);
                            *(v4u*)(Y + (size_t)row * DM + pn * 256 + wc * 64 + bj * 32 + fq * 8) = w; }
                    } else {
                        const int h = (pn - 2) * 4 + wc;
                        bf16* dst = GVT + ((size_t)(b * 8 + h) * 64) * SEQ + t;
#pragma unroll
                        for (int bj = 0; bj < 2; ++bj)
#pragma unroll
                            for (int n = 0; n < 2; ++n)
#pragma unroll
                                for (int i = 0; i < 4; ++i) dst[(size_t)(32 * bj + 8 * fq + 4 * n + i) * SEQ] = (bf16)f2bf(v[bj][n][i]);
                        sq += __shfl_xor(sq, 16); sq += __shfl_xor(sq, 32);
                        if (fq == 0) SSV[(size_t)row * 8 + (pn - 2) * 4 + wc] = sq;
                    }
                } else if (pn < 9) {
                    const bool is_q = (pn == 4 || pn == 5);
                    const bool is_k = (wc < 2);
                    const bool normed = is_q || ((pn == 7 || pn == 8) && is_k);
                    if (normed) {
                        float sq = 0.f;
#pragma unroll
                        for (int bj = 0; bj < 2; ++bj)
#pragma unroll
                            for (int n = 0; n < 2; ++n)
#pragma unroll
                                for (int i = 0; i < 4; ++i) sq += v[bj][n][i] * v[bj][n][i];
                        sq += __shfl_xor(sq, 16); sq += __shfl_xor(sq, 32);
                        const float rh = rsq_acc(sq, 1.f / 64.f) * (is_q ? 0.125f * 1.4426950408889634f : 1.f);
#pragma unroll
                        for (int bj = 0; bj < 2; ++bj)
#pragma unroll
                            for (int n = 0; n < 2; ++n)
#pragma unroll
                                for (int i = 0; i < 4; ++i) v[bj][n][i] *= rh * gn[bj][n][i];
                    }
                    if (is_q || is_k) {
                        bf16* dst;
                        if (is_q) dst = Y + (size_t)row * DM + 512 + (pn - 4) * 256 + wc * 64;
                        else { bf16* kb = (pn == 6) ? KCR : (pn == 7) ? KS : KW; dst = kb + ((size_t)(b * 2 + wc) * SEQ + t) * 64; }
#pragma unroll
                        for (int bj = 0; bj < 2; ++bj) { v4u w; w.x = pk2(v[bj][0][0], v[bj][0][1]); w.y = pk2(v[bj][0][2], v[bj][0][3]); w.z = pk2(v[bj][1][0], v[bj][1][1]); w.w = pk2(v[bj][1][2], v[bj][1][3]);
                            *(v4u*)(dst + bj * 32 + fq * 8) = w; }
                    } else if (pn == 6) {
                        bf16* dst = VCR + ((size_t)(b * 2 + (wc - 2)) * SEQ + t) * 64;
#pragma unroll
                        for (int bj = 0; bj < 2; ++bj) { v4u w; w.x = pk2(v[bj][0][0], v[bj][0][1]); w.y = pk2(v[bj][0][2], v[bj][0][3]); w.z = pk2(v[bj][1][0], v[bj][1][1]); w.w = pk2(v[bj][1][2], v[bj][1][3]);
                            *(v4u*)(dst + bj * 32 + fq * 8) = w; }
                    } else {
                        bf16* vb = (pn == 7) ? VST : VWT;
                        bf16* dst = vb + ((size_t)(b * 2 + (wc - 2)) * 64) * SEQ + t;
#pragma unroll
                        for (int bj = 0; bj < 2; ++bj)
#pragma unroll
                            for (int n = 0; n < 2; ++n)
#pragma unroll
                                for (int i = 0; i < 4; ++i) dst[(size_t)(32 * bj + 8 * fq + 4 * n + i) * SEQ] = (bf16)f2bf(v[bj][n][i]);
                    }
                } else {
                    if (wc == 0 && fq < 3) {
                        f32x4 g0, g1;
#pragma unroll
                        for (int i = 0; i < 4; ++i) { g0[i] = sigmoidf_(v[0][0][i]); g1[i] = sigmoidf_(v[0][1][i]); }
                        *(f32x4*)(GATES + (size_t)row * 24 + fq * 8) = g0; *(f32x4*)(GATES + (size_t)row * 24 + fq * 8 + 4) = g1;
                    }
                }
            }
    }
};
struct EpiCmp {
    static constexpr bool PERM = true;
    const float* cb1p; bf16* H1;
    __device__ __forceinline__ void operator()(const f32x4 (&acc)[2][2][4][2], const pg8::Unit& u, int wr, int wc, int fr, int fq) const {
        float bias[2][2][4];
#pragma unroll
        for (int bj = 0; bj < 2; ++bj)
#pragma unroll
            for (int n = 0; n < 2; ++n)
#pragma unroll
                for (int i = 0; i < 4; ++i) { const int col = u.pn * 256 + bj * 128 + wc * 32 + fq * 8 + n * 4 + i; float s = 0.f;
#pragma unroll
                    for (int p = 0; p < 8; ++p) s += cb1p[p * 512 + col];
                    bias[bj][n][i] = s; }
#pragma unroll
        for (int ai = 0; ai < 2; ++ai)
#pragma unroll
            for (int m = 0; m < 4; ++m) {
                const int row = u.pm * 256 + ai * 128 + wr * 64 + m * 16 + fr;
#pragma unroll
                for (int bj = 0; bj < 2; ++bj) { float o[8];
#pragma unroll
                    for (int n = 0; n < 2; ++n)
#pragma unroll
                        for (int i = 0; i < 4; ++i) o[n * 4 + i] = gelu_tanh(acc[ai][bj][m][n][i] + bias[bj][n][i]);
                    v4u w; w.x = pk2(o[0], o[1]); w.y = pk2(o[2], o[3]); w.z = pk2(o[4], o[5]); w.w = pk2(o[6], o[7]);
                    *(v4u*)(H1 + (size_t)row * 256 + bj * 128 + wc * 32 + fq * 8) = w; }
            }
    }
};

struct Frame {
    LAS unsigned char* lds; volatile LAS unsigned* MISC; gu32* ctl;
    int tid, lane, wave, vcu, G;
};
struct Args { const float* in[24]; float* out; unsigned char* ws; int ph_lo, ph_hi, li, pad; };

__device__ __forceinline__ void p0_tr_item(const float* W, int ldw, int K, const float* gain, bf16* WT, int n0d, int sc0, int nvalid, int kb, LAS float* scr, int lane) {
    const int k0 = 64 * kb;
#pragma unroll 8
    for (int i = 0; i < 32; ++i) { const int kk = 2 * i + (lane >> 5), c = lane & 31;
        float x = 0.f; if (c < nvalid) { x = W[(size_t)(k0 + kk) * ldw + sc0 + c]; if (gain) x *= gain[k0 + kk]; }
        scr[kk * 33 + c] = x; }
    LDS_WAIT(); asm volatile("" ::: "memory");
    const int c = lane & 7;
#pragma unroll
    for (int j = 0; j < 4; ++j) { const int n = (lane >> 3) + 8 * j; const LAS float* s = scr + (8 * c) * 33 + n;
        v4u o; o.x = pk2(s[0 * 33], s[1 * 33]); o.y = pk2(s[2 * 33], s[3 * 33]); o.z = pk2(s[4 * 33], s[5 * 33]); o.w = pk2(s[6 * 33], s[7 * 33]);
        *(GAS v4u*)(WT + (size_t)(n0d + n) * K + k0 + 8 * c) = o; }
    LDS_WAIT(); asm volatile("" ::: "memory");
}

__device__ __forceinline__ void p0_prologue(Frame& F, const Args& A) {
    unsigned char* ws = A.ws;
    LAS float* scr = (LAS float*)(F.lds + RING_OFF + F.wave * 16384);
    const int gw = F.vcu * NWAVES + F.wave, NGW = F.G * NWAVES, lane = F.lane;
    constexpr int I_GU = (DM / 64) * (NGU / 32), I_D = (DFF / 64) * (DM / 32), I_IN = (DM / 64) * (NIN / 32), I_OUT = (DM / 64) * (DM / 32), I_C1 = 2 * (2048 / 64) * (256 / 32);
    constexpr int I_WS = 8 * 128 * 128 / 64 / 8;
    constexpr int I_CB = 64;
    constexpr int NITEMS = 2 * I_GU + 2 * I_D + I_IN + I_OUT + I_C1 + I_WS + I_CB;
    for (int it = gw; it < NITEMS; it += NGW) {
        int r = it;
        if (r < 2 * I_GU) {
            const int f = r / I_GU; r -= f * I_GU; const int nblk = NGU / 32, kb = r / nblk, nb = r % nblk, n0 = 32 * nb, pn = n0 >> 8, bj = (n0 >> 7) & 1, j = n0 & 127;
            const float* W = f ? (bj ? A.in[21] : A.in[20]) : (bj ? A.in[3] : A.in[2]);
            p0_tr_item(W, DFF, DM, f ? A.in[19] : A.in[1], (bf16*)(ws + (f ? WS_WGU2 : WS_WGU1)), n0, 128 * pn + j, 32, kb, scr, lane); continue; }
        r -= 2 * I_GU;
        if (r < 2 * I_D) {
            const int f = r / I_D; r -= f * I_D; const int nblk = DM / 32, kb = r / nblk, nb = r % nblk;
            p0_tr_item(f ? A.in[22] : A.in[4], DM, DFF, nullptr, (bf16*)(ws + (f ? WS_WD2 : WS_WD1)), 32 * nb, 32 * nb, 32, kb, scr, lane); continue; }
        r -= 2 * I_D;
        if (r < I_IN) {
            const int nblk = NIN / 32, kb = r / nblk, nb = r % nblk, n0 = 32 * nb, pn = n0 >> 8, tc = n0 & 255;
            const int col = 256 * pn + 64 * ((tc >> 5) & 3) + 32 * (tc >> 7);
            int nv = INC - col; nv = nv < 0 ? 0 : (nv > 32 ? 32 : nv);
            p0_tr_item(A.in[6], INC, DM, A.in[5], (bf16*)(ws + WS_WIN), n0, col, nv, kb, scr, lane); continue; }
        r -= I_IN;
        if (r < I_OUT) { const int nblk = DM / 32, kb = r / nblk, nb = r % nblk;
            p0_tr_item(A.in[18], DM, DM, nullptr, (bf16*)(ws + WS_WOUT), 32 * nb, 32 * nb, 32, kb, scr, lane); continue; }
        r -= I_OUT;
        if (r < I_C1) { const int kv = r / (I_C1 / 2); r -= kv * (I_C1 / 2); const int nblk = 256 / 32, kb = r / nblk, nb = r % nblk;
            p0_tr_item(A.in[13] + (size_t)kv * 2048 * 256, 256, 2048, nullptr, (bf16*)(ws + WS_CW1) + (size_t)kv * 256 * 2048, 32 * nb, 32 * nb, 32, kb, scr, lane); continue; }
        r -= I_C1;
        if (r < I_WS) {
            const int e0 = (r * 64 + lane) * 8; const int s0 = e0 & 127, t = (e0 >> 7) & 127;
            const float* src = A.in[8] + e0; unsigned o[4];
#pragma unroll
            for (int i = 0; i < 4; ++i) { const float a = (s0 + 2 * i <= t) ? src[2 * i] : 0.f, b2 = (s0 + 2 * i + 1 <= t) ? src[2 * i + 1] : 0.f; o[i] = pk2(a, b2); }
            *(v4u*)((bf16*)(ws + WS_WSB) + e0) = (v4u){o[0], o[1], o[2], o[3]}; continue; }
        r -= I_WS;
        {
            const int kp = r & 7, jb = (r >> 3) & 3, kv = r >> 5, j = jb * 64 + lane;
            const float* pe = A.in[12] + (size_t)kv * 2048; const float* w1 = A.in[13] + (size_t)kv * 2048 * 256;
            float s = (kp == 0) ? A.in[14][kv * 256 + j] : 0.f;
            for (int k = kp * 256; k < kp * 256 + 256; ++k) s += pe[k] * w1[(size_t)k * 256 + j];
            ((float*)(ws + WS_CB1P))[kp * 512 + kv * 256 + j] = s;
        }
    }
    const float* x = A.in[0]; bf16* XB = (bf16*)(ws + WS_XB); float* SS0 = (float*)(ws + WS_SS0);
    for (int m = gw; m < MTOK; m += NGW) {
        const GAS f32x4* xr = (const GAS f32x4*)(x + (size_t)m * DM) + lane;
        GAS unsigned long long* o8 = (GAS unsigned long long*)(XB + (size_t)m * DM) + lane;
        float s = 0.f;
#pragma unroll
        for (int j = 0; j < 4; ++j) { const f32x4 v = xr[64 * j]; s += (v.x * v.x + v.y * v.y) + (v.z * v.z + v.w * v.w);
            o8[64 * j] = (unsigned long long)pk2(v.x, v.y) | ((unsigned long long)pk2(v.z, v.w) << 32); }
        s = wave_sum(s);
        if (lane < 16) SS0[(size_t)m * 16 + lane] = (lane == 0) ? s : 0.f;
    }
}

__device__ __forceinline__ void gmlp_unit_simple(Frame& F, const Args& A, int unit) {
    unsigned char* ws = A.ws;
    const int b = unit >> 5, c = unit & 31, r0 = b * SEQ + c * 128;
    LAS float* rv = (LAS float*)(F.lds + RING_OFF);
    const float* SSV = (const float*)(ws + WS_SSV);
    if (F.tid < 128) { float s = 0.f;
#pragma unroll
        for (int p = 0; p < 8; ++p) s += SSV[(size_t)(r0 + F.tid) * 8 + p];
        rv[F.tid] = rsq_acc(s, 1.f / 512.f); }
    __syncthreads();
    const bf16* GVT = (const bf16*)(ws + WS_GVT); const bf16* WSB = (const bf16*)(ws + WS_WSB); bf16* Y = (bf16*)(ws + WS_Y);
    const float* gvn = A.in[7]; const float* bs = A.in[9];
    for (int idx = F.tid; idx < 128 * 512; idx += 512) {
        const int tl = idx & 127, hd = idx >> 7, h = hd >> 6, d = hd & 63;
        const bf16* gv = GVT + ((size_t)(b * 8 + h) * 64 + d) * SEQ + c * 128; const bf16* w = WSB + (size_t)(h * 128 + tl) * 128;
        float a = 0.f;
        for (int s = 0; s <= tl; ++s) a += bf2f(w[s]) * bf2f(gv[s]) * rv[s];
        const float sv = a * gvn[h * 64 + d] + bs[h * 128 + tl];
        const size_t yi = (size_t)(r0 + tl) * DM + hd;
        Y[yi] = (bf16)f2bf(bf2f(Y[yi]) * sv);
    }
    __syncthreads();
}
__device__ __forceinline__ void cmp2_unit_simple(Frame& F, const Args& A, int pm) {
    unsigned char* ws = A.ws;
    __threadfence(); __syncthreads();
    const int kv = pm >> 4;
    const bf16* H1 = (const bf16*)(ws + WS_H1);
    const float* w2 = A.in[15] + (size_t)kv * 256 * 64; const float* b2 = A.in[16] + kv * 64; const float* kg0 = A.in[11];
    bf16* KCMP = (bf16*)(ws + WS_KCMP); bf16* VCMPT = (bf16*)(ws + WS_VCMPT);
    const int d = F.lane;
    for (int rr = F.wave; rr < 256; rr += NWAVES) {
        const int row = pm * 256 + rr;
        float a = b2[d];
        for (int j = 0; j < 256; ++j) a += bf2f(H1[(size_t)row * 256 + j]) * w2[j * 64 + d];
        const int n = row & 255, bg = (row & 4095) >> 8;
        if (kv == 0) { const float ssq = wave_sum(a * a); a = a * rsq_acc(ssq, 1.f / 64.f) * kg0[d]; KCMP[((size_t)bg * 256 + n) * 64 + d] = (bf16)f2bf(a); }
        else VCMPT[((size_t)bg * 64 + d) * 256 + n] = (bf16)f2bf(a);
    }
}

namespace att {
typedef short bf16x8 __attribute__((ext_vector_type(8)));
typedef short s16x4 __attribute__((ext_vector_type(4)));
typedef float f32x16 __attribute__((ext_vector_type(16)));
typedef float f32x2_t __attribute__((ext_vector_type(2))); typedef __bf16 bf16x2_t __attribute__((ext_vector_type(2)));
constexpr int KROW = 144, VROW = 136, KBUF = 64 * KROW, VBUF = 64 * VROW;
constexpr int OFF_K = 0, OFF_V = 2 * KBUF, OFF_IMP = 36864, OFF_MSK = OFF_IMP + 8 * 2048, ATT_LDS = OFF_MSK + 512;
constexpr float NEGBIG = -30000.f;
__device__ __forceinline__ unsigned cvtpk(float lo, float hi) { f32x2_t v = {lo, hi}; bf16x2_t b = __builtin_convertvector(v, bf16x2_t); return __builtin_bit_cast(unsigned, b); }
__device__ __forceinline__ int crow(int r, int hi) { return (r & 3) + 8 * (r >> 2) + 4 * hi; }
__device__ __forceinline__ float xhalf(float x) { return __shfl_xor(x, 32); }
template <bool NEAR, bool CMP>
__device__ __forceinline__ void tile(const LAS unsigned char* Kb, const LAS unsigned char* Vb, const bf16x8 (&qf)[4], float cinit, bool rowsel, int t, int key0, int dmax,
                                     const LAS float* tblh, f32x16 (&O)[2], float& l, float (&u)[2][4], float& carry, int r, int hh) {
    f32x16 S[2];
#pragma unroll
    for (int a = 0; a < 2; ++a) {
#pragma unroll
        for (int i = 0; i < 16; ++i) S[a][i] = cinit;
#pragma unroll
        for (int kk = 0; kk < 4; ++kk) { const bf16x8 kf = *(const LAS bf16x8*)(Kb + (32 * a + r) * KROW + (2 * kk + hh) * 16);
            S[a] = __builtin_amdgcn_mfma_f32_32x32x16_bf16(kf, qf[kk], S[a], 0, 0, 0); }
    }
    float ls = 0.f;
#pragma unroll
    for (int a = 0; a < 2; ++a) {
#pragma unroll
        for (int i = 0; i < 16; ++i) {
            float pz;
            if (NEAR) { const int key = key0 + 32 * a + crow(i, hh); const int pos = CMP ? 16 * key + 31 : key; const int dist = t - pos;
                const bool valid = rowsel && dist >= 0 && dist <= dmax; int idx = dist < 0 ? 0 : (dist > 128 ? 128 : dist);
                pz = __builtin_amdgcn_exp2f(S[a][i] + tblh[idx]); pz = valid ? pz : 0.f; }
            else pz = __builtin_amdgcn_exp2f(S[a][i]);
            S[a][i] = pz; ls += pz;
        }
        if (CMP) {
            float e3[4], rq[4];
#pragma unroll
            for (int q = 0; q < 4; ++q) { e3[q] = S[a][4 * q + 3]; rq[q] = xhalf(e3[q]); }
#pragma unroll
            for (int q = 0; q < 4; ++q) { const float own = (S[a][4 * q] + S[a][4 * q + 1]) + (S[a][4 * q + 2] + S[a][4 * q + 3]);
                const float prev = hh ? rq[q] : (q > 0 ? rq[q - 1] : carry); u[a][q] = own + prev; }
            carry = rq[3];
        }
    }
    l += ls;
    bf16x8 pf[2][2];
#pragma unroll
    for (int a = 0; a < 2; ++a)
#pragma unroll
        for (int s2 = 0; s2 < 2; ++s2) { unsigned w0 = cvtpk(S[a][8 * s2 + 0], S[a][8 * s2 + 1]), w1 = cvtpk(S[a][8 * s2 + 2], S[a][8 * s2 + 3]), w2 = cvtpk(S[a][8 * s2 + 4], S[a][8 * s2 + 5]), w3 = cvtpk(S[a][8 * s2 + 6], S[a][8 * s2 + 7]);
            v4u w = {w0, w1, w2, w3}; pf[a][s2] = __builtin_bit_cast(bf16x8, w); }
#pragma unroll
    for (int dt = 0; dt < 2; ++dt)
#pragma unroll
        for (int a = 0; a < 2; ++a)
#pragma unroll
            for (int s2 = 0; s2 < 2; ++s2) { const LAS unsigned char* vp = Vb + (32 * dt + r) * VROW + (32 * a + 16 * s2 + 4 * hh) * 2;
                const s16x4 lo = *(const LAS s16x4*)vp, hi = *(const LAS s16x4*)(vp + 16);
                const bf16x8 vf = {lo[0], lo[1], lo[2], lo[3], hi[0], hi[1], hi[2], hi[3]};
                O[dt] = __builtin_amdgcn_mfma_f32_32x32x16_bf16(vf, pf[a][s2], O[dt], 0, 0, 0); }
}
}

__device__ __forceinline__ void attn_unit(Frame& F, const Args& A, int bg, int c) {
    using namespace att;
    unsigned char* ws = A.ws;
    const int tid = F.tid, lane = F.lane, w = F.wave, r = lane & 31, hh = lane >> 5, hg = r >> 3, qi = r & 7;
    const int b = bg >> 1, g = bg & 1, h = g * 4 + hg;
    const int t = 64 * c + 8 * w + qi; const size_t tok = (size_t)b * SEQ + t;
    LAS unsigned char* L = F.lds + RING_OFF;
    const LAS float* tblh = (const LAS float*)(F.lds + TBL_OFF) + h * 132;
    bf16* Y = (bf16*)(ws + WS_Y);
    bf16* yrow = Y + tok * DM + 512 + h * 64;
    bf16x8 qf[4];
#pragma unroll
    for (int kk = 0; kk < 4; ++kk) qf[kk] = *(const bf16x8*)(yrow + 16 * kk + 8 * hh);
    const float c31 = tblh[128];
    const float* gt = (const float*)(ws + WS_GATES) + tok * 24;
    const float g0 = gt[h], g1 = gt[8 + h], g2 = gt[16 + h];
    const int nc = (c >> 4) + 1, ns = c + 1, w0 = c > 8 ? c - 8 : 0, nw = c - w0 + 1, ntile = nc + ns + nw;
    const int srow = tid >> 3, sch = tid & 7;
    v4u kreg, vreg;
#define ATT_GLOAD(i) do { const int i_ = (i); const bf16* kp_; const bf16* vp_; size_t ldv_; \
        if (i_ < nc) { kp_ = (const bf16*)(ws + WS_KCMP) + ((size_t)bg * 256 + 64 * i_) * 64; vp_ = (const bf16*)(ws + WS_VCMPT) + (size_t)bg * 64 * 256 + 64 * i_; ldv_ = 256; } \
        else if (i_ < nc + ns) { const int j_ = i_ - nc; kp_ = (const bf16*)(ws + WS_KS) + ((size_t)bg * SEQ + 64 * j_) * 64; vp_ = (const bf16*)(ws + WS_VST) + (size_t)bg * 64 * SEQ + 64 * j_; ldv_ = SEQ; } \
        else { const int j_ = w0 + i_ - nc - ns; kp_ = (const bf16*)(ws + WS_KW) + ((size_t)bg * SEQ + 64 * j_) * 64; vp_ = (const bf16*)(ws + WS_VWT) + (size_t)bg * 64 * SEQ + 64 * j_; ldv_ = SEQ; } \
        kreg = *(const v4u*)(kp_ + srow * 64 + sch * 8); vreg = *(const v4u*)(vp_ + (size_t)srow * ldv_ + sch * 8); } while (0)
#define ATT_SWRITE(buf) do { *(LAS v4u*)(L + OFF_K + (buf) * KBUF + srow * KROW + sch * 16) = kreg; \
        LAS unsigned char* vd_ = L + OFF_V + (buf) * VBUF + srow * VROW + sch * 16; *(LAS v2u*)vd_ = (v2u){vreg.x, vreg.y}; *(LAS v2u*)(vd_ + 8) = (v2u){vreg.z, vreg.w}; } while (0)
#define ATT_NEXT(i) do { if ((i) + 1 < ntile) ATT_GLOAD((i) + 1); } while (0)
#define ATT_FLIP(i) do { if ((i) + 1 < ntile) ATT_SWRITE(((i) + 1) & 1); __syncthreads(); } while (0)
    ATT_GLOAD(0); ATT_SWRITE(0); __syncthreads();
    f32x16 out[2], O[2];
#pragma unroll
    for (int i = 0; i < 16; ++i) { out[0][i] = 0.f; out[1][i] = 0.f; O[0][i] = 0.f; O[1][i] = 0.f; }
    float l = 0.f, carry = 0.f, dummy_u[2][4];
    int it = 0;
    float u[4][2][4];
#pragma unroll
    for (int i = 0; i < 4; ++i)
#pragma unroll
        for (int a = 0; a < 2; ++a)
#pragma unroll
            for (int q = 0; q < 4; ++q) u[i][a][q] = 0.f;
#pragma unroll
    for (int i = 0; i < 4; ++i) {
        if (i < nc) {
            ATT_NEXT(it);
            const LAS unsigned char* Kb = L + OFF_K + (it & 1) * KBUF; const LAS unsigned char* Vb = L + OFF_V + (it & 1) * VBUF;
            const bool far = 64 * c >= 1024 * i + 1167;
            if (far) tile<false, true>(Kb, Vb, qf, c31, true, t, 64 * i, 1 << 30, tblh, O, l, u[i], carry, r, hh);
            else tile<true, true>(Kb, Vb, qf, 0.f, true, t, 64 * i, 1 << 30, tblh, O, l, u[i], carry, r, hh);
            ATT_FLIP(it); ++it;
        }
    }
    unsigned long long mask;
    {
        const float lt = l + xhalf(l); const float linv = lt > 0.f ? 1.f / lt : 0.f; const float sc = g0 * linv;
#pragma unroll
        for (int i = 0; i < 16; ++i) { out[0][i] += sc * O[0][i]; out[1][i] += sc * O[1][i]; O[0][i] = 0.f; O[1][i] = 0.f; }
        LAS float* impw = (LAS float*)(L + OFF_IMP + w * 2048);
#pragma unroll
        for (int i = 0; i < 4; ++i)
#pragma unroll
            for (int a = 0; a < 2; ++a)
#pragma unroll
                for (int q = 0; q < 4; ++q) {
                    float x = u[i][a][q] * linv; x += __shfl_xor(x, 8); x += __shfl_xor(x, 16);
                    const int j = 8 * (2 * i + a) + 2 * q + hh;
                    const bool forced = (j == 0) || (j == c) || (j == c - 1);
                    x = (j <= c) ? (forced ? 1e6f : x) : -1.f;
                    const unsigned bits = (__builtin_bit_cast(unsigned, x) & ~63u) | (unsigned)(63 - j);
                    if (hg == 0) impw[qi * 64 + j] = __builtin_bit_cast(float, bits);
                }
        LDS_WAIT(); asm volatile("" ::: "memory");
        const int q2 = lane >> 3, part = lane & 7;
        const LAS float* iq = impw + q2 * 64;
        float mine[8]; int cnt[8];
        { const f32x4 m0 = *(const LAS f32x4*)(iq + 8 * part), m1 = *(const LAS f32x4*)(iq + 8 * part + 4);
#pragma unroll
          for (int i = 0; i < 4; ++i) { mine[i] = m0[i]; mine[4 + i] = m1[i]; cnt[i] = 0; cnt[4 + i] = 0; } }
#pragma unroll
        for (int k = 0; k < 16; ++k) { const f32x4 v = *(const LAS f32x4*)(iq + 4 * k);
#pragma unroll
            for (int e = 0; e < 4; ++e)
#pragma unroll
                for (int i = 0; i < 8; ++i) cnt[i] += (v[e] > mine[i]) ? 1 : 0; }
        unsigned byte = 0;
#pragma unroll
        for (int i = 0; i < 8; ++i) byte |= (cnt[i] < 16) ? (1u << i) : 0u;
        LAS unsigned char* mw = (LAS unsigned char*)(L + OFF_MSK + w * 64);
        mw[q2 * 8 + part] = (unsigned char)byte;
        LDS_WAIT(); asm volatile("" ::: "memory");
        mask = *(const LAS unsigned long long*)(mw + qi * 8);
        l = 0.f;
    }
    unsigned long long uni = 0;
#pragma unroll
    for (int q = 0; q < 8; ++q) { uni |= (unsigned long long)(unsigned)__builtin_amdgcn_readlane((int)(unsigned)mask, q) | ((unsigned long long)(unsigned)__builtin_amdgcn_readlane((int)(unsigned)(mask >> 32), q) << 32); }
#pragma unroll 1
    for (int j = 0; j <= c; ++j) {
        ATT_NEXT(it);
        if ((uni >> j) & 1ull) {
            const LAS unsigned char* Kb = L + OFF_K + (it & 1) * KBUF; const LAS unsigned char* Vb = L + OFF_V + (it & 1) * VBUF;
            const bool rs = (mask >> j) & 1ull;
            if (j <= c - 3) tile<false, false>(Kb, Vb, qf, rs ? c31 : NEGBIG, true, t, 64 * j, 1 << 30, tblh, O, l, dummy_u, carry, r, hh);
            else tile<true, false>(Kb, Vb, qf, 0.f, rs, t, 64 * j, 1 << 30, tblh, O, l, dummy_u, carry, r, hh);
        }
        ATT_FLIP(it); ++it;
    }
    {
        const float lt = l + xhalf(l); const float sc = lt > 0.f ? g1 / lt : 0.f;
#pragma unroll
        for (int i = 0; i < 16; ++i) { out[0][i] += sc * O[0][i]; out[1][i] += sc * O[1][i]; O[0][i] = 0.f; O[1][i] = 0.f; }
        l = 0.f;
    }
#pragma unroll 1
    for (int j = w0; j <= c; ++j) {
        ATT_NEXT(it);
        const LAS unsigned char* Kb = L + OFF_K + (it & 1) * KBUF; const LAS unsigned char* Vb = L + OFF_V + (it & 1) * VBUF;
        if (j <= c - 3 && j != c - 8) tile<false, false>(Kb, Vb, qf, c31, true, t, 64 * j, 511, tblh, O, l, dummy_u, carry, r, hh);
        else tile<true, false>(Kb, Vb, qf, 0.f, true, t, 64 * j, 511, tblh, O, l, dummy_u, carry, r, hh);
        ATT_FLIP(it); ++it;
    }
    {
        const float lt = l + xhalf(l); const float sc = lt > 0.f ? g2 / lt : 0.f;
#pragma unroll
        for (int i = 0; i < 16; ++i) { out[0][i] += sc * O[0][i]; out[1][i] += sc * O[1][i]; }
    }
#pragma unroll
    for (int dt = 0; dt < 2; ++dt)
#pragma unroll
        for (int q = 0; q < 4; ++q) { v2u wv; wv.x = cvtpk(out[dt][4 * q], out[dt][4 * q + 1]); wv.y = cvtpk(out[dt][4 * q + 2], out[dt][4 * q + 3]);
            *(v2u*)(yrow + 32 * dt + 8 * q + 4 * hh) = wv; }
    __syncthreads();
#undef ATT_GLOAD
#undef ATT_SWRITE
#undef ATT_NEXT
#undef ATT_FLIP
}

__global__ void __launch_bounds__(NWAVES * 64, 2) mk_fwd(Args args) {
    extern __shared__ __attribute__((aligned(16))) unsigned char lds[];
    Frame F;
    F.lds = (LAS unsigned char*)lds;
    F.MISC = (volatile LAS unsigned*)(F.lds + MISC_OFF);
    F.tid = threadIdx.x; F.lane = F.tid & 63; F.wave = __builtin_amdgcn_readfirstlane(F.tid >> 6);
    F.G = gridDim.x; { const int bx = blockIdx.x; F.vcu = (F.G % 8 == 0) ? (bx % 8) * (F.G / 8) + bx / 8 : bx; }
    unsigned char* ws = args.ws;
    F.ctl = (gu32*)(ws + WS_CTL);
    for (int u = F.tid; u < (LDS_BYTES - LDSCTL_OFF) / 4; u += NWAVES * 64) ((LAS unsigned*)(F.lds + LDSCTL_OFF))[u] = 0u;
    __syncthreads();
    if (F.tid < 128) { const int n = F.tid; int bkt = n;
        if (n >= 16) { const float nf = (float)n; int large = 16 + (int)(logf(nf / 16.f) / logf(8.f) * 16.f); bkt = large < 31 ? large : 31; }
        ((LAS unsigned char*)(F.lds + TB_OFF))[n] = (unsigned char)bkt; }
    __syncthreads();
    for (int e = F.tid; e < 8 * 129; e += NWAVES * 64) { const int hh_ = e / 129, x = e % 129; const int bk = x < 128 ? ((LAS unsigned char*)(F.lds + TB_OFF))[x] : 31;
        ((LAS float*)(F.lds + TBL_OFF))[hh_ * 132 + x] = args.in[17][hh_ * 32 + bk] * 1.4426950408889634f; }
    __syncthreads();
    XcdBarrier bar; bar.bar = (unsigned*)(F.ctl + CW_BAR) + args.li * XCD_BAR_WORDS; bar.x = 0; bar.st = nullptr;
    if (N_LAUNCHES != PER_PHASE) bar = xcd_barrier_post((unsigned*)(F.ctl + CW_BAR) + args.li * XCD_BAR_WORDS, F.MISC + 8);
#define GRID_BAR() do { if (N_LAUNCHES != PER_PHASE) xcd_barrier(bar); } while (0)
    const int lo = args.ph_lo, hi = args.ph_hi;
#define IN(k) (lo <= (k) && (k) < hi)
#define BOTH(k) (IN(k) && IN((k) + 1))
    bf16* XB = (bf16*)(ws + WS_XB); bf16* ACT = (bf16*)(ws + WS_ACT); bf16* Y = (bf16*)(ws + WS_Y);
    float* SS0 = (float*)(ws + WS_SS0); float* SS1 = (float*)(ws + WS_SS1); float* SS2 = (float*)(ws + WS_SS2); float* SS3 = (float*)(ws + WS_SS3);

    if (IN(0)) { p0_prologue(F, args); if (BOTH(0)) GRID_BAR(); }
    if (IN(1)) {
        pg8::Gemm g{XB, (const bf16*)(ws + WS_WGU1), MTOK, NGU, DM, DM, DM}; pg8::StaticOrder S; S.init(MTOK, NGU, F.G, (int)blockIdx.x);
        EpiSwiGLU E{SS0, ACT};
        pg8::gemm_phase<EpiSwiGLU, pg8::StaticOrder, true, true>(F.lds + RING_OFF, g, S, E);
        if (BOTH(1)) GRID_BAR();
    }
    if (IN(2)) {
        pg8::Gemm g{ACT, (const bf16*)(ws + WS_WD1), MTOK, DM, DFF, DFF, DFF}; pg8::StaticOrder S; S.init(MTOK, DM, F.G, (int)blockIdx.x);
        EpiResid E{args.in[0], args.out, XB, SS1, 0.5f};
        pg8::gemm_phase<EpiResid, pg8::StaticOrder, true, true>(F.lds + RING_OFF, g, S, E);
        if (BOTH(2)) GRID_BAR();
    }
    if (IN(3)) {
        pg8::Gemm g{XB, (const bf16*)(ws + WS_WIN), MTOK, NIN, DM, DM, DM}; pg8::StaticOrder S; S.init(MTOK, NIN, F.G, (int)blockIdx.x);
        EpiMix E{SS1, Y, (bf16*)(ws + WS_GVT), (float*)(ws + WS_SSV), (bf16*)(ws + WS_KCR), (bf16*)(ws + WS_VCR), (bf16*)(ws + WS_KS), (bf16*)(ws + WS_VST),
                 (bf16*)(ws + WS_KW), (bf16*)(ws + WS_VWT), (float*)(ws + WS_GATES), args.in[10], args.in[11]};
        pg8::gemm_phase<EpiMix, pg8::StaticOrder, true, true>(F.lds + RING_OFF, g, S, E);
        if (BOTH(3)) GRID_BAR();
    }
    if (IN(4)) {
        {
            pg8::Gemm g{(const bf16*)(ws + WS_KCR), (const bf16*)(ws + WS_CW1), 8192, 512, 2048, 1024, 2048}; pg8::CmpOrder S{(int)blockIdx.x};
            EpiCmp E{(const float*)(ws + WS_CB1P), (bf16*)(ws + WS_H1)};
            pg8::gemm_phase<EpiCmp, pg8::CmpOrder, false, true>(F.lds + RING_OFF, g, S, E);
            if (blockIdx.x < 32) cmp2_unit_simple(F, args, (int)blockIdx.x);
            __syncthreads();
        }
        for (int u = F.vcu; u < 256; u += F.G) gmlp_unit_simple(F, args, u);
        if (BOTH(4)) GRID_BAR();
    }
    if (IN(5)) {
#pragma unroll 1
        for (int n = F.vcu; n < NBG * 64; n += F.G) { const int v = n & 255, i = n >> 8, x = v >> 5, lv = v & 31; attn_unit(F, args, 2 * x + (i & 1), i < 2 ? 63 - lv : lv); }
        if (BOTH(5)) GRID_BAR();
    }
    if (IN(6)) {
        pg8::Gemm g{Y, (const bf16*)(ws + WS_WOUT), MTOK, DM, DM, DM, DM}; pg8::StaticOrder S; S.init(MTOK, DM, F.G, (int)blockIdx.x);
        EpiResid E{args.out, args.out, XB, SS2, 1.0f};
        pg8::gemm_phase<EpiResid, pg8::StaticOrder, true, true>(F.lds + RING_OFF, g, S, E);
        if (BOTH(6)) GRID_BAR();
    }
    if (IN(7)) {
        pg8::Gemm g{XB, (const bf16*)(ws + WS_WGU2), MTOK, NGU, DM, DM, DM}; pg8::StaticOrder S; S.init(MTOK, NGU, F.G, (int)blockIdx.x);
        EpiSwiGLU E{SS2, ACT};
        pg8::gemm_phase<EpiSwiGLU, pg8::StaticOrder, true, true>(F.lds + RING_OFF, g, S, E);
        if (BOTH(7)) GRID_BAR();
    }
    if (IN(8)) {
        pg8::Gemm g{ACT, (const bf16*)(ws + WS_WD2), MTOK, DM, DFF, DFF, DFF}; pg8::StaticOrder S; S.init(MTOK, DM, F.G, (int)blockIdx.x);
        EpiResid E{args.out, args.out, nullptr, SS3, 0.5f};
        pg8::gemm_phase<EpiResid, pg8::StaticOrder, true, true>(F.lds + RING_OFF, g, S, E);
        if (BOTH(8)) GRID_BAR();
    }
    if (IN(9)) {
        const int gw = F.vcu * NWAVES + F.wave, NGW = F.G * NWAVES; const float* gf = args.in[23];
        for (int m = gw; m < MTOK; m += NGW) {
            float s = (F.lane < 16) ? SS3[(size_t)m * 16 + F.lane] : 0.f; s = wave_sum(s);
            const float ri = rsq_acc(s, 1.f / DM);
            GAS f32x4* xr = (GAS f32x4*)(args.out + (size_t)m * DM) + F.lane;
#pragma unroll
            for (int j = 0; j < 4; ++j) { f32x4 v = xr[64 * j]; const f32x4 gg = *((const f32x4*)gf + F.lane + 64 * j); v = v * ri * gg; xr[64 * j] = v; }
        }
    }
#undef IN
#undef BOTH
#undef GRID_BAR
}

extern "C" void kernel_launch(void* const* d_in, const int* in_sizes, int n_in, void* d_out, int out_size, void* d_ws, size_t ws_size, hipStream_t stream) {
    static int grid = 0;
    if (grid == 0) {
        if (n_in != 24 || in_sizes[0] != MTOK * DM || out_size != MTOK * DM || ws_size < WS_END) { fprintf(stderr, "kernel_launch: unexpected shapes (n_in %d, in0 %d, out %d, ws %zu)\n", n_in, n_in > 0 ? in_sizes[0] : -1, out_size, ws_size); grid = -1; return; }
        int dev = 0, cus = 0, per_cu = 0;
        if (hipGetDevice(&dev) != hipSuccess || hipDeviceGetAttribute(&cus, hipDeviceAttributeMultiprocessorCount, dev) != hipSuccess) { grid = -1; return; }
        if (hipFuncSetAttribute((const void*)mk_fwd, hipFuncAttributeMaxDynamicSharedMemorySize, LDS_BYTES) != hipSuccess) { fprintf(stderr, "kernel_launch: hipFuncSetAttribute failed\n"); grid = -1; return; }
        if (hipOccupancyMaxActiveBlocksPerMultiprocessor(&per_cu, (const void*)mk_fwd, NWAVES * 64, LDS_BYTES) != hipSuccess || per_cu < 1) { fprintf(stderr, "kernel_launch: occupancy query says %d blocks per CU\n", per_cu); (void)hipGetLastError(); grid = -1; return; }
        grid = cus;
    }
    if (grid < 0) return;
    (void)hipMemsetAsync((char*)d_ws + WS_CTL, 0, CTL_ZERO_BYTES, stream);
    Args a{};
    for (int i = 0; i < 24; ++i) a.in[i] = (const float*)d_in[i];
    a.out = (float*)d_out; a.ws = (unsigned char*)d_ws;
    if (N_LAUNCHES == 1) {
        a.ph_lo = 0; a.ph_hi = PER_PHASE; a.li = 0;
        void* kargs[] = {&a};
        hipError_t e = hipLaunchCooperativeKernel((const void*)mk_fwd, dim3(grid), dim3(NWAVES * 64), kargs, LDS_BYTES, stream);
        if (e != hipSuccess) fprintf(stderr, "kernel_launch: cooperative launch failed: %s (grid %d)\n", hipGetErrorString(e), grid);
    } else {
        for (int li = 0; li < PER_PHASE; ++li) { a.ph_lo = li; a.ph_hi = li + 1; a.li = 0;
            hipLaunchKernelGGL(mk_fwd, dim3(grid), dim3(NWAVES * 64), LDS_BYTES, stream, a); }
    }
}
```

```cpp
#include <hip/hip_runtime.h>
#include <cstdio>
#include <cstdint>

#ifndef MK_N_LAUNCHES
#define MK_N_LAUNCHES 1
#endif

namespace pg8 {
#define PG8_LAS __attribute__((address_space(3)))
typedef unsigned short bf16_t;
typedef short bf16x8 __attribute__((ext_vector_type(8)));
typedef float f32x4 __attribute__((ext_vector_type(4)));
typedef unsigned u32x4 __attribute__((ext_vector_type(4)));
typedef unsigned u32x2 __attribute__((ext_vector_type(2)));
constexpr int BM = 256, BK = 64, HALF = 128, HTB = HALF * BK * 2, STAGE_BYTES = 8 * HTB, NXCD = 8, WGM = 8;

__host__ __device__ __forceinline__ int lds_byte(int r, int c) { const int st = (r >> 4) * 2 + (c >> 5), rr = r & 15, cc = c & 31, ob = rr * 64 + cc * 2; return st * 1024 + (ob ^ (((ob >> 9) & 1) << 5)); }
__host__ __device__ __forceinline__ void stage_rc(int b, int& R, int& C) { const int st = b / 1024, sb = b % 1024, swz = sb ^ (((sb >> 9) & 1) << 5); R = (st >> 1) * 16 + swz / 64; C = (st & 1) * 32 + (swz % 64) / 2; }
__host__ __device__ __forceinline__ int perm32(int rho) { const int n = rho >> 4, i = rho & 15; return 8 * (i >> 2) + 4 * n + (i & 3); }

struct Unit { int pm, pn; };
struct Gemm { const bf16_t* A; const bf16_t* Bt; int M, N, K, lda, ldb; };

struct StaticOrder {
    int nM, nN, nwg, G, c;
    __host__ __device__ void init(int M, int N, int G_, int c_) { nM = M / BM; nN = N / BM; nwg = nM * nN; G = G_; c = c_; }
    __host__ __device__ bool next(int i, Unit& u) const {
        const long L = (long)i * G + c; if (L >= nwg) return false;
        int wgid = (int)L; { const int q = nwg / NXCD, r = nwg % NXCD, xcd = wgid % NXCD, off = wgid / NXCD; wgid = (xcd < r ? xcd * (q + 1) : r * (q + 1) + (xcd - r) * q) + off; }
        const int nig = WGM * nN, gid = wgid / nig, fm = gid * WGM, gsz = (nM - fm) < WGM ? (nM - fm) : WGM;
        u.pm = fm + ((wgid % nig) % gsz); u.pn = (wgid % nig) / gsz; return true;
    }
};
struct CmpOrder {
    int c;
    __device__ bool next(int i, Unit& u) const { if (i != 0 || c >= 32) return false; u.pm = c; u.pn = c >> 4; return true; }
};

__device__ __forceinline__ unsigned cvt_pk_bf16(float lo, float hi) { unsigned r; asm volatile("v_cvt_pk_bf16_f32 %0, %1, %2" : "=v"(r) : "v"(lo), "v"(hi)); return r; }

template <class Epi, class Sched, bool ALIGN_EPI = false, bool SP2 = false>
__device__ __forceinline__ void gemm_phase(PG8_LAS unsigned char* lds, const Gemm g, const Sched& S, const Epi& E) {
    const int tid = threadIdx.x, wid = __builtin_amdgcn_readfirstlane(tid >> 6), lane = tid & 63, wr = wid >> 2, wc = wid & 3, fr = lane & 15, fq = lane >> 4;
    const int K = g.K, nt = K / BK;
    unsigned voffA[2], voffB[2];
#pragma unroll
    for (int i = 0; i < 2; ++i) { int R, C; stage_rc(tid * 16 + i * 8192, R, C); const int Rb = Epi::PERM ? ((R & ~31) + perm32(R & 31)) : R;
        voffA[i] = (unsigned)(R * g.lda + C) * 2u; voffB[i] = (unsigned)(Rb * g.ldb + C) * 2u; }
    const size_t kstep = (size_t)(BK * 2);
    const size_t hstepA = (size_t)HALF * g.lda * 2, hstepB = (size_t)HALF * g.ldb * 2;
    const size_t tstepA = 2 * hstepA, tstepB = 2 * hstepB;
    const unsigned ldsw = (unsigned)wid * 1024u;
    const int aoff = lds_byte(wr * 64 + fr, fq * 8), boff = lds_byte(wc * 32 + fr, fq * 8);
#define PG8_SA(b, h) (((b) * 2 + (h)) * HTB)
#define PG8_SB(b, h) ((4 + (b) * 2 + (h)) * HTB)
#define PG8_STAGE(bufoff, gbase, voff) do { _Pragma("unroll") for (int _i = 0; _i < 2; ++_i) \
        __builtin_amdgcn_global_load_lds((const unsigned*)((const char*)(gbase) + (voff)[_i]), (PG8_LAS unsigned*)(lds + (bufoff) + ldsw + _i * 8192), 16, 0, 0); } while (0)
#define PG8_LDA(dst, b, h) do { _Pragma("unroll") for (int m = 0; m < 4; ++m) _Pragma("unroll") for (int k = 0; k < 2; ++k) dst[m][k] = *(const PG8_LAS bf16x8*)(lds + PG8_SA(b, h) + aoff + m * 2048 + k * 1024); } while (0)
#define PG8_LDB(dst, b, h) do { _Pragma("unroll") for (int n = 0; n < 2; ++n) _Pragma("unroll") for (int k = 0; k < 2; ++k) dst[n][k] = *(const PG8_LAS bf16x8*)(lds + PG8_SB(b, h) + boff + n * 2048 + k * 1024); } while (0)
#define PG8_MMA(ai, bj, At, Bt) do { __builtin_amdgcn_s_setprio(1); _Pragma("unroll") for (int m = 0; m < 4; ++m) _Pragma("unroll") for (int n = 0; n < 2; ++n) _Pragma("unroll") for (int k = 0; k < 2; ++k) \
        acc[ai][bj][m][n] = __builtin_amdgcn_mfma_f32_16x16x32_bf16(Bt[n][k], At[m][k], acc[ai][bj][m][n], 0, 0, 0); __builtin_amdgcn_s_setprio(0); } while (0)
#define PG8_WAIT_V(n) asm volatile("s_waitcnt vmcnt(" #n ")" ::: "memory")
#define PG8_WAIT_L(n) asm volatile("s_waitcnt lgkmcnt(" #n ")" ::: "memory")
#define PG8_BAR __builtin_amdgcn_s_barrier()
#define PG8_SCHED __builtin_amdgcn_sched_barrier(0)
    Unit cur, nxt; int ui = 0;
    if (!S.next(0, cur)) return;
    f32x4 acc[2][2][4][2];
#pragma unroll
    for (int a = 0; a < 2; ++a)
#pragma unroll
        for (int b = 0; b < 2; ++b)
#pragma unroll
            for (int m = 0; m < 4; ++m)
#pragma unroll
                for (int n = 0; n < 2; ++n) acc[a][b][m][n] = (f32x4){0.f, 0.f, 0.f, 0.f};
    bf16x8 At[4][2], B0[2][2], B1[2][2];
    const char* cA = (const char*)g.A + (size_t)cur.pm * tstepA; const char* cB = (const char*)g.Bt + (size_t)cur.pn * tstepB;
    if constexpr (SP2) {
        PG8_STAGE(PG8_SB(0, 0), cB, voffB); PG8_STAGE(PG8_SB(0, 1), cB + hstepB, voffB); PG8_STAGE(PG8_SA(0, 0), cA, voffA); PG8_STAGE(PG8_SA(0, 1), cA + hstepA, voffA);
        if (wr == 1) PG8_BAR;
        PG8_WAIT_V(2); PG8_BAR;
        PG8_STAGE(PG8_SB(1, 0), cB + kstep, voffB); PG8_STAGE(PG8_SA(1, 0), cA + kstep, voffA); PG8_STAGE(PG8_SB(1, 1), cB + hstepB + kstep, voffB);
        PG8_WAIT_V(6); PG8_BAR;
    } else {
        PG8_STAGE(PG8_SB(0, 0), cB, voffB); PG8_STAGE(PG8_SA(0, 0), cA, voffA); PG8_STAGE(PG8_SB(0, 1), cB + hstepB, voffB); PG8_STAGE(PG8_SA(0, 1), cA + hstepA, voffA);
        if (wr == 1) PG8_BAR;
        PG8_WAIT_V(4); PG8_BAR;
        PG8_STAGE(PG8_SB(1, 0), cB + kstep, voffB); PG8_STAGE(PG8_SA(1, 0), cA + kstep, voffA); PG8_STAGE(PG8_SB(1, 1), cB + hstepB + kstep, voffB);
        PG8_WAIT_V(6); PG8_BAR;
    }
    for (;;) {
        const bool has_next = S.next(ui + 1, nxt);
        const char* nA = has_next ? (const char*)g.A + (size_t)nxt.pm * tstepA : cA; const char* nB = has_next ? (const char*)g.Bt + (size_t)nxt.pn * tstepB : cB;
        for (int t = 0; t < nt; t += 2) {
            const bool last = (t == nt - 2);
            const char* a1 = cA + (size_t)(t + 1) * kstep;
            const char* a2 = last ? nA : cA + (size_t)(t + 2) * kstep; const char* b2 = last ? nB : cB + (size_t)(t + 2) * kstep;
            const char* a3 = a2 + kstep; const char* b3 = b2 + kstep;
            if constexpr (SP2) {
            PG8_LDB(B0, 0, 0); PG8_LDB(B1, 0, 1); PG8_SCHED; PG8_LDA(At, 0, 0); PG8_STAGE(PG8_SA(1, 1), a1 + hstepA, voffA);
            PG8_WAIT_V(8); PG8_WAIT_L(0); PG8_BAR; PG8_MMA(0, 0, At, B0); PG8_MMA(0, 1, At, B1); PG8_BAR; PG8_SCHED;
            PG8_LDA(At, 0, 1); PG8_STAGE(PG8_SB(0, 0), b2, voffB); PG8_STAGE(PG8_SB(0, 1), b2 + hstepB, voffB); PG8_STAGE(PG8_SA(0, 0), a2, voffA);
            PG8_WAIT_V(8); PG8_WAIT_L(0); PG8_BAR; PG8_MMA(1, 0, At, B0); PG8_MMA(1, 1, At, B1); PG8_BAR; PG8_SCHED;
            PG8_LDB(B0, 1, 0); PG8_LDB(B1, 1, 1); PG8_SCHED; PG8_LDA(At, 1, 0); PG8_STAGE(PG8_SA(0, 1), a2 + hstepA, voffA);
            PG8_WAIT_V(8); PG8_WAIT_L(0); PG8_BAR; PG8_MMA(0, 0, At, B0); PG8_MMA(0, 1, At, B1); PG8_BAR; PG8_SCHED;
            PG8_LDA(At, 1, 1); PG8_STAGE(PG8_SB(1, 0), b3, voffB); PG8_STAGE(PG8_SB(1, 1), b3 + hstepB, voffB); PG8_STAGE(PG8_SA(1, 0), a3, voffA);
            PG8_WAIT_V(8); PG8_WAIT_L(0); PG8_BAR; PG8_MMA(1, 0, At, B0); PG8_MMA(1, 1, At, B1); PG8_BAR; PG8_SCHED;
            } else {
            PG8_LDB(B0, 0, 0); PG8_SCHED; PG8_LDA(At, 0, 0); PG8_STAGE(PG8_SA(1, 1), a1 + hstepA, voffA);
            PG8_WAIT_L(8); PG8_BAR; PG8_WAIT_L(0); PG8_MMA(0, 0, At, B0); PG8_BAR; PG8_SCHED;
            PG8_LDB(B1, 0, 1); PG8_STAGE(PG8_SB(0, 0), b2, voffB);
            PG8_BAR; PG8_WAIT_L(0); PG8_MMA(0, 1, At, B1); PG8_BAR;
            PG8_LDA(At, 0, 1); PG8_STAGE(PG8_SA(0, 0), a2, voffA);
            PG8_BAR; PG8_WAIT_L(0); PG8_MMA(1, 0, At, B0); PG8_BAR; PG8_SCHED;
            PG8_STAGE(PG8_SB(0, 1), b2 + hstepB, voffB);
            PG8_WAIT_V(6); PG8_BAR; PG8_MMA(1, 1, At, B1); PG8_BAR;
            PG8_LDB(B0, 1, 0); PG8_SCHED; PG8_LDA(At, 1, 0); PG8_STAGE(PG8_SA(0, 1), a2 + hstepA, voffA);
            PG8_WAIT_L(8); PG8_BAR; PG8_WAIT_L(0); PG8_MMA(0, 0, At, B0); PG8_BAR; PG8_SCHED;
            PG8_LDB(B1, 1, 1); PG8_STAGE(PG8_SB(1, 0), b3, voffB);
            PG8_BAR; PG8_WAIT_L(0); PG8_MMA(0, 1, At, B1); PG8_BAR;
            PG8_LDA(At, 1, 1); PG8_STAGE(PG8_SA(1, 0), a3, voffA);
            PG8_BAR; PG8_WAIT_L(0); PG8_MMA(1, 0, At, B0); PG8_BAR; PG8_SCHED;
            PG8_STAGE(PG8_SB(1, 1), b3 + hstepB, voffB);
            PG8_WAIT_V(6); PG8_BAR; PG8_MMA(1, 1, At, B1); PG8_BAR;
            }
        }
        if constexpr (ALIGN_EPI) { if (wr == 0) PG8_BAR; }
        E(acc, cur, wr, wc, fr, fq);
        if (!has_next) break;
#pragma unroll
        for (int a = 0; a < 2; ++a)
#pragma unroll
            for (int b = 0; b < 2; ++b)
#pragma unroll
                for (int m = 0; m < 4; ++m)
#pragma unroll
                    for (int n = 0; n < 2; ++n) acc[a][b][m][n] = (f32x4){0.f, 0.f, 0.f, 0.f};
        cur = nxt; cA = nA; cB = nB; ++ui;
        if constexpr (ALIGN_EPI) { if (wr == 1) PG8_BAR; }
    }
    PG8_WAIT_V(0);
    if constexpr (!ALIGN_EPI) { if (wr == 0) PG8_BAR; }
    PG8_BAR;
#undef PG8_SA
#undef PG8_SB
#undef PG8_STAGE
#undef PG8_LDA
#undef PG8_LDB
#undef PG8_MMA
#undef PG8_WAIT_V
#undef PG8_WAIT_L
#undef PG8_BAR
#undef PG8_SCHED
}
}

constexpr int NWAVES = 8;
constexpr int BATCH = 8, SEQ = 4096, DM = 1024, MTOK = BATCH * SEQ;
constexpr int DFF = 2816, NGU = 2 * DFF, INC = 2328, NIN = 2560;
constexpr int HD = 64, NBG = 16, NCMP = 255;
constexpr float EPS = 1e-6f;
constexpr int PER_PHASE = 10;
constexpr int N_LAUNCHES = MK_N_LAUNCHES;

constexpr size_t MiB = 1u << 20;
constexpr size_t WS_CTL = 0, CTL_ZERO_BYTES = 1 * MiB;
constexpr size_t WS_WGU1 = 2 * MiB, WS_WD1 = 13 * MiB, WS_WGU2 = 19 * MiB, WS_WD2 = 30 * MiB, WS_WIN = 36 * MiB, WS_WOUT = 41 * MiB, WS_CW1 = 43 * MiB;
constexpr size_t WS_WSB = 45 * MiB, WS_CB1P = 45 * MiB + 512 * 1024, WS_CW2 = 45 * MiB + 768 * 1024;
constexpr size_t WS_SS0 = 46 * MiB, WS_SS1 = 48 * MiB, WS_SS2 = 50 * MiB, WS_SS3 = 52 * MiB, WS_SSV = 54 * MiB;
constexpr size_t WS_XB = 56 * MiB;
constexpr size_t WS_ACT = 120 * MiB;
constexpr size_t WS_Y = 120 * MiB, WS_GVT = 184 * MiB, WS_KCR = 216 * MiB, WS_VCR = 224 * MiB, WS_KS = 232 * MiB, WS_VST = 240 * MiB, WS_KW = 248 * MiB, WS_VWT = 256 * MiB;
constexpr size_t WS_GATES = 264 * MiB, WS_H1 = 268 * MiB, WS_KCMP = 272 * MiB, WS_VCMPT = 272 * MiB + 512 * 1024;
constexpr size_t WS_END = 296 * MiB;
constexpr int CW_BAR = 4096;

constexpr int RING_OFF = 0, RING_BYTES = 131072;
constexpr int LDSCTL_OFF = RING_BYTES, MISC_OFF = LDSCTL_OFF + 320;
constexpr int TB_OFF = LDSCTL_OFF + 1024;
constexpr int TBL_OFF = LDSCTL_OFF + 2048;
constexpr int LDS_BYTES = 147456;

#define GAS __attribute__((address_space(1)))
#define LAS __attribute__((address_space(3)))
typedef unsigned short bf16;
typedef unsigned v4u __attribute__((ext_vector_type(4)));
typedef unsigned v2u __attribute__((ext_vector_type(2)));
typedef float f32x4 __attribute__((ext_vector_type(4)));
typedef GAS unsigned gu32;
#define RLX_AGENT __ATOMIC_RELAXED, __HIP_MEMORY_SCOPE_AGENT
#define LDS_WAIT() asm volatile("s_waitcnt lgkmcnt(0)" ::: "memory")
#define VM_WAIT() asm volatile("s_waitcnt vmcnt(0)" ::: "memory")
__device__ __forceinline__ unsigned f2bf(float f) { unsigned u = __builtin_bit_cast(unsigned, f); return (u + 0x7fffu + ((u >> 16) & 1u)) >> 16; }
__device__ __forceinline__ unsigned pk2(float lo, float hi) { return f2bf(lo) | (f2bf(hi) << 16); }
__device__ __forceinline__ float bf2f(unsigned short b) { return __builtin_bit_cast(float, (unsigned)b << 16); }
__device__ __forceinline__ float wave_sum(float v) {
#pragma unroll
    for (int o = 1; o < 64; o <<= 1) v += __shfl_xor(v, o);
    return v;
}
__device__ __forceinline__ float wave_max(float v) {
#pragma unroll
    for (int o = 1; o < 64; o <<= 1) v = fmaxf(v, __shfl_xor(v, o));
    return v;
}
__device__ __forceinline__ float gelu_tanh(float x) { const float u2 = 1.5957691216057308f * (x + 0.044715f * x * x * x); return x / (1.f + __expf(-u2)); }
__device__ __forceinline__ float sigmoidf_(float x) { return 1.f / (1.f + __expf(-x)); }

#define XB_TMO      128
#define XB_XCNT(j)  (256  + 64 * (j))
#define XB_XSUB(j)  (1280 + 64 * (j))
#define XB_XGEN(j)  (2304 + 64 * (j))
#define XB_TOP      3328
#define XB_TOPGEN   3392
#define XCD_BAR_WORDS 3456
#define XB_SPIN_CAP (1u << 22)
__device__ __forceinline__ unsigned xb_ld(unsigned* p)              { return __hip_atomic_load(p, __ATOMIC_RELAXED, __HIP_MEMORY_SCOPE_AGENT); }
__device__ __forceinline__ unsigned xb_add(unsigned* p, unsigned v) { return __hip_atomic_fetch_add(p, v, __ATOMIC_RELAXED, __HIP_MEMORY_SCOPE_AGENT); }
__device__ __forceinline__ unsigned xb_xcc_id() { return (unsigned)__builtin_amdgcn_s_getreg((3 << 11) | 20) & 0xFu; }
#define XB_SPIN(cond, bar) do { unsigned _sp = 0; while (cond) { __builtin_amdgcn_s_sleep(1); \
    if ((++_sp & 255u) == 0u) { if (xb_ld(&(bar)[XB_TMO])) break; if (_sp > XB_SPIN_CAP) { atomicAdd(&(bar)[XB_TMO], 1u); break; } } } } while (0)
struct XcdBarrier { unsigned* bar; unsigned x; volatile LAS unsigned* st; };
__device__ __forceinline__ XcdBarrier xcd_barrier_post(unsigned* bar, volatile LAS unsigned* st) {
    XcdBarrier b; b.bar = bar; b.x = xb_xcc_id(); b.st = st;
    if (threadIdx.x == 0) (void)xb_add(&bar[XB_XCNT(b.x)], 1u);
    return b;
}
__device__ __forceinline__ void xcd_barrier_complete(unsigned* bar, unsigned x, unsigned& nloc, unsigned& nx) {
    const unsigned G = gridDim.x * gridDim.y * gridDim.z;
    unsigned sum, cnt, mine, sp = 0u;
    for (;;) {
        sum = 0u; cnt = 0u; mine = 0u;
#pragma unroll
        for (unsigned j = 0; j < 16; ++j) { const unsigned c = xb_ld(&bar[XB_XCNT(j)]); sum += c; cnt += (c > 0u) ? 1u : 0u; mine = (j == x) ? c : mine; }
        if (sum == G) break;
        __builtin_amdgcn_s_sleep(1);
        if ((++sp & 255u) == 0u) { if (xb_ld(&bar[XB_TMO])) break; if (sp > XB_SPIN_CAP) { atomicAdd(&bar[XB_TMO], 1u); break; } }
    }
    nloc = mine > 0u ? mine : 1u; nx = cnt > 0u ? cnt : 1u;
}
__device__ __forceinline__ void xcd_barrier(const XcdBarrier& b) {
    asm volatile("s_waitcnt vmcnt(0)" ::: "memory");
    __syncthreads();
    if (threadIdx.x == 0) {
        unsigned* bar = b.bar;
        __builtin_amdgcn_s_waitcnt(0);
        unsigned nloc = b.st[0], nx = b.st[1];
        if (nloc == 0u) { xcd_barrier_complete(bar, b.x, nloc, nx); b.st[0] = nloc; b.st[1] = nx; }
        const unsigned old = xb_add(&bar[XB_XSUB(b.x)], 1u);
        const unsigned gen = old / nloc;
        if (old + 1u == (gen + 1u) * nloc) {
            __builtin_amdgcn_fence(__ATOMIC_RELEASE, "agent");
            asm volatile("s_waitcnt vmcnt(0)" ::: "memory");
            const unsigned og = xb_add(&bar[XB_TOP], 1u);
            const unsigned tg = og / nx;
            if (og + 1u == (tg + 1u) * nx) xb_add(&bar[XB_TOPGEN], 1u);
            else XB_SPIN(xb_ld(&bar[XB_TOPGEN]) == tg, bar);
            __builtin_amdgcn_fence(__ATOMIC_ACQUIRE, "agent");
            xb_add(&bar[XB_XGEN(b.x)], 1u);
            asm volatile("s_waitcnt vmcnt(0)" ::: "memory");
        } else {
            XB_SPIN(xb_ld(&bar[XB_XGEN(b.x)]) == gen, bar);
            __builtin_amdgcn_fence(__ATOMIC_ACQUIRE, "agent");
            asm volatile("s_waitcnt vmcnt(0)" ::: "memory");
        }
    }
    __syncthreads();
}

__device__ __forceinline__ float row_rinv(const float* ss, int row, int fq) {
    const f32x4 p = *(const f32x4*)(ss + (size_t)row * 16 + 4 * fq);
    float s = (p[0] + p[1]) + (p[2] + p[3]);
    s += __shfl_xor(s, 16); s += __shfl_xor(s, 32);
    return __builtin_amdgcn_rsqf(s * (1.f / DM) + EPS);
}
__device__ __forceinline__ float rsq_acc(float s, float invn) { return 1.0f / sqrtf(s * invn + EPS); }

struct EpiSwiGLU {
    static constexpr bool PERM = true;
    const float* ss; bf16* act;
    __device__ __forceinline__ void operator()(const f32x4 (&acc)[2][2][4][2], const pg8::Unit& u, int wr, int wc, int fr, int fq) const {
#pragma unroll
        for (int ai = 0; ai < 2; ++ai)
#pragma unroll
            for (int m = 0; m < 4; ++m) {
                const int row = u.pm * 256 + ai * 128 + wr * 64 + m * 16 + fr;
                const float ri = row_rinv(ss, row, fq);
                float o[8];
#pragma unroll
                for (int n = 0; n < 2; ++n)
#pragma unroll
                    for (int i = 0; i < 4; ++i) { const float g = acc[ai][0][m][n][i] * ri, up = acc[ai][1][m][n][i] * ri; o[n * 4 + i] = g * sigmoidf_(g) * up; }
                v4u w; w.x = pk2(o[0], o[1]); w.y = pk2(o[2], o[3]); w.z = pk2(o[4], o[5]); w.w = pk2(o[6], o[7]);
                *(v4u*)(act + (size_t)row * DFF + u.pn * 128 + wc * 32 + fq * 8) = w;
            }
    }
};
struct EpiResid {
    static constexpr bool PERM = false;
    const float* base; float* out; bf16* xb; float* ssp; float scale;
    __device__ __forceinline__ void operator()(const f32x4 (&acc)[2][2][4][2], const pg8::Unit& u, int wr, int wc, int fr, int fq) const {
#pragma unroll
        for (int ai = 0; ai < 2; ++ai)
#pragma unroll
            for (int m = 0; m < 4; ++m) {
                const int row = u.pm * 256 + ai * 128 + wr * 64 + m * 16 + fr;
                float sq = 0.f;
#pragma unroll
                for (int bj = 0; bj < 2; ++bj)
#pragma unroll
                    for (int n = 0; n < 2; ++n) {
                        const size_t off = (size_t)row * DM + u.pn * 256 + bj * 128 + wc * 32 + n * 16 + fq * 4;
                        const f32x4 b = *(const f32x4*)(base + off);
                        const f32x4 o = b + acc[ai][bj][m][n] * scale;
                        *(f32x4*)(out + off) = o;
                        if (xb) { v2u w; w.x = pk2(o[0], o[1]); w.y = pk2(o[2], o[3]); *(v2u*)(xb + off) = w; }
                        sq += (o[0] * o[0] + o[1] * o[1]) + (o[2] * o[2] + o[3] * o[3]);
                    }
                sq += __shfl_xor(sq, 16); sq += __shfl_xor(sq, 32);
                if (fq == 0) ssp[(size_t)row * 16 + u.pn * 4 + wc] = sq;
            }
    }
};
struct EpiMix {
    static constexpr bool PERM = true;
    const float* ss; bf16* Y; bf16* GVT; float* SSV; bf16* KCR; bf16* VCR; bf16* KS; bf16* VST; bf16* KW; bf16* VWT; float* GATES;
    const float* qg; const float* kg;
    __device__ __forceinline__ void operator()(const f32x4 (&acc)[2][2][4][2], const pg8::Unit& u, int wr, int wc, int fr, int fq) const {
        const int pn = u.pn;
        float gn[2][2][4];
        const float* gsrc = nullptr;
        if (pn == 4 || pn == 5) gsrc = qg; else if (pn == 7 && wc < 2) gsrc = kg + 64; else if (pn == 8 && wc < 2) gsrc = kg + 128;
#pragma unroll
        for (int bj = 0; bj < 2; ++bj)
#pragma unroll
            for (int n = 0; n < 2; ++n)
#pragma unroll
                for (int i = 0; i < 4; ++i) gn[bj][n][i] = gsrc ? gsrc[32 * bj + 8 * fq + 4 * n + i] : 1.f;
#pragma unroll
        for (int ai = 0; ai < 2; ++ai)
#pragma unroll
            for (int m = 0; m < 4; ++m) {
                const int row = u.pm * 256 + ai * 128 + wr * 64 + m * 16 + fr;
                const int b = row >> 12, t = row & 4095;
                const float ri = row_rinv(ss, row, fq);
                float v[2][2][4];
#pragma unroll
                for (int bj = 0; bj < 2; ++bj)
#pragma unroll
                    for (int n = 0; n < 2; ++n)
#pragma unroll
                        for (int i = 0; i < 4; ++i) v[bj][n][i] = acc[ai][bj][m][n][i] * ri;
                if (pn < 4) {
                    float sq = 0.f;
#pragma unroll
                    for (int bj = 0; bj < 2; ++bj)
#pragma unroll
                        for (int n = 0; n < 2; ++n)
#pragma unroll
                            for (int i = 0; i < 4; ++i) { const float x = gelu_tanh(v[bj][n][i]); v[bj][n][i] = x; sq += x * x; }
                    if (pn < 2) {
#pragma unroll
                        for (int bj = 0; bj < 2; ++bj) { v4u w; w.x = pk2(v[bj][0][0], v[bj][0][1]); w.y = pk2(v[bj][0][2], v[bj][0][3]); w.z = pk2(v[bj][1][0], v[bj][1][1]); w.w = pk2(v[bj][1][2], v[bj][1][3]);
                            *(v4u*)(Y + (size_t)row * DM + pn * 256 + wc * 64 + bj * 32 + fq * 8) = w; }
                    } else {
                        const int h = (pn - 2) * 4 + wc;
                        bf16* dst = GVT + ((size_t)(b * 8 + h) * 64) * SEQ + t;
#pragma unroll
                        for (int bj = 0; bj < 2; ++bj)
#pragma unroll
                            for (int n = 0; n < 2; ++n)
#pragma unroll
                                for (int i = 0; i < 4; ++i) dst[(size_t)(32 * bj + 8 * fq + 4 * n + i) * SEQ] = (bf16)f2bf(v[bj][n][i]);
                        sq += __shfl_xor(sq, 16); sq += __shfl_xor(sq, 32);
                        if (fq == 0) SSV[(size_t)row * 8 + (pn - 2) * 4 + wc] = sq;
                    }
                } else if (pn < 9) {
                    const bool is_q = (pn == 4 || pn == 5);
                    const bool is_k = (wc < 2);
                    const bool normed = is_q || ((pn == 7 || pn == 8) && is_k);
                    if (normed) {
                        float sq = 0.f;
#pragma unroll
                        for (int bj = 0; bj < 2; ++bj)
#pragma unroll
                            for (int n = 0; n < 2; ++n)
#pragma unroll
                                for (int i = 0; i < 4; ++i) sq += v[bj][n][i] * v[bj][n][i];
                        sq += __shfl_xor(sq, 16); sq += __shfl_xor(sq, 32);
                        const float rh = rsq_acc(sq, 1.f / 64.f) * (is_q ? 0.125f * 1.4426950408889634f : 1.f);
#pragma unroll
                        for (int bj = 0; bj < 2; ++bj)
#pragma unroll
                            for (int n = 0; n < 2; ++n)
#pragma unroll
                                for (int i = 0; i < 4; ++i) v[bj][n][i] *= rh * gn[bj][n][i];
                    }
                    if (is_q || is_k) {
                        bf16* dst;
                        if (is_q) dst = Y + (size_t)row * DM + 512 + (pn - 4) * 256 + wc * 64;
                        else { bf16* kb = (pn == 6) ? KCR : (pn == 7) ? KS : KW; dst = kb + ((size_t)(b * 2 + wc) * SEQ + t) * 64; }
#pragma unroll
                        for (int bj = 0; bj < 2; ++bj) { v4u w; w.x = pk2(v[bj][0][0], v[bj][0][1]); w.y = pk2(v[bj][0][2], v[bj][0][3]); w.z = pk2(v[bj][1][0], v[bj][1][1]); w.w = pk2(v[bj][1][2], v[bj][1][3]);
                            *(v4u*)(dst + bj * 32 + fq * 8) = w; }
                    } else if (pn == 6) {
                        bf16* dst = VCR + ((size_t)(b * 2 + (wc - 2)) * SEQ + t) * 64;
#pragma unroll
                        for (int bj = 0; bj < 2; ++bj) { v4u w; w.x = pk2(v[bj][0][0], v[bj][0][1]); w.y = pk2(v[bj][0][2], v[bj][0][3]); w.z = pk2(v[bj][1][0], v[bj][1][1]); w.w = pk2(v[bj][1][2], v[bj][1][3]);
                            *(v4u*)(dst + bj * 32 + fq * 8) = w; }
                    } else {
                        bf16* vb = (pn == 7) ? VST : VWT;
                        bf16* dst = vb + ((size_t)(b * 2 + (wc - 2)) * 64) * SEQ + t;
#pragma unroll
                        for (int bj = 0; bj < 2; ++bj)
#pragma unroll
                            for (int n = 0; n < 2; ++n)
#pragma unroll
                                for (int i = 0; i < 4; ++i) dst[(size_t)(32 * bj + 8 * fq + 4 * n + i) * SEQ] = (bf16)f2bf(v[bj][n][i]);
                    }
                } else {
                    if (wc == 0 && fq < 3) {
                        f32x4 g0, g1;
#pragma unroll
                        for (int i = 0; i < 4; ++i) { g0[i] = sigmoidf_(v[0][0][i]); g1[i] = sigmoidf_(v[0][1][i]); }
                        *(f32x4*)(GATES + (size_t)row * 24 + fq * 8) = g0; *(f32x4*)(GATES + (size_t)row * 24 + fq * 8 + 4) = g1;
                    }
                }
            }
    }
};
struct EpiCmp {
    static constexpr bool PERM = true;
    const float* cb1p; bf16* H1;
    __device__ __forceinline__ void operator()(const f32x4 (&acc)[2][2][4][2], const pg8::Unit& u, int wr, int wc, int fr, int fq) const {
        float bias[2][2][4];
#pragma unroll
        for (int bj = 0; bj < 2; ++bj)
#pragma unroll
            for (int n = 0; n < 2; ++n)
#pragma unroll
                for (int i = 0; i < 4; ++i) { const int col = u.pn * 256 + bj * 128 + wc * 32 + fq * 8 + n * 4 + i; float s = 0.f;
#pragma unroll
                    for (int p = 0; p < 8; ++p) s += cb1p[p * 512 + col];
                    bias[bj][n][i] = s; }
#pragma unroll
        for (int ai = 0; ai < 2; ++ai)
#pragma unroll
            for (int m = 0; m < 4; ++m) {
                const int row = u.pm * 256 + ai * 128 + wr * 64 + m * 16 + fr;
#pragma unroll
                for (int bj = 0; bj < 2; ++bj) { float o[8];
#pragma unroll
                    for (int n = 0; n < 2; ++n)
#pragma unroll
                        for (int i = 0; i < 4; ++i) o[n * 4 + i] = gelu_tanh(acc[ai][bj][m][n][i] + bias[bj][n][i]);
                    v4u w; w.x = pk2(o[0], o[1]); w.y = pk2(o[2], o[3]); w.z = pk2(o[4], o[5]); w.w = pk2(o[6], o[7]);
                    *(v4u*)(H1 + (size_t)row * 256 + bj * 128 + wc * 32 + fq * 8) = w; }
            }
    }
};

struct Frame {
    LAS unsigned char* lds; volatile LAS unsigned* MISC; gu32* ctl;
    int tid, lane, wave, vcu, G;
};
struct Args { const float* in[24]; float* out; unsigned char* ws; int ph_lo, ph_hi, li, pad; };

__device__ __forceinline__ void p0_tr_item(const float* W, int ldw, int K, const float* gain, bf16* WT, int n0d, int sc0, int nvalid, int kb, LAS float* scr, int lane) {
    const int k0 = 64 * kb;
#pragma unroll 8
    for (int i = 0; i < 32; ++i) { const int kk = 2 * i + (lane >> 5), c = lane & 31;
        float x = 0.f; if (c < nvalid) { x = W[(size_t)(k0 + kk) * ldw + sc0 + c]; if (gain) x *= gain[k0 + kk]; }
        scr[kk * 33 + c] = x; }
    LDS_WAIT(); asm volatile("" ::: "memory");
    const int c = lane & 7;
#pragma unroll
    for (int j = 0; j < 4; ++j) { const int n = (lane >> 3) + 8 * j; const LAS float* s = scr + (8 * c) * 33 + n;
        v4u o; o.x = pk2(s[0 * 33], s[1 * 33]); o.y = pk2(s[2 * 33], s[3 * 33]); o.z = pk2(s[4 * 33], s[5 * 33]); o.w = pk2(s[6 * 33], s[7 * 33]);
        *(GAS v4u*)(WT + (size_t)(n0d + n) * K + k0 + 8 * c) = o; }
    LDS_WAIT(); asm volatile("" ::: "memory");
}

__device__ __forceinline__ void p0_prologue(Frame& F, const Args& A) {
    unsigned char* ws = A.ws;
    LAS float* scr = (LAS float*)(F.lds + RING_OFF + F.wave * 16384);
    const int gw = F.vcu * NWAVES + F.wave, NGW = F.G * NWAVES, lane = F.lane;
    constexpr int I_GU = (DM / 64) * (NGU / 32), I_D = (DFF / 64) * (DM / 32), I_IN = (DM / 64) * (NIN / 32), I_OUT = (DM / 64) * (DM / 32), I_C1 = 2 * (2048 / 64) * (256 / 32);
    constexpr int I_WS = 8 * 128 * 128 / 64 / 8;
    constexpr int I_CB = 64, I_C2 = 64;
    constexpr int NITEMS = 2 * I_GU + 2 * I_D + I_IN + I_OUT + I_C1 + I_WS + I_CB + I_C2;
    for (int it = gw; it < NITEMS; it += NGW) {
        int r = it;
        if (r < 2 * I_GU) {
            const int f = r / I_GU; r -= f * I_GU; const int nblk = NGU / 32, kb = r / nblk, nb = r % nblk, n0 = 32 * nb, pn = n0 >> 8, bj = (n0 >> 7) & 1, j = n0 & 127;
            const float* W = f ? (bj ? A.in[21] : A.in[20]) : (bj ? A.in[3] : A.in[2]);
            p0_tr_item(W, DFF, DM, f ? A.in[19] : A.in[1], (bf16*)(ws + (f ? WS_WGU2 : WS_WGU1)), n0, 128 * pn + j, 32, kb, scr, lane); continue; }
        r -= 2 * I_GU;
        if (r < 2 * I_D) {
            const int f = r / I_D; r -= f * I_D; const int nblk = DM / 32, kb = r / nblk, nb = r % nblk;
            p0_tr_item(f ? A.in[22] : A.in[4], DM, DFF, nullptr, (bf16*)(ws + (f ? WS_WD2 : WS_WD1)), 32 * nb, 32 * nb, 32, kb, scr, lane); continue; }
        r -= 2 * I_D;
        if (r < I_IN) {
            const int nblk = NIN / 32, kb = r / nblk, nb = r % nblk, n0 = 32 * nb, pn = n0 >> 8, tc = n0 & 255;
            const int col = 256 * pn + 64 * ((tc >> 5) & 3) + 32 * (tc >> 7);
            int nv = INC - col; nv = nv < 0 ? 0 : (nv > 32 ? 32 : nv);
            p0_tr_item(A.in[6], INC, DM, A.in[5], (bf16*)(ws + WS_WIN), n0, col, nv, kb, scr, lane); continue; }
        r -= I_IN;
        if (r < I_OUT) { const int nblk = DM / 32, kb = r / nblk, nb = r % nblk;
            p0_tr_item(A.in[18], DM, DM, nullptr, (bf16*)(ws + WS_WOUT), 32 * nb, 32 * nb, 32, kb, scr, lane); continue; }
        r -= I_OUT;
        if (r < I_C1) { const int kv = r / (I_C1 / 2); r -= kv * (I_C1 / 2); const int nblk = 256 / 32, kb = r / nblk, nb = r % nblk;
            p0_tr_item(A.in[13] + (size_t)kv * 2048 * 256, 256, 2048, nullptr, (bf16*)(ws + WS_CW1) + (size_t)kv * 256 * 2048, 32 * nb, 32 * nb, 32, kb, scr, lane); continue; }
        r -= I_C1;
        if (r < I_WS) {
            const int e0 = (r * 64 + lane) * 8; const int s0 = e0 & 127, t = (e0 >> 7) & 127;
            const float* src = A.in[8] + e0; unsigned o[4];
#pragma unroll
            for (int i = 0; i < 4; ++i) { const float a = (s0 + 2 * i <= t) ? src[2 * i] : 0.f, b2 = (s0 + 2 * i + 1 <= t) ? src[2 * i + 1] : 0.f; o[i] = pk2(a, b2); }
            *(v4u*)((bf16*)(ws + WS_WSB) + e0) = (v4u){o[0], o[1], o[2], o[3]}; continue; }
        r -= I_WS;
        if (r >= I_CB) {
            r -= I_CB; const int e0 = (r * 64 + lane) * 8, kv = e0 >> 14, d = (e0 >> 8) & 63, j0 = e0 & 255;
            const float* src = A.in[15] + (size_t)kv * 256 * 64 + d; unsigned o[4];
#pragma unroll
            for (int i = 0; i < 4; ++i) o[i] = pk2(src[(size_t)(j0 + 2 * i) * 64], src[(size_t)(j0 + 2 * i + 1) * 64]);
            *(v4u*)((bf16*)(ws + WS_CW2) + e0) = (v4u){o[0], o[1], o[2], o[3]}; continue; }
        {
            const int kp = r & 7, jb = (r >> 3) & 3, kv = r >> 5, j = jb * 64 + lane;
            const float* pe = A.in[12] + (size_t)kv * 2048; const float* w1 = A.in[13] + (size_t)kv * 2048 * 256;
            float s = (kp == 0) ? A.in[14][kv * 256 + j] : 0.f;
            for (int k = kp * 256; k < kp * 256 + 256; ++k) s += pe[k] * w1[(size_t)k * 256 + j];
            ((float*)(ws + WS_CB1P))[kp * 512 + kv * 256 + j] = s;
        }
    }
    const float* x = A.in[0]; bf16* XB = (bf16*)(ws + WS_XB); float* SS0 = (float*)(ws + WS_SS0);
    for (int m = gw; m < MTOK; m += NGW) {
        const GAS f32x4* xr = (const GAS f32x4*)(x + (size_t)m * DM) + lane;
        GAS unsigned long long* o8 = (GAS unsigned long long*)(XB + (size_t)m * DM) + lane;
        float s = 0.f;
#pragma unroll
        for (int j = 0; j < 4; ++j) { const f32x4 v = xr[64 * j]; s += (v.x * v.x + v.y * v.y) + (v.z * v.z + v.w * v.w);
            o8[64 * j] = (unsigned long long)pk2(v.x, v.y) | ((unsigned long long)pk2(v.z, v.w) << 32); }
        s = wave_sum(s);
        if (lane < 16) SS0[(size_t)m * 16 + lane] = (lane == 0) ? s : 0.f;
    }
}

__device__ __forceinline__ void gmlp_unit(Frame& F, const Args& A, int unit) {
    typedef short bf16x8 __attribute__((ext_vector_type(8)));
    typedef float f32x16 __attribute__((ext_vector_type(16)));
    unsigned char* ws = A.ws;
    const int b = unit >> 5, c = unit & 31, r0 = b * SEQ + c * 128, lane = F.lane, h = F.wave, r = lane & 31, hh = lane >> 5;
    LAS float* rv = (LAS float*)(F.lds + RING_OFF);
    const float* SSV = (const float*)(ws + WS_SSV);
    if (F.tid < 128) { const f32x4 p0 = *(const f32x4*)(SSV + (size_t)(r0 + F.tid) * 8), p1 = *(const f32x4*)(SSV + (size_t)(r0 + F.tid) * 8 + 4);
        const float sm = ((p0[0] + p0[1]) + (p0[2] + p0[3])) + ((p1[0] + p1[1]) + (p1[2] + p1[3]));
        rv[F.tid] = rsq_acc(sm, 1.f / 512.f); }
    __syncthreads();
    const bf16* GVT = (const bf16*)(ws + WS_GVT) + ((size_t)(b * 8 + h) * 64) * SEQ + c * 128;
    const bf16* WSB = (const bf16*)(ws + WS_WSB) + (size_t)h * 128 * 128;
    bf16* Y = (bf16*)(ws + WS_Y);
    f32x16 acc[4][2];
#pragma unroll
    for (int tt = 0; tt < 4; ++tt)
#pragma unroll
        for (int dt = 0; dt < 2; ++dt)
#pragma unroll
            for (int i = 0; i < 16; ++i) acc[tt][dt][i] = 0.f;
#pragma unroll
    for (int ks = 0; ks < 8; ++ks) {
        const int s0 = 16 * ks + 8 * hh;
        bf16x8 vf[2];
        const f32x4 ra = *(const LAS f32x4*)(rv + s0), rb = *(const LAS f32x4*)(rv + s0 + 4);
#pragma unroll
        for (int dt = 0; dt < 2; ++dt) { const v4u raw = *(const v4u*)(GVT + (size_t)(32 * dt + r) * SEQ + s0);
            v4u o; o.x = pk2(__builtin_bit_cast(float, raw.x << 16) * ra[0], __builtin_bit_cast(float, raw.x & 0xffff0000u) * ra[1]);
            o.y = pk2(__builtin_bit_cast(float, raw.y << 16) * ra[2], __builtin_bit_cast(float, raw.y & 0xffff0000u) * ra[3]);
            o.z = pk2(__builtin_bit_cast(float, raw.z << 16) * rb[0], __builtin_bit_cast(float, raw.z & 0xffff0000u) * rb[1]);
            o.w = pk2(__builtin_bit_cast(float, raw.w << 16) * rb[2], __builtin_bit_cast(float, raw.w & 0xffff0000u) * rb[3]);
            vf[dt] = __builtin_bit_cast(bf16x8, o); }
#pragma unroll
        for (int tt = 0; tt < 4; ++tt) {
            if (16 * ks <= 32 * tt + 31) {
                const bf16x8 wf = *(const bf16x8*)(WSB + (size_t)(32 * tt + r) * 128 + s0);
#pragma unroll
                for (int dt = 0; dt < 2; ++dt) acc[tt][dt] = __builtin_amdgcn_mfma_f32_32x32x16_bf16(vf[dt], wf, acc[tt][dt], 0, 0, 0);
            }
        }
    }
    const float* gvn = A.in[7] + h * 64; const float* bs = A.in[9] + h * 128;
#pragma unroll
    for (int tt = 0; tt < 4; ++tt) {
        const int tl = 32 * tt + r; const float bt = bs[tl];
        bf16* yrow = Y + (size_t)(r0 + tl) * DM + h * 64;
#pragma unroll
        for (int dt = 0; dt < 2; ++dt)
#pragma unroll
            for (int q = 0; q < 4; ++q) { const int d = 32 * dt + 8 * q + 4 * hh;
                const f32x4 gg = *(const f32x4*)(gvn + d); const v2u uu = *(const v2u*)(yrow + d);
                const float o0 = __builtin_bit_cast(float, uu.x << 16) * (acc[tt][dt][4 * q] * gg[0] + bt), o1 = __builtin_bit_cast(float, uu.x & 0xffff0000u) * (acc[tt][dt][4 * q + 1] * gg[1] + bt);
                const float o2 = __builtin_bit_cast(float, uu.y << 16) * (acc[tt][dt][4 * q + 2] * gg[2] + bt), o3 = __builtin_bit_cast(float, uu.y & 0xffff0000u) * (acc[tt][dt][4 * q + 3] * gg[3] + bt);
                v2u wv; wv.x = pk2(o0, o1); wv.y = pk2(o2, o3); *(v2u*)(yrow + d) = wv; }
    }
    __syncthreads();
}
__device__ __forceinline__ void cmp2_unit(Frame& F, const Args& A, int pm) {
    typedef short bf16x8 __attribute__((ext_vector_type(8)));
    typedef float f32x16 __attribute__((ext_vector_type(16)));
    unsigned char* ws = A.ws;
    __threadfence(); __syncthreads();
    const int kv = pm >> 4, lane = F.lane, r = lane & 31, hh = lane >> 5;
    const int row = pm * 256 + F.wave * 32 + r;
    const bf16* H1 = (const bf16*)(ws + WS_H1) + (size_t)row * 256;
    const bf16* W2 = (const bf16*)(ws + WS_CW2) + (size_t)kv * 64 * 256;
    f32x16 acc[2];
#pragma unroll
    for (int i = 0; i < 16; ++i) { acc[0][i] = 0.f; acc[1][i] = 0.f; }
#pragma unroll
    for (int ks = 0; ks < 16; ++ks) {
        const bf16x8 hf = *(const bf16x8*)(H1 + 16 * ks + 8 * hh);
#pragma unroll
        for (int dt = 0; dt < 2; ++dt) { const bf16x8 wf = *(const bf16x8*)(W2 + (size_t)(32 * dt + r) * 256 + 16 * ks + 8 * hh);
            acc[dt] = __builtin_amdgcn_mfma_f32_32x32x16_bf16(wf, hf, acc[dt], 0, 0, 0); }
    }
    const float* b2 = A.in[16] + kv * 64; const float* kg0 = A.in[11];
    float sq = 0.f;
#pragma unroll
    for (int dt = 0; dt < 2; ++dt)
#pragma unroll
        for (int i = 0; i < 16; ++i) { const int d = 32 * dt + (i & 3) + 8 * (i >> 2) + 4 * hh; acc[dt][i] += b2[d]; sq += acc[dt][i] * acc[dt][i]; }
    const int n = row & 255, bg = (row & 4095) >> 8;
    if (kv == 0) {
        sq += __shfl_xor(sq, 32); const float rn = rsq_acc(sq, 1.f / 64.f);
        bf16* dst = (bf16*)(ws + WS_KCMP) + ((size_t)bg * 256 + n) * 64;
#pragma unroll
        for (int dt = 0; dt < 2; ++dt)
#pragma unroll
            for (int q = 0; q < 4; ++q) { const int d = 32 * dt + 8 * q + 4 * hh; const f32x4 gg = *(const f32x4*)(kg0 + d);
                v2u wv; wv.x = pk2(acc[dt][4 * q] * rn * gg[0], acc[dt][4 * q + 1] * rn * gg[1]); wv.y = pk2(acc[dt][4 * q + 2] * rn * gg[2], acc[dt][4 * q + 3] * rn * gg[3]);
                *(v2u*)(dst + d) = wv; }
    } else {
        bf16* dst = (bf16*)(ws + WS_VCMPT) + (size_t)bg * 64 * 256 + n;
#pragma unroll
        for (int dt = 0; dt < 2; ++dt)
#pragma unroll
            for (int i = 0; i < 16; ++i) { const int d = 32 * dt + (i & 3) + 8 * (i >> 2) + 4 * hh; dst[(size_t)d * 256] = (bf16)f2bf(acc[dt][i]); }
    }
}

namespace att {
typedef short bf16x8 __attribute__((ext_vector_type(8)));
typedef short s16x4 __attribute__((ext_vector_type(4)));
typedef float f32x16 __attribute__((ext_vector_type(16)));
typedef float f32x2_t __attribute__((ext_vector_type(2))); typedef __bf16 bf16x2_t __attribute__((ext_vector_type(2)));
constexpr int KROW = 144, VROW = 136, KBUF = 64 * KROW, VBUF = 64 * VROW;
constexpr int OFF_K = 0, OFF_V = 2 * KBUF, OFF_IMP = 36864, OFF_MSK = OFF_IMP + 8 * 2048, ATT_LDS = OFF_MSK + 512;
constexpr float NEGBIG = -30000.f;
__device__ __forceinline__ unsigned cvtpk(float lo, float hi) { f32x2_t v = {lo, hi}; bf16x2_t b = __builtin_convertvector(v, bf16x2_t); return __builtin_bit_cast(unsigned, b); }
__device__ __forceinline__ int crow(int r, int hi) { return (r & 3) + 8 * (r >> 2) + 4 * hi; }
__device__ __forceinline__ float xhalf(float x) { return __shfl_xor(x, 32); }
template <bool NEAR, bool CMP>
__device__ __forceinline__ void tile(const LAS unsigned char* Kb, const LAS unsigned char* Vb, const bf16x8 (&qf)[4], float cinit, bool rowsel, int t, int key0, int dmax,
                                     const LAS float* tblh, f32x16 (&O)[2], float& l, float (&u)[2][4], float& carry, int r, int hh) {
    f32x16 S[2];
#pragma unroll
    for (int a = 0; a < 2; ++a) {
#pragma unroll
        for (int i = 0; i < 16; ++i) S[a][i] = cinit;
#pragma unroll
        for (int kk = 0; kk < 4; ++kk) { const bf16x8 kf = *(const LAS bf16x8*)(Kb + (32 * a + r) * KROW + (2 * kk + hh) * 16);
            S[a] = __builtin_amdgcn_mfma_f32_32x32x16_bf16(kf, qf[kk], S[a], 0, 0, 0); }
    }
    float ls = 0.f;
#pragma unroll
    for (int a = 0; a < 2; ++a) {
#pragma unroll
        for (int i = 0; i < 16; ++i) {
            float pz;
            if (NEAR) { const int key = key0 + 32 * a + crow(i, hh); const int pos = CMP ? 16 * key + 31 : key; const int dist = t - pos;
                const bool valid = rowsel && dist >= 0 && dist <= dmax; int idx = dist < 0 ? 0 : (dist > 128 ? 128 : dist);
                pz = __builtin_amdgcn_exp2f(S[a][i] + tblh[idx]); pz = valid ? pz : 0.f; }
            else pz = __builtin_amdgcn_exp2f(S[a][i]);
            S[a][i] = pz; ls += pz;
        }
        if (CMP) {
            float e3[4], rq[4];
#pragma unroll
            for (int q = 0; q < 4; ++q) { e3[q] = S[a][4 * q + 3]; rq[q] = xhalf(e3[q]); }
#pragma unroll
            for (int q = 0; q < 4; ++q) { const float own = (S[a][4 * q] + S[a][4 * q + 1]) + (S[a][4 * q + 2] + S[a][4 * q + 3]);
                const float prev = hh ? rq[q] : (q > 0 ? rq[q - 1] : carry); u[a][q] = own + prev; }
            carry = rq[3];
        }
    }
    l += ls;
    bf16x8 pf[2][2];
#pragma unroll
    for (int a = 0; a < 2; ++a)
#pragma unroll
        for (int s2 = 0; s2 < 2; ++s2) { unsigned w0 = cvtpk(S[a][8 * s2 + 0], S[a][8 * s2 + 1]), w1 = cvtpk(S[a][8 * s2 + 2], S[a][8 * s2 + 3]), w2 = cvtpk(S[a][8 * s2 + 4], S[a][8 * s2 + 5]), w3 = cvtpk(S[a][8 * s2 + 6], S[a][8 * s2 + 7]);
            v4u w = {w0, w1, w2, w3}; pf[a][s2] = __builtin_bit_cast(bf16x8, w); }
#pragma unroll
    for (int dt = 0; dt < 2; ++dt)
#pragma unroll
        for (int a = 0; a < 2; ++a)
#pragma unroll
            for (int s2 = 0; s2 < 2; ++s2) { const LAS unsigned char* vp = Vb + (32 * dt + r) * VROW + (32 * a + 16 * s2 + 4 * hh) * 2;
                const s16x4 lo = *(const LAS s16x4*)vp, hi = *(const LAS s16x4*)(vp + 16);
                const bf16x8 vf = {lo[0], lo[1], lo[2], lo[3], hi[0], hi[1], hi[2], hi[3]};
                O[dt] = __builtin_amdgcn_mfma_f32_32x32x16_bf16(vf, pf[a][s2], O[dt], 0, 0, 0); }
}
}

__device__ __forceinline__ void attn_unit(Frame& F, const Args& A, int bg, int c) {
    using namespace att;
    unsigned char* ws = A.ws;
    const int tid = F.tid, lane = F.lane, w = F.wave, r = lane & 31, hh = lane >> 5, hg = r >> 3, qi = r & 7;
    const int b = bg >> 1, g = bg & 1, h = g * 4 + hg;
    const int t = 64 * c + 8 * w + qi; const size_t tok = (size_t)b * SEQ + t;
    LAS unsigned char* L = F.lds + RING_OFF;
    const LAS float* tblh = (const LAS float*)(F.lds + TBL_OFF) + h * 132;
    bf16* Y = (bf16*)(ws + WS_Y);
    bf16* yrow = Y + tok * DM + 512 + h * 64;
    bf16x8 qf[4];
#pragma unroll
    for (int kk = 0; kk < 4; ++kk) qf[kk] = *(const bf16x8*)(yrow + 16 * kk + 8 * hh);
    const float c31 = tblh[128];
    const float* gt = (const float*)(ws + WS_GATES) + tok * 24;
    const float g0 = gt[h], g1 = gt[8 + h], g2 = gt[16 + h];
    const int nc = (c >> 4) + 1, ns = c + 1, w0 = c > 8 ? c - 8 : 0, nw = c - w0 + 1, ntile = nc + ns + nw;
    const int srow = tid >> 3, sch = tid & 7;
    v4u kreg, vreg;
#define ATT_GLOAD(i) do { const int i_ = (i); const bf16* kp_; const bf16* vp_; size_t ldv_; \
        if (i_ < nc) { kp_ = (const bf16*)(ws + WS_KCMP) + ((size_t)bg * 256 + 64 * i_) * 64; vp_ = (const bf16*)(ws + WS_VCMPT) + (size_t)bg * 64 * 256 + 64 * i_; ldv_ = 256; } \
        else if (i_ < nc + ns) { const int j_ = i_ - nc; kp_ = (const bf16*)(ws + WS_KS) + ((size_t)bg * SEQ + 64 * j_) * 64; vp_ = (const bf16*)(ws + WS_VST) + (size_t)bg * 64 * SEQ + 64 * j_; ldv_ = SEQ; } \
        else { const int j_ = w0 + i_ - nc - ns; kp_ = (const bf16*)(ws + WS_KW) + ((size_t)bg * SEQ + 64 * j_) * 64; vp_ = (const bf16*)(ws + WS_VWT) + (size_t)bg * 64 * SEQ + 64 * j_; ldv_ = SEQ; } \
        kreg = *(const v4u*)(kp_ + srow * 64 + sch * 8); vreg = *(const v4u*)(vp_ + (size_t)srow * ldv_ + sch * 8); } while (0)
#define ATT_SWRITE(buf) do { *(LAS v4u*)(L + OFF_K + (buf) * KBUF + srow * KROW + sch * 16) = kreg; \
        LAS unsigned char* vd_ = L + OFF_V + (buf) * VBUF + srow * VROW + sch * 16; *(LAS v2u*)vd_ = (v2u){vreg.x, vreg.y}; *(LAS v2u*)(vd_ + 8) = (v2u){vreg.z, vreg.w}; } while (0)
#define ATT_NEXT(i) do { if ((i) + 1 < ntile) ATT_GLOAD((i) + 1); } while (0)
#define ATT_FLIP(i) do { if ((i) + 1 < ntile) ATT_SWRITE(((i) + 1) & 1); __syncthreads(); } while (0)
    ATT_GLOAD(0); ATT_SWRITE(0); __syncthreads();
    f32x16 out[2], O[2];
#pragma unroll
    for (int i = 0; i < 16; ++i) { out[0][i] = 0.f; out[1][i] = 0.f; O[0][i] = 0.f; O[1][i] = 0.f; }
    float l = 0.f, carry = 0.f, dummy_u[2][4];
    int it = 0;
    float u[4][2][4];
#pragma unroll
    for (int i = 0; i < 4; ++i)
#pragma unroll
        for (int a = 0; a < 2; ++a)
#pragma unroll
            for (int q = 0; q < 4; ++q) u[i][a][q] = 0.f;
#pragma unroll
    for (int i = 0; i < 4; ++i) {
        if (i < nc) {
            ATT_NEXT(it);
            const LAS unsigned char* Kb = L + OFF_K + (it & 1) * KBUF; const LAS unsigned char* Vb = L + OFF_V + (it & 1) * VBUF;
            const bool far = 64 * c >= 1024 * i + 1167;
            if (far) tile<false, true>(Kb, Vb, qf, c31, true, t, 64 * i, 1 << 30, tblh, O, l, u[i], carry, r, hh);
            else tile<true, true>(Kb, Vb, qf, 0.f, true, t, 64 * i, 1 << 30, tblh, O, l, u[i], carry, r, hh);
            ATT_FLIP(it); ++it;
        }
    }
    unsigned long long mask;
    {
        const float lt = l + xhalf(l); const float linv = lt > 0.f ? 1.f / lt : 0.f; const float sc = g0 * linv;
#pragma unroll
        for (int i = 0; i < 16; ++i) { out[0][i] += sc * O[0][i]; out[1][i] += sc * O[1][i]; O[0][i] = 0.f; O[1][i] = 0.f; }
        LAS float* impw = (LAS float*)(L + OFF_IMP + w * 2048);
#pragma unroll
        for (int i = 0; i < 4; ++i)
#pragma unroll
            for (int a = 0; a < 2; ++a)
#pragma unroll
                for (int q = 0; q < 4; ++q) {
                    float x = u[i][a][q] * linv; x += __shfl_xor(x, 8); x += __shfl_xor(x, 16);
                    const int j = 8 * (2 * i + a) + 2 * q + hh;
                    const bool forced = (j == 0) || (j == c) || (j == c - 1);
                    x = (j <= c) ? (forced ? 1e6f : x) : -1.f;
                    const unsigned bits = (__builtin_bit_cast(unsigned, x) & ~63u) | (unsigned)(63 - j);
                    if (hg == 0) impw[qi * 64 + j] = __builtin_bit_cast(float, bits);
                }
        LDS_WAIT(); asm volatile("" ::: "memory");
        const int q2 = lane >> 3, part = lane & 7;
        const LAS float* iq = impw + q2 * 64;
        float mine[8]; int cnt[8];
        { const f32x4 m0 = *(const LAS f32x4*)(iq + 8 * part), m1 = *(const LAS f32x4*)(iq + 8 * part + 4);
#pragma unroll
          for (int i = 0; i < 4; ++i) { mine[i] = m0[i]; mine[4 + i] = m1[i]; cnt[i] = 0; cnt[4 + i] = 0; } }
#pragma unroll
        for (int k = 0; k < 16; ++k) { const f32x4 v = *(const LAS f32x4*)(iq + 4 * k);
#pragma unroll
            for (int e = 0; e < 4; ++e)
#pragma unroll
                for (int i = 0; i < 8; ++i) cnt[i] += (v[e] > mine[i]) ? 1 : 0; }
        unsigned byte = 0;
#pragma unroll
        for (int i = 0; i < 8; ++i) byte |= (cnt[i] < 16) ? (1u << i) : 0u;
        LAS unsigned char* mw = (LAS unsigned char*)(L + OFF_MSK + w * 64);
        mw[q2 * 8 + part] = (unsigned char)byte;
        LDS_WAIT(); asm volatile("" ::: "memory");
        mask = *(const LAS unsigned long long*)(mw + qi * 8);
        l = 0.f;
    }
    unsigned long long uni = 0;
#pragma unroll
    for (int q = 0; q < 8; ++q) { uni |= (unsigned long long)(unsigned)__builtin_amdgcn_readlane((int)(unsigned)mask, q) | ((unsigned long long)(unsigned)__builtin_amdgcn_readlane((int)(unsigned)(mask >> 32), q) << 32); }
#pragma unroll 1
    for (int j = 0; j <= c; ++j) {
        ATT_NEXT(it);
        if ((uni >> j) & 1ull) {
            const LAS unsigned char* Kb = L + OFF_K + (it & 1) * KBUF; const LAS unsigned char* Vb = L + OFF_V + (it & 1) * VBUF;
            const bool rs = (mask >> j) & 1ull;
            if (j <= c - 3) tile<false, false>(Kb, Vb, qf, rs ? c31 : NEGBIG, true, t, 64 * j, 1 << 30, tblh, O, l, dummy_u, carry, r, hh);
            else tile<true, false>(Kb, Vb, qf, 0.f, rs, t, 64 * j, 1 << 30, tblh, O, l, dummy_u, carry, r, hh);
        }
        ATT_FLIP(it); ++it;
    }
    {
        const float lt = l + xhalf(l); const float sc = lt > 0.f ? g1 / lt : 0.f;
#pragma unroll
        for (int i = 0; i < 16; ++i) { out[0][i] += sc * O[0][i]; out[1][i] += sc * O[1][i]; O[0][i] = 0.f; O[1][i] = 0.f; }
        l = 0.f;
    }
#pragma unroll 1
    for (int j = w0; j <= c; ++j) {
        ATT_NEXT(it);
        const LAS unsigned char* Kb = L + OFF_K + (it & 1) * KBUF; const LAS unsigned char* Vb = L + OFF_V + (it & 1) * VBUF;
        if (j <= c - 3 && j != c - 8) tile<false, false>(Kb, Vb, qf, c31, true, t, 64 * j, 511, tblh, O, l, dummy_u, carry, r, hh);
        else tile<true, false>(Kb, Vb, qf, 0.f, true, t, 64 * j, 511, tblh, O, l, dummy_u, carry, r, hh);
        ATT_FLIP(it); ++it;
    }
    {
        const float lt = l + xhalf(l); const float sc = lt > 0.f ? g2 / lt : 0.f;
#pragma unroll
        for (int i = 0; i < 16; ++i) { out[0][i] += sc * O[0][i]; out[1][i] += sc * O[1][i]; }
    }
#pragma unroll
    for (int dt = 0; dt < 2; ++dt)
#pragma unroll
        for (int q = 0; q < 4; ++q) { v2u wv; wv.x = cvtpk(out[dt][4 * q], out[dt][4 * q + 1]); wv.y = cvtpk(out[dt][4 * q + 2], out[dt][4 * q + 3]);
            *(v2u*)(yrow + 32 * dt + 8 * q + 4 * hh) = wv; }
    __syncthreads();
#undef ATT_GLOAD
#undef ATT_SWRITE
#undef ATT_NEXT
#undef ATT_FLIP
}

__global__ void __launch_bounds__(NWAVES * 64, 2) mk_fwd(Args args) {
    extern __shared__ __attribute__((aligned(16))) unsigned char lds[];
    Frame F;
    F.lds = (LAS unsigned char*)lds;
    F.MISC = (volatile LAS unsigned*)(F.lds + MISC_OFF);
    F.tid = threadIdx.x; F.lane = F.tid & 63; F.wave = __builtin_amdgcn_readfirstlane(F.tid >> 6);
    F.G = gridDim.x; { const int bx = blockIdx.x; F.vcu = (F.G % 8 == 0) ? (bx % 8) * (F.G / 8) + bx / 8 : bx; }
    unsigned char* ws = args.ws;
    F.ctl = (gu32*)(ws + WS_CTL);
    for (int u = F.tid; u < (LDS_BYTES - LDSCTL_OFF) / 4; u += NWAVES * 64) ((LAS unsigned*)(F.lds + LDSCTL_OFF))[u] = 0u;
    __syncthreads();
    if (F.tid < 128) { const int n = F.tid; int bkt = n;
        if (n >= 16) { const float nf = (float)n; int large = 16 + (int)(logf(nf / 16.f) / logf(8.f) * 16.f); bkt = large < 31 ? large : 31; }
        ((LAS unsigned char*)(F.lds + TB_OFF))[n] = (unsigned char)bkt; }
    __syncthreads();
    for (int e = F.tid; e < 8 * 129; e += NWAVES * 64) { const int hh_ = e / 129, x = e % 129; const int bk = x < 128 ? ((LAS unsigned char*)(F.lds + TB_OFF))[x] : 31;
        ((LAS float*)(F.lds + TBL_OFF))[hh_ * 132 + x] = args.in[17][hh_ * 32 + bk] * 1.4426950408889634f; }
    __syncthreads();
    XcdBarrier bar; bar.bar = (unsigned*)(F.ctl + CW_BAR) + args.li * XCD_BAR_WORDS; bar.x = 0; bar.st = nullptr;
    if (N_LAUNCHES != PER_PHASE) bar = xcd_barrier_post((unsigned*)(F.ctl + CW_BAR) + args.li * XCD_BAR_WORDS, F.MISC + 8);
#define GRID_BAR() do { if (N_LAUNCHES != PER_PHASE) xcd_barrier(bar); } while (0)
    const int lo = args.ph_lo, hi = args.ph_hi;
#define IN(k) (lo <= (k) && (k) < hi)
#define BOTH(k) (IN(k) && IN((k) + 1))
    bf16* XB = (bf16*)(ws + WS_XB); bf16* ACT = (bf16*)(ws + WS_ACT); bf16* Y = (bf16*)(ws + WS_Y);
    float* SS0 = (float*)(ws + WS_SS0); float* SS1 = (float*)(ws + WS_SS1); float* SS2 = (float*)(ws + WS_SS2); float* SS3 = (float*)(ws + WS_SS3);

    if (IN(0)) { p0_prologue(F, args); if (BOTH(0)) GRID_BAR(); }
    if (IN(1)) {
        pg8::Gemm g{XB, (const bf16*)(ws + WS_WGU1), MTOK, NGU, DM, DM, DM}; pg8::StaticOrder S; S.init(MTOK, NGU, F.G, (int)blockIdx.x);
        EpiSwiGLU E{SS0, ACT};
        pg8::gemm_phase<EpiSwiGLU, pg8::StaticOrder, true, true>(F.lds + RING_OFF, g, S, E);
        if (BOTH(1)) GRID_BAR();
    }
    if (IN(2)) {
        pg8::Gemm g{ACT, (const bf16*)(ws + WS_WD1), MTOK, DM, DFF, DFF, DFF}; pg8::StaticOrder S; S.init(MTOK, DM, F.G, (int)blockIdx.x);
        EpiResid E{args.in[0], args.out, XB, SS1, 0.5f};
        pg8::gemm_phase<EpiResid, pg8::StaticOrder, true, true>(F.lds + RING_OFF, g, S, E);
        if (BOTH(2)) GRID_BAR();
    }
    if (IN(3)) {
        pg8::Gemm g{XB, (const bf16*)(ws + WS_WIN), MTOK, NIN, DM, DM, DM}; pg8::StaticOrder S; S.init(MTOK, NIN, F.G, (int)blockIdx.x);
        EpiMix E{SS1, Y, (bf16*)(ws + WS_GVT), (float*)(ws + WS_SSV), (bf16*)(ws + WS_KCR), (bf16*)(ws + WS_VCR), (bf16*)(ws + WS_KS), (bf16*)(ws + WS_VST),
                 (bf16*)(ws + WS_KW), (bf16*)(ws + WS_VWT), (float*)(ws + WS_GATES), args.in[10], args.in[11]};
        pg8::gemm_phase<EpiMix, pg8::StaticOrder, true, true>(F.lds + RING_OFF, g, S, E);
        if (BOTH(3)) GRID_BAR();
    }
    if (IN(4)) {
        {
            pg8::Gemm g{(const bf16*)(ws + WS_KCR), (const bf16*)(ws + WS_CW1), 8192, 512, 2048, 1024, 2048}; pg8::CmpOrder S{(int)blockIdx.x};
            EpiCmp E{(const float*)(ws + WS_CB1P), (bf16*)(ws + WS_H1)};
            pg8::gemm_phase<EpiCmp, pg8::CmpOrder, false, true>(F.lds + RING_OFF, g, S, E);
            if (blockIdx.x < 32) cmp2_unit(F, args, (int)blockIdx.x);
            __syncthreads();
        }
        for (int u = F.vcu; u < 256; u += F.G) gmlp_unit(F, args, u);
        if (BOTH(4)) GRID_BAR();
    }
    if (IN(5)) {
#pragma unroll 1
        for (int n = F.vcu; n < NBG * 64; n += F.G) { const int v = n & 255, i = n >> 8, x = v >> 5, lv = v & 31; attn_unit(F, args, 2 * x + (i & 1), i < 2 ? 63 - lv : lv); }
        if (BOTH(5)) GRID_BAR();
    }
    if (IN(6)) {
        pg8::Gemm g{Y, (const bf16*)(ws + WS_WOUT), MTOK, DM, DM, DM, DM}; pg8::StaticOrder S; S.init(MTOK, DM, F.G, (int)blockIdx.x);
        EpiResid E{args.out, args.out, XB, SS2, 1.0f};
        pg8::gemm_phase<EpiResid, pg8::StaticOrder, true, true>(F.lds + RING_OFF, g, S, E);
        if (BOTH(6)) GRID_BAR();
    }
    if (IN(7)) {
        pg8::Gemm g{XB, (const bf16*)(ws + WS_WGU2), MTOK, NGU, DM, DM, DM}; pg8::StaticOrder S; S.init(MTOK, NGU, F.G, (int)blockIdx.x);
        EpiSwiGLU E{SS2, ACT};
        pg8::gemm_phase<EpiSwiGLU, pg8::StaticOrder, true, true>(F.lds + RING_OFF, g, S, E);
        if (BOTH(7)) GRID_BAR();
    }
    if (IN(8)) {
        pg8::Gemm g{ACT, (const bf16*)(ws + WS_WD2), MTOK, DM, DFF, DFF, DFF}; pg8::StaticOrder S; S.init(MTOK, DM, F.G, (int)blockIdx.x);
        EpiResid E{args.out, args.out, nullptr, SS3, 0.5f};
        pg8::gemm_phase<EpiResid, pg8::StaticOrder, true, true>(F.lds + RING_OFF, g, S, E);
        if (BOTH(8)) GRID_BAR();
    }
    if (IN(9)) {
        const int gw = F.vcu * NWAVES + F.wave, NGW = F.G * NWAVES; const float* gf = args.in[23];
        for (int m = gw; m < MTOK; m += NGW) {
            float s = (F.lane < 16) ? SS3[(size_t)m * 16 + F.lane] : 0.f; s = wave_sum(s);
            const float ri = rsq_acc(s, 1.f / DM);
            GAS f32x4* xr = (GAS f32x4*)(args.out + (size_t)m * DM) + F.lane;
#pragma unroll
            for (int j = 0; j < 4; ++j) { f32x4 v = xr[64 * j]; const f32x4 gg = *((const f32x4*)gf + F.lane + 64 * j); v = v * ri * gg; xr[64 * j] = v; }
        }
    }
#undef IN
#undef BOTH
#undef GRID_BAR
}

extern "C" void kernel_launch(void* const* d_in, const int* in_sizes, int n_in, void* d_out, int out_size, void* d_ws, size_t ws_size, hipStream_t stream) {
    static int grid = 0;
    if (grid == 0) {
        if (n_in != 24 || in_sizes[0] != MTOK * DM || out_size != MTOK * DM || ws_size < WS_END) { fprintf(stderr, "kernel_launch: unexpected shapes (n_in %d, in0 %d, out %d, ws %zu)\n", n_in, n_in > 0 ? in_sizes[0] : -1, out_size, ws_size); grid = -1; return; }
        int dev = 0, cus = 0, per_cu = 0;
        if (hipGetDevice(&dev) != hipSuccess || hipDeviceGetAttribute(&cus, hipDeviceAttributeMultiprocessorCount, dev) != hipSuccess) { grid = -1; return; }
        if (hipFuncSetAttribute((const void*)mk_fwd, hipFuncAttributeMaxDynamicSharedMemorySize, LDS_BYTES) != hipSuccess) { fprintf(stderr, "kernel_launch: hipFuncSetAttribute failed\n"); grid = -1; return; }
        if (hipOccupancyMaxActiveBlocksPerMultiprocessor(&per_cu, (const void*)mk_fwd, NWAVES * 64, LDS_BYTES) != hipSuccess || per_cu < 1) { fprintf(stderr, "kernel_launch: occupancy query says %d blocks per CU\n", per_cu); (void)hipGetLastError(); grid = -1; return; }
        grid = cus;
    }
    if (grid < 0) return;
    (void)hipMemsetAsync((char*)d_ws + WS_CTL, 0, CTL_ZERO_BYTES, stream);
    Args a{};
    for (int i = 0; i < 24; ++i) a.in[i] = (const float*)d_in[i];
    a.out = (float*)d_out; a.ws = (unsigned char*)d_ws;
    if (N_LAUNCHES == 1) {
        a.ph_lo = 0; a.ph_hi = PER_PHASE; a.li = 0;
        void* kargs[] = {&a};
        hipError_t e = hipLaunchCooperativeKernel((const void*)mk_fwd, dim3(grid), dim3(NWAVES * 64), kargs, LDS_BYTES, stream);
        if (e != hipSuccess) fprintf(stderr, "kernel_launch: cooperative launch failed: %s (grid %d)\n", hipGetErrorString(e), grid);
    } else {
        for (int li = 0; li < PER_PHASE; ++li) { a.ph_lo = li; a.ph_hi = li + 1; a.li = 0;
            hipLaunchKernelGGL(mk_fwd, dim3(grid), dim3(NWAVES * 64), LDS_BYTES, stream, a); }
    }
}
```

```cpp
#include <hip/hip_runtime.h>
#include <cstdio>
#include <cstdint>

#ifndef DBG_REP
#define DBG_REP -1
#endif
#ifndef DBG_TW
#define DBG_TW 0
#endif
#ifndef DBG_T
#define DBG_T 0
#endif
#define NREP(k) for (int rep_ = 0; rep_ < ((DBG_REP) == (k) ? 2 : 1); ++rep_)
#ifndef MK_N_LAUNCHES
#define MK_N_LAUNCHES 1
#endif

namespace pg8 {
#define PG8_LAS __attribute__((address_space(3)))
typedef unsigned short bf16_t;
typedef short bf16x8 __attribute__((ext_vector_type(8)));
typedef float f32x4 __attribute__((ext_vector_type(4)));
typedef unsigned u32x4 __attribute__((ext_vector_type(4)));
typedef unsigned u32x2 __attribute__((ext_vector_type(2)));
constexpr int BM = 256, BK = 64, HALF = 128, HTB = HALF * BK * 2, STAGE_BYTES = 8 * HTB, NXCD = 8, WGM = 8;

__host__ __device__ __forceinline__ int lds_byte(int r, int c) { const int st = (r >> 4) * 2 + (c >> 5), rr = r & 15, cc = c & 31, ob = rr * 64 + cc * 2; return st * 1024 + (ob ^ (((ob >> 9) & 1) << 5)); }
__host__ __device__ __forceinline__ void stage_rc(int b, int& R, int& C) { const int st = b / 1024, sb = b % 1024, swz = sb ^ (((sb >> 9) & 1) << 5); R = (st >> 1) * 16 + swz / 64; C = (st & 1) * 32 + (swz % 64) / 2; }
__host__ __device__ __forceinline__ int perm32(int rho) { const int n = rho >> 4, i = rho & 15; return 8 * (i >> 2) + 4 * n + (i & 3); }

struct Unit { int pm, pn; };
struct Gemm { const bf16_t* A; const bf16_t* Bt; int M, N, K, lda, ldb; };

struct StaticOrder {
    int nM, nN, nwg, G, c;
    __host__ __device__ void init(int M, int N, int G_, int c_) { nM = M / BM; nN = N / BM; nwg = nM * nN; G = G_; c = c_; }
    __host__ __device__ bool next(int i, Unit& u) const {
        const long L = (long)i * G + c; if (L >= nwg) return false;
        int wgid = (int)L; { const int q = nwg / NXCD, r = nwg % NXCD, xcd = wgid % NXCD, off = wgid / NXCD; wgid = (xcd < r ? xcd * (q + 1) : r * (q + 1) + (xcd - r) * q) + off; }
        const int nig = WGM * nN, gid = wgid / nig, fm = gid * WGM, gsz = (nM - fm) < WGM ? (nM - fm) : WGM;
        u.pm = fm + ((wgid % nig) % gsz); u.pn = (wgid % nig) / gsz; return true;
    }
};
struct CmpOrder {
    int c;
    __device__ bool next(int i, Unit& u) const { if (i != 0 || c >= 32) return false; u.pm = c; u.pn = c >> 4; return true; }
};

__device__ __forceinline__ unsigned cvt_pk_bf16(float lo, float hi) { unsigned r; asm volatile("v_cvt_pk_bf16_f32 %0, %1, %2" : "=v"(r) : "v"(lo), "v"(hi)); return r; }

template <class Epi, class Sched, bool ALIGN_EPI = false, bool SP2 = false>
__device__ __forceinline__ void gemm_phase(PG8_LAS unsigned char* lds, const Gemm g, const Sched& S, const Epi& E) {
    const int tid = threadIdx.x, wid = __builtin_amdgcn_readfirstlane(tid >> 6), lane = tid & 63, wr = wid >> 2, wc = wid & 3, fr = lane & 15, fq = lane >> 4;
    const int K = g.K, nt = K / BK;
    unsigned voffA[2], voffB[2];
#pragma unroll
    for (int i = 0; i < 2; ++i) { int R, C; stage_rc(tid * 16 + i * 8192, R, C); const int Rb = Epi::PERM ? ((R & ~31) + perm32(R & 31)) : R;
        voffA[i] = (unsigned)(R * g.lda + C) * 2u; voffB[i] = (unsigned)(Rb * g.ldb + C) * 2u; }
    const size_t kstep = (size_t)(BK * 2);
    const size_t hstepA = (size_t)HALF * g.lda * 2, hstepB = (size_t)HALF * g.ldb * 2;
    const size_t tstepA = 2 * hstepA, tstepB = 2 * hstepB;
    const unsigned ldsw = (unsigned)wid * 1024u;
    const int aoff = lds_byte(wr * 64 + fr, fq * 8), boff = lds_byte(wc * 32 + fr, fq * 8);
#define PG8_SA(b, h) (((b) * 2 + (h)) * HTB)
#define PG8_SB(b, h) ((4 + (b) * 2 + (h)) * HTB)
#define PG8_STAGE(bufoff, gbase, voff) do { _Pragma("unroll") for (int _i = 0; _i < 2; ++_i) \
        __builtin_amdgcn_global_load_lds((const unsigned*)((const char*)(gbase) + (voff)[_i]), (PG8_LAS unsigned*)(lds + (bufoff) + ldsw + _i * 8192), 16, 0, 0); } while (0)
#define PG8_LDA(dst, b, h) do { _Pragma("unroll") for (int m = 0; m < 4; ++m) _Pragma("unroll") for (int k = 0; k < 2; ++k) dst[m][k] = *(const PG8_LAS bf16x8*)(lds + PG8_SA(b, h) + aoff + m * 2048 + k * 1024); } while (0)
#define PG8_LDB(dst, b, h) do { _Pragma("unroll") for (int n = 0; n < 2; ++n) _Pragma("unroll") for (int k = 0; k < 2; ++k) dst[n][k] = *(const PG8_LAS bf16x8*)(lds + PG8_SB(b, h) + boff + n * 2048 + k * 1024); } while (0)
#define PG8_MMA(ai, bj, At, Bt) do { __builtin_amdgcn_s_setprio(1); _Pragma("unroll") for (int m = 0; m < 4; ++m) _Pragma("unroll") for (int n = 0; n < 2; ++n) _Pragma("unroll") for (int k = 0; k < 2; ++k) \
        acc[ai][bj][m][n] = __builtin_amdgcn_mfma_f32_16x16x32_bf16(Bt[n][k], At[m][k], acc[ai][bj][m][n], 0, 0, 0); __builtin_amdgcn_s_setprio(0); } while (0)
#define PG8_WAIT_V(n) asm volatile("s_waitcnt vmcnt(" #n ")" ::: "memory")
#define PG8_WAIT_L(n) asm volatile("s_waitcnt lgkmcnt(" #n ")" ::: "memory")
#define PG8_BAR __builtin_amdgcn_s_barrier()
#define PG8_SCHED __builtin_amdgcn_sched_barrier(0)
    Unit cur, nxt; int ui = 0;
    if (!S.next(0, cur)) return;
    f32x4 acc[2][2][4][2];
#pragma unroll
    for (int a = 0; a < 2; ++a)
#pragma unroll
        for (int b = 0; b < 2; ++b)
#pragma unroll
            for (int m = 0; m < 4; ++m)
#pragma unroll
                for (int n = 0; n < 2; ++n) acc[a][b][m][n] = (f32x4){0.f, 0.f, 0.f, 0.f};
    bf16x8 At[4][2], B0[2][2], B1[2][2];
    const char* cA = (const char*)g.A + (size_t)cur.pm * tstepA; const char* cB = (const char*)g.Bt + (size_t)cur.pn * tstepB;
    if constexpr (SP2) {
        PG8_STAGE(PG8_SB(0, 0), cB, voffB); PG8_STAGE(PG8_SB(0, 1), cB + hstepB, voffB); PG8_STAGE(PG8_SA(0, 0), cA, voffA); PG8_STAGE(PG8_SA(0, 1), cA + hstepA, voffA);
        if (wr == 1) PG8_BAR;
        PG8_WAIT_V(2); PG8_BAR;
        PG8_STAGE(PG8_SB(1, 0), cB + kstep, voffB); PG8_STAGE(PG8_SA(1, 0), cA + kstep, voffA); PG8_STAGE(PG8_SB(1, 1), cB + hstepB + kstep, voffB);
        PG8_WAIT_V(6); PG8_BAR;
    } else {
        PG8_STAGE(PG8_SB(0, 0), cB, voffB); PG8_STAGE(PG8_SA(0, 0), cA, voffA); PG8_STAGE(PG8_SB(0, 1), cB + hstepB, voffB); PG8_STAGE(PG8_SA(0, 1), cA + hstepA, voffA);
        if (wr == 1) PG8_BAR;
        PG8_WAIT_V(4); PG8_BAR;
        PG8_STAGE(PG8_SB(1, 0), cB + kstep, voffB); PG8_STAGE(PG8_SA(1, 0), cA + kstep, voffA); PG8_STAGE(PG8_SB(1, 1), cB + hstepB + kstep, voffB);
        PG8_WAIT_V(6); PG8_BAR;
    }
    for (;;) {
        const bool has_next = S.next(ui + 1, nxt);
        const char* nA = has_next ? (const char*)g.A + (size_t)nxt.pm * tstepA : cA; const char* nB = has_next ? (const char*)g.Bt + (size_t)nxt.pn * tstepB : cB;
        for (int t = 0; t < nt; t += 2) {
            const bool last = (t == nt - 2);
            const char* a1 = cA + (size_t)(t + 1) * kstep;
            const char* a2 = last ? nA : cA + (size_t)(t + 2) * kstep; const char* b2 = last ? nB : cB + (size_t)(t + 2) * kstep;
            const char* a3 = a2 + kstep; const char* b3 = b2 + kstep;
            if constexpr (SP2) {
            PG8_LDB(B0, 0, 0); PG8_LDB(B1, 0, 1); PG8_SCHED; PG8_LDA(At, 0, 0); PG8_STAGE(PG8_SA(1, 1), a1 + hstepA, voffA);
            PG8_WAIT_V(8); PG8_WAIT_L(0); PG8_BAR; PG8_MMA(0, 0, At, B0); PG8_MMA(0, 1, At, B1); PG8_BAR; PG8_SCHED;
            PG8_LDA(At, 0, 1); PG8_STAGE(PG8_SB(0, 0), b2, voffB); PG8_STAGE(PG8_SB(0, 1), b2 + hstepB, voffB); PG8_STAGE(PG8_SA(0, 0), a2, voffA);
            PG8_WAIT_V(8); PG8_WAIT_L(0); PG8_BAR; PG8_MMA(1, 0, At, B0); PG8_MMA(1, 1, At, B1); PG8_BAR; PG8_SCHED;
            PG8_LDB(B0, 1, 0); PG8_LDB(B1, 1, 1); PG8_SCHED; PG8_LDA(At, 1, 0); PG8_STAGE(PG8_SA(0, 1), a2 + hstepA, voffA);
            PG8_WAIT_V(8); PG8_WAIT_L(0); PG8_BAR; PG8_MMA(0, 0, At, B0); PG8_MMA(0, 1, At, B1); PG8_BAR; PG8_SCHED;
            PG8_LDA(At, 1, 1); PG8_STAGE(PG8_SB(1, 0), b3, voffB); PG8_STAGE(PG8_SB(1, 1), b3 + hstepB, voffB); PG8_STAGE(PG8_SA(1, 0), a3, voffA);
            PG8_WAIT_V(8); PG8_WAIT_L(0); PG8_BAR; PG8_MMA(1, 0, At, B0); PG8_MMA(1, 1, At, B1); PG8_BAR; PG8_SCHED;
            } else {
            PG8_LDB(B0, 0, 0); PG8_SCHED; PG8_LDA(At, 0, 0); PG8_STAGE(PG8_SA(1, 1), a1 + hstepA, voffA);
            PG8_WAIT_L(8); PG8_BAR; PG8_WAIT_L(0); PG8_MMA(0, 0, At, B0); PG8_BAR; PG8_SCHED;
            PG8_LDB(B1, 0, 1); PG8_STAGE(PG8_SB(0, 0), b2, voffB);
            PG8_BAR; PG8_WAIT_L(0); PG8_MMA(0, 1, At, B1); PG8_BAR;
            PG8_LDA(At, 0, 1); PG8_STAGE(PG8_SA(0, 0), a2, voffA);
            PG8_BAR; PG8_WAIT_L(0); PG8_MMA(1, 0, At, B0); PG8_BAR; PG8_SCHED;
            PG8_STAGE(PG8_SB(0, 1), b2 + hstepB, voffB);
            PG8_WAIT_V(6); PG8_BAR; PG8_MMA(1, 1, At, B1); PG8_BAR;
            PG8_LDB(B0, 1, 0); PG8_SCHED; PG8_LDA(At, 1, 0); PG8_STAGE(PG8_SA(0, 1), a2 + hstepA, voffA);
            PG8_WAIT_L(8); PG8_BAR; PG8_WAIT_L(0); PG8_MMA(0, 0, At, B0); PG8_BAR; PG8_SCHED;
            PG8_LDB(B1, 1, 1); PG8_STAGE(PG8_SB(1, 0), b3, voffB);
            PG8_BAR; PG8_WAIT_L(0); PG8_MMA(0, 1, At, B1); PG8_BAR;
            PG8_LDA(At, 1, 1); PG8_STAGE(PG8_SA(1, 0), a3, voffA);
            PG8_BAR; PG8_WAIT_L(0); PG8_MMA(1, 0, At, B0); PG8_BAR; PG8_SCHED;
            PG8_STAGE(PG8_SB(1, 1), b3 + hstepB, voffB);
            PG8_WAIT_V(6); PG8_BAR; PG8_MMA(1, 1, At, B1); PG8_BAR;
            }
        }
        if constexpr (ALIGN_EPI) { if (wr == 0) PG8_BAR; }
        E(acc, cur, wr, wc, fr, fq);
        if (!has_next) break;
#pragma unroll
        for (int a = 0; a < 2; ++a)
#pragma unroll
            for (int b = 0; b < 2; ++b)
#pragma unroll
                for (int m = 0; m < 4; ++m)
#pragma unroll
                    for (int n = 0; n < 2; ++n) acc[a][b][m][n] = (f32x4){0.f, 0.f, 0.f, 0.f};
        cur = nxt; cA = nA; cB = nB; ++ui;
        if constexpr (ALIGN_EPI) { if (wr == 1) PG8_BAR; }
    }
    PG8_WAIT_V(0);
    if constexpr (!ALIGN_EPI) { if (wr == 0) PG8_BAR; }
    PG8_BAR;
#undef PG8_SA
#undef PG8_SB
#undef PG8_STAGE
#undef PG8_LDA
#undef PG8_LDB
#undef PG8_MMA
#undef PG8_WAIT_V
#undef PG8_WAIT_L
#undef PG8_BAR
#undef PG8_SCHED
}
}

constexpr int NWAVES = 8;
constexpr int BATCH = 8, SEQ = 4096, DM = 1024, MTOK = BATCH * SEQ;
constexpr int DFF = 2816, NGU = 2 * DFF, INC = 2328, NIN = 2560;
constexpr int HD = 64, NBG = 16, NCMP = 255;
constexpr float EPS = 1e-6f;
constexpr int PER_PHASE = 10;
constexpr int N_LAUNCHES = MK_N_LAUNCHES;

constexpr size_t MiB = 1u << 20;
constexpr size_t WS_CTL = 0, CTL_ZERO_BYTES = 1 * MiB;
constexpr size_t WS_WGU1 = 2 * MiB, WS_WD1 = 13 * MiB, WS_WGU2 = 19 * MiB, WS_WD2 = 30 * MiB, WS_WIN = 36 * MiB, WS_WOUT = 41 * MiB, WS_CW1 = 43 * MiB;
constexpr size_t WS_WSB = 45 * MiB, WS_CB1P = 45 * MiB + 512 * 1024, WS_CW2 = 45 * MiB + 768 * 1024;
constexpr size_t WS_SS0 = 46 * MiB, WS_SS1 = 48 * MiB, WS_SS2 = 50 * MiB, WS_SS3 = 52 * MiB, WS_SSV = 54 * MiB;
constexpr size_t WS_XB = 56 * MiB;
constexpr size_t WS_ACT = 120 * MiB;
constexpr size_t WS_Y = 120 * MiB, WS_GVT = 184 * MiB, WS_KCR = 216 * MiB, WS_VCR = 224 * MiB, WS_KS = 232 * MiB, WS_VST = 240 * MiB, WS_KW = 248 * MiB, WS_VWT = 256 * MiB;
constexpr size_t WS_GATES = 264 * MiB, WS_H1 = 268 * MiB, WS_KCMP = 272 * MiB, WS_VCMPT = 272 * MiB + 512 * 1024;
constexpr size_t WS_END = 296 * MiB;
constexpr int CW_BAR = 4096;
constexpr int CW_Q = 8192;

constexpr int RING_OFF = 0, RING_BYTES = 147456;
constexpr int LDSCTL_OFF = RING_BYTES, MISC_OFF = LDSCTL_OFF + 320;
constexpr int TB_OFF = LDSCTL_OFF + 1024;
constexpr int TBL_OFF = LDSCTL_OFF + 2048;
constexpr int LDS_BYTES = 163840;

#define GAS __attribute__((address_space(1)))
#define LAS __attribute__((address_space(3)))
typedef unsigned short bf16;
typedef unsigned v4u __attribute__((ext_vector_type(4)));
typedef unsigned v2u __attribute__((ext_vector_type(2)));
typedef float f32x4 __attribute__((ext_vector_type(4)));
typedef GAS unsigned gu32;
#define RLX_AGENT __ATOMIC_RELAXED, __HIP_MEMORY_SCOPE_AGENT
#define LDS_WAIT() asm volatile("s_waitcnt lgkmcnt(0)" ::: "memory")
#define VM_WAIT() asm volatile("s_waitcnt vmcnt(0)" ::: "memory")
__device__ __forceinline__ unsigned f2bf(float f) { unsigned u = __builtin_bit_cast(unsigned, f); return (u + 0x7fffu + ((u >> 16) & 1u)) >> 16; }
__device__ __forceinline__ unsigned pk2(float lo, float hi) { return f2bf(lo) | (f2bf(hi) << 16); }
__device__ __forceinline__ float bf2f(unsigned short b) { return __builtin_bit_cast(float, (unsigned)b << 16); }
__device__ __forceinline__ float wave_sum(float v) {
#pragma unroll
    for (int o = 1; o < 64; o <<= 1) v += __shfl_xor(v, o);
    return v;
}
__device__ __forceinline__ float wave_max(float v) {
#pragma unroll
    for (int o = 1; o < 64; o <<= 1) v = fmaxf(v, __shfl_xor(v, o));
    return v;
}
__device__ __forceinline__ float gelu_tanh(float x) { const float u2 = 1.5957691216057308f * (x + 0.044715f * x * x * x); return x / (1.f + __expf(-u2)); }
__device__ __forceinline__ float sigmoidf_(float x) { return 1.f / (1.f + __expf(-x)); }

#define XB_TMO      128
#define XB_XCNT(j)  (256  + 64 * (j))
#define XB_XSUB(j)  (1280 + 64 * (j))
#define XB_XGEN(j)  (2304 + 64 * (j))
#define XB_TOP      3328
#define XB_TOPGEN   3392
#define XCD_BAR_WORDS 3456
#define XB_SPIN_CAP (1u << 22)
__device__ __forceinline__ unsigned xb_ld(unsigned* p)              { return __hip_atomic_load(p, __ATOMIC_RELAXED, __HIP_MEMORY_SCOPE_AGENT); }
__device__ __forceinline__ unsigned xb_add(unsigned* p, unsigned v) { return __hip_atomic_fetch_add(p, v, __ATOMIC_RELAXED, __HIP_MEMORY_SCOPE_AGENT); }
__device__ __forceinline__ unsigned xb_xcc_id() { return (unsigned)__builtin_amdgcn_s_getreg((3 << 11) | 20) & 0xFu; }
#define XB_SPIN(cond, bar) do { unsigned _sp = 0; while (cond) { __builtin_amdgcn_s_sleep(1); \
    if ((++_sp & 255u) == 0u) { if (xb_ld(&(bar)[XB_TMO])) break; if (_sp > XB_SPIN_CAP) { atomicAdd(&(bar)[XB_TMO], 1u); break; } } } } while (0)
struct XcdBarrier { unsigned* bar; unsigned x; volatile LAS unsigned* st; };
__device__ __forceinline__ XcdBarrier xcd_barrier_post(unsigned* bar, volatile LAS unsigned* st) {
    XcdBarrier b; b.bar = bar; b.x = xb_xcc_id(); b.st = st;
    if (threadIdx.x == 0) (void)xb_add(&bar[XB_XCNT(b.x)], 1u);
    return b;
}
__device__ __forceinline__ void xcd_barrier_complete(unsigned* bar, unsigned x, unsigned& nloc, unsigned& nx) {
    const unsigned G = gridDim.x * gridDim.y * gridDim.z;
    unsigned sum, cnt, mine, sp = 0u;
    for (;;) {
        sum = 0u; cnt = 0u; mine = 0u;
#pragma unroll
        for (unsigned j = 0; j < 16; ++j) { const unsigned c = xb_ld(&bar[XB_XCNT(j)]); sum += c; cnt += (c > 0u) ? 1u : 0u; mine = (j == x) ? c : mine; }
        if (sum == G) break;
        __builtin_amdgcn_s_sleep(1);
        if ((++sp & 255u) == 0u) { if (xb_ld(&bar[XB_TMO])) break; if (sp > XB_SPIN_CAP) { atomicAdd(&bar[XB_TMO], 1u); break; } }
    }
    nloc = mine > 0u ? mine : 1u; nx = cnt > 0u ? cnt : 1u;
}
__device__ __forceinline__ void xcd_barrier(const XcdBarrier& b) {
    asm volatile("s_waitcnt vmcnt(0)" ::: "memory");
    __syncthreads();
    if (threadIdx.x == 0) {
        unsigned* bar = b.bar;
        __builtin_amdgcn_s_waitcnt(0);
        unsigned nloc = b.st[0], nx = b.st[1];
        if (nloc == 0u) { xcd_barrier_complete(bar, b.x, nloc, nx); b.st[0] = nloc; b.st[1] = nx; }
        const unsigned old = xb_add(&bar[XB_XSUB(b.x)], 1u);
        const unsigned gen = old / nloc;
        if (old + 1u == (gen + 1u) * nloc) {
            __builtin_amdgcn_fence(__ATOMIC_RELEASE, "agent");
            asm volatile("s_waitcnt vmcnt(0)" ::: "memory");
            const unsigned og = xb_add(&bar[XB_TOP], 1u);
            const unsigned tg = og / nx;
            if (og + 1u == (tg + 1u) * nx) xb_add(&bar[XB_TOPGEN], 1u);
            else XB_SPIN(xb_ld(&bar[XB_TOPGEN]) == tg, bar);
            __builtin_amdgcn_fence(__ATOMIC_ACQUIRE, "agent");
            xb_add(&bar[XB_XGEN(b.x)], 1u);
            asm volatile("s_waitcnt vmcnt(0)" ::: "memory");
        } else {
            XB_SPIN(xb_ld(&bar[XB_XGEN(b.x)]) == gen, bar);
            __builtin_amdgcn_fence(__ATOMIC_ACQUIRE, "agent");
            asm volatile("s_waitcnt vmcnt(0)" ::: "memory");
        }
    }
    __syncthreads();
}

__device__ __forceinline__ float row_rinv(const float* ss, int row, int fq) {
    const f32x4 p = *(const f32x4*)(ss + (size_t)row * 16 + 4 * fq);
    float s = (p[0] + p[1]) + (p[2] + p[3]);
    s += __shfl_xor(s, 16); s += __shfl_xor(s, 32);
    return __builtin_amdgcn_rsqf(s * (1.f / DM) + EPS);
}
__device__ __forceinline__ float rsq_acc(float s, float invn) { return 1.0f / sqrtf(s * invn + EPS); }

struct EpiSwiGLU {
    static constexpr bool PERM = true;
    const float* ss; bf16* act;
    __device__ __forceinline__ void operator()(const f32x4 (&acc)[2][2][4][2], const pg8::Unit& u, int wr, int wc, int fr, int fq) const {
#pragma unroll
        for (int ai = 0; ai < 2; ++ai)
#pragma unroll
            for (int m = 0; m < 4; ++m) {
                const int row = u.pm * 256 + ai * 128 + wr * 64 + m * 16 + fr;
                const float ri = row_rinv(ss, row, fq);
                float o[8];
#pragma unroll
                for (int n = 0; n < 2; ++n)
#pragma unroll
                    for (int i = 0; i < 4; ++i) { const float g = acc[ai][0][m][n][i] * ri, up = acc[ai][1][m][n][i] * ri; o[n * 4 + i] = g * sigmoidf_(g) * up; }
                v4u w; w.x = pk2(o[0], o[1]); w.y = pk2(o[2], o[3]); w.z = pk2(o[4], o[5]); w.w = pk2(o[6], o[7]);
                *(v4u*)(act + (size_t)row * DFF + u.pn * 128 + wc * 32 + fq * 8) = w;
            }
    }
};
struct EpiResid {
    static constexpr bool PERM = false;
    const float* base; float* out; bf16* xb; float* ssp; float scale;
    __device__ __forceinline__ void operator()(const f32x4 (&acc)[2][2][4][2], const pg8::Unit& u, int wr, int wc, int fr, int fq) const {
#pragma unroll
        for (int ai = 0; ai < 2; ++ai)
#pragma unroll
            for (int m = 0; m < 4; ++m) {
                const int row = u.pm * 256 + ai * 128 + wr * 64 + m * 16 + fr;
                float sq = 0.f;
#pragma unroll
                for (int bj = 0; bj < 2; ++bj)
#pragma unroll
                    for (int n = 0; n < 2; ++n) {
                        const size_t off = (size_t)row * DM + u.pn * 256 + bj * 128 + wc * 32 + n * 16 + fq * 4;
                        const f32x4 b = *(const f32x4*)(base + off);
                        const f32x4 o = b + acc[ai][bj][m][n] * scale;
                        *(f32x4*)(out + off) = o;
                        if (xb) { v2u w; w.x = pk2(o[0], o[1]); w.y = pk2(o[2], o[3]); *(v2u*)(xb + off) = w; }
                        sq += (o[0] * o[0] + o[1] * o[1]) + (o[2] * o[2] + o[3] * o[3]);
                    }
                sq += __shfl_xor(sq, 16); sq += __shfl_xor(sq, 32);
                if (fq == 0) ssp[(size_t)row * 16 + u.pn * 4 + wc] = sq;
            }
    }
};
struct EpiMix {
    static constexpr bool PERM = true;
    const float* ss; unsigned char* ws; const float* qg; const float* kg;
    __device__ __forceinline__ void operator()(const f32x4 (&acc)[2][2][4][2], const pg8::Unit& u, int wr, int wc, int fr, int fq) const {
        const int pn = u.pn;
        bf16* const Y = (bf16*)(ws + WS_Y); bf16* const GVT = (bf16*)(ws + WS_GVT); float* const SSV = (float*)(ws + WS_SSV); bf16* const KCR = (bf16*)(ws + WS_KCR); bf16* const VCR = (bf16*)(ws + WS_VCR);
        bf16* const KS = (bf16*)(ws + WS_KS); bf16* const VST = (bf16*)(ws + WS_VST); bf16* const KW = (bf16*)(ws + WS_KW); bf16* const VWT = (bf16*)(ws + WS_VWT); float* const GATES = (float*)(ws + WS_GATES);
        float gn[2][2][4];
        const float* gsrc = nullptr;
        if (pn == 4 || pn == 5) gsrc = qg; else if (pn == 7 && wc < 2) gsrc = kg + 64; else if (pn == 8 && wc < 2) gsrc = kg + 128;
#pragma unroll
        for (int bj = 0; bj < 2; ++bj)
#pragma unroll
            for (int n = 0; n < 2; ++n)
#pragma unroll
                for (int i = 0; i < 4; ++i) gn[bj][n][i] = gsrc ? gsrc[32 * bj + 8 * fq + 4 * n + i] : 1.f;
#pragma unroll
        for (int ai = 0; ai < 2; ++ai)
#pragma unroll
            for (int m = 0; m < 4; ++m) {
                const int row = u.pm * 256 + ai * 128 + wr * 64 + m * 16 + fr;
                const int b = row >> 12, t = row & 4095;
                const float ri = row_rinv(ss, row, fq);
                float v[2][2][4];
#pragma unroll
                for (int bj = 0; bj < 2; ++bj)
#pragma unroll
                    for (int n = 0; n < 2; ++n)
#pragma unroll
                        for (int i = 0; i < 4; ++i) v[bj][n][i] = acc[ai][bj][m][n][i] * ri;
                if (pn < 4) {
                    float sq = 0.f;
#pragma unroll
                    for (int bj = 0; bj < 2; ++bj)
#pragma unroll
                        for (int n = 0; n < 2; ++n)
#pragma unroll
                            for (int i = 0; i < 4; ++i) { const float x = gelu_tanh(v[bj][n][i]); v[bj][n][i] = x; sq += x * x; }
                    if (pn < 2) {
#pragma unroll
                        for (int bj = 0; bj < 2; ++bj) { v4u w; w.x = pk2(v[bj][0][0], v[bj][0][1]); w.y = pk2(v[bj][0][2], v[bj][0][3]); w.z = pk2(v[bj][1][0], v[bj][1][1]); w.w = pk2(v[bj][1][2], v[bj][1][3]);
                            *(v4u*)(Y + (size_t)row * DM + pn * 256 + wc * 64 + bj * 32 + fq * 8) = w; }
                    } else {
                        const int h = (pn - 2) * 4 + wc;
                        bf16* dst = GVT + ((size_t)(b * 8 + h) * 64) * SEQ + t;
#pragma unroll
                        for (int bj = 0; bj < 2; ++bj)
#pragma unroll
                            for (int n = 0; n < 2; ++n)
#pragma unroll
                                for (int i = 0; i < 4; ++i) dst[(size_t)(32 * bj + 8 * fq + 4 * n + i) * SEQ] = (bf16)f2bf(v[bj][n][i]);
                        sq += __shfl_xor(sq, 16); sq += __shfl_xor(sq, 32);
                        if (fq == 0) SSV[(size_t)row * 8 + (pn - 2) * 4 + wc] = sq;
                    }
                } else if (pn < 9) {
                    const bool is_q = (pn == 4 || pn == 5);
                    const bool is_k = (wc < 2);
                    const bool normed = is_q || ((pn == 7 || pn == 8) && is_k);
                    if (normed) {
                        float sq = 0.f;
#pragma unroll
                        for (int bj = 0; bj < 2; ++bj)
#pragma unroll
                            for (int n = 0; n < 2; ++n)
#pragma unroll
                                for (int i = 0; i < 4; ++i) sq += v[bj][n][i] * v[bj][n][i];
                        sq += __shfl_xor(sq, 16); sq += __shfl_xor(sq, 32);
                        const float rh = rsq_acc(sq, 1.f / 64.f) * (is_q ? 0.125f * 1.4426950408889634f : 1.f);
#pragma unroll
                        for (int bj = 0; bj < 2; ++bj)
#pragma unroll
                            for (int n = 0; n < 2; ++n)
#pragma unroll
                                for (int i = 0; i < 4; ++i) v[bj][n][i] *= rh * gn[bj][n][i];
                    }
                    if (is_q || is_k) {
                        bf16* dst;
                        if (is_q) dst = Y + (size_t)row * DM + 512 + (pn - 4) * 256 + wc * 64;
                        else { bf16* kb = (pn == 6) ? KCR : (pn == 7) ? KS : KW; dst = kb + ((size_t)(b * 2 + wc) * SEQ + t) * 64; }
#pragma unroll
                        for (int bj = 0; bj < 2; ++bj) { v4u w; w.x = pk2(v[bj][0][0], v[bj][0][1]); w.y = pk2(v[bj][0][2], v[bj][0][3]); w.z = pk2(v[bj][1][0], v[bj][1][1]); w.w = pk2(v[bj][1][2], v[bj][1][3]);
                            *(v4u*)(dst + bj * 32 + fq * 8) = w; }
                    } else if (pn == 6) {
                        bf16* dst = VCR + ((size_t)(b * 2 + (wc - 2)) * SEQ + t) * 64;
#pragma unroll
                        for (int bj = 0; bj < 2; ++bj) { v4u w; w.x = pk2(v[bj][0][0], v[bj][0][1]); w.y = pk2(v[bj][0][2], v[bj][0][3]); w.z = pk2(v[bj][1][0], v[bj][1][1]); w.w = pk2(v[bj][1][2], v[bj][1][3]);
                            *(v4u*)(dst + bj * 32 + fq * 8) = w; }
                    } else {
                        bf16* vb = (pn == 7) ? VST : VWT;
                        const int tp = (t & ~12) | ((t & 4) << 1) | ((t & 8) >> 1);
                        bf16* dst = vb + ((size_t)(b * 2 + (wc - 2)) * 64) * SEQ + tp;
#pragma unroll
                        for (int bj = 0; bj < 2; ++bj)
#pragma unroll
                            for (int n = 0; n < 2; ++n)
#pragma unroll
                                for (int i = 0; i < 4; ++i) dst[(size_t)(32 * bj + 8 * fq + 4 * n + i) * SEQ] = (bf16)f2bf(v[bj][n][i]);
                    }
                } else {
                    if (wc == 0 && fq < 3) {
                        f32x4 g0, g1;
#pragma unroll
                        for (int i = 0; i < 4; ++i) { g0[i] = sigmoidf_(v[0][0][i]); g1[i] = sigmoidf_(v[0][1][i]); }
                        *(f32x4*)(GATES + (size_t)row * 24 + fq * 8) = g0; *(f32x4*)(GATES + (size_t)row * 24 + fq * 8 + 4) = g1;
                    }
                }
            }
    }
};
struct EpiCmp {
    static constexpr bool PERM = true;
    const float* cb1p; bf16* H1;
    __device__ __forceinline__ void operator()(const f32x4 (&acc)[2][2][4][2], const pg8::Unit& u, int wr, int wc, int fr, int fq) const {
        float bias[2][2][4];
#pragma unroll
        for (int bj = 0; bj < 2; ++bj)
#pragma unroll
            for (int n = 0; n < 2; ++n)
#pragma unroll
                for (int i = 0; i < 4; ++i) { const int col = u.pn * 256 + bj * 128 + wc * 32 + fq * 8 + n * 4 + i; float s = 0.f;
#pragma unroll
                    for (int p = 0; p < 8; ++p) s += cb1p[p * 512 + col];
                    bias[bj][n][i] = s; }
#pragma unroll
        for (int ai = 0; ai < 2; ++ai)
#pragma unroll
            for (int m = 0; m < 4; ++m) {
                const int row = u.pm * 256 + ai * 128 + wr * 64 + m * 16 + fr;
#pragma unroll
                for (int bj = 0; bj < 2; ++bj) { float o[8];
#pragma unroll
                    for (int n = 0; n < 2; ++n)
#pragma unroll
                        for (int i = 0; i < 4; ++i) o[n * 4 + i] = gelu_tanh(acc[ai][bj][m][n][i] + bias[bj][n][i]);
                    v4u w; w.x = pk2(o[0], o[1]); w.y = pk2(o[2], o[3]); w.z = pk2(o[4], o[5]); w.w = pk2(o[6], o[7]);
                    *(v4u*)(H1 + (size_t)row * 256 + bj * 128 + wc * 32 + fq * 8) = w; }
            }
    }
};

struct Frame {
    LAS unsigned char* lds; volatile LAS unsigned* MISC; gu32* ctl;
    int tid, lane, wave, vcu, G;
};
struct Args { const float* in[24]; float* out; unsigned char* ws; int ph_lo, ph_hi, li, pad; };

__device__ __forceinline__ void p0_tr_item(const float* W, int ldw, int K, const float* gain, bf16* WT, int n0d, int sc0, int nvalid, int kb, LAS float* scr, int lane) {
    const int k0 = 64 * kb;
#pragma unroll 8
    for (int i = 0; i < 32; ++i) { const int kk = 2 * i + (lane >> 5), c = lane & 31;
        float x = 0.f; if (c < nvalid) { x = W[(size_t)(k0 + kk) * ldw + sc0 + c]; if (gain) x *= gain[k0 + kk]; }
        scr[kk * 33 + c] = x; }
    LDS_WAIT(); asm volatile("" ::: "memory");
    const int c = lane & 7;
#pragma unroll
    for (int j = 0; j < 4; ++j) { const int n = (lane >> 3) + 8 * j; const LAS float* s = scr + (8 * c) * 33 + n;
        v4u o; o.x = pk2(s[0 * 33], s[1 * 33]); o.y = pk2(s[2 * 33], s[3 * 33]); o.z = pk2(s[4 * 33], s[5 * 33]); o.w = pk2(s[6 * 33], s[7 * 33]);
        *(GAS v4u*)(WT + (size_t)(n0d + n) * K + k0 + 8 * c) = o; }
    LDS_WAIT(); asm volatile("" ::: "memory");
}

__device__ __forceinline__ void p0_prologue(Frame& F, const Args& A) {
    unsigned char* ws = A.ws;
    LAS float* scr = (LAS float*)(F.lds + RING_OFF + F.wave * 16384);
    const int gw = F.vcu * NWAVES + F.wave, NGW = F.G * NWAVES, lane = F.lane;
    constexpr int I_GU = (DM / 64) * (NGU / 32), I_D = (DFF / 64) * (DM / 32), I_IN = (DM / 64) * (NIN / 32), I_OUT = (DM / 64) * (DM / 32), I_C1 = 2 * (2048 / 64) * (256 / 32);
    constexpr int I_WS = 8 * 128 * 128 / 64 / 8;
    constexpr int I_CB = 64, I_C2 = 64;
    constexpr int NITEMS = 2 * I_GU + 2 * I_D + I_IN + I_OUT + I_C1 + I_WS + I_CB + I_C2;
    for (int it = gw; it < NITEMS; it += NGW) {
        int r = it;
        if (r < 2 * I_GU) {
            const int f = r / I_GU; r -= f * I_GU; const int nblk = NGU / 32, kb = r / nblk, nb = r % nblk, n0 = 32 * nb, pn = n0 >> 8, bj = (n0 >> 7) & 1, j = n0 & 127;
            const float* W = f ? (bj ? A.in[21] : A.in[20]) : (bj ? A.in[3] : A.in[2]);
            p0_tr_item(W, DFF, DM, f ? A.in[19] : A.in[1], (bf16*)(ws + (f ? WS_WGU2 : WS_WGU1)), n0, 128 * pn + j, 32, kb, scr, lane); continue; }
        r -= 2 * I_GU;
        if (r < 2 * I_D) {
            const int f = r / I_D; r -= f * I_D; const int nblk = DM / 32, kb = r / nblk, nb = r % nblk;
            p0_tr_item(f ? A.in[22] : A.in[4], DM, DFF, nullptr, (bf16*)(ws + (f ? WS_WD2 : WS_WD1)), 32 * nb, 32 * nb, 32, kb, scr, lane); continue; }
        r -= 2 * I_D;
        if (r < I_IN) {
            const int nblk = NIN / 32, kb = r / nblk, nb = r % nblk, n0 = 32 * nb, pn = n0 >> 8, tc = n0 & 255;
            const int col = 256 * pn + 64 * ((tc >> 5) & 3) + 32 * (tc >> 7);
            int nv = INC - col; nv = nv < 0 ? 0 : (nv > 32 ? 32 : nv);
            p0_tr_item(A.in[6], INC, DM, A.in[5], (bf16*)(ws + WS_WIN), n0, col, nv, kb, scr, lane); continue; }
        r -= I_IN;
        if (r < I_OUT) { const int nblk = DM / 32, kb = r / nblk, nb = r % nblk;
            p0_tr_item(A.in[18], DM, DM, nullptr, (bf16*)(ws + WS_WOUT), 32 * nb, 32 * nb, 32, kb, scr, lane); continue; }
        r -= I_OUT;
        if (r < I_C1) { const int kv = r / (I_C1 / 2); r -= kv * (I_C1 / 2); const int nblk = 256 / 32, kb = r / nblk, nb = r % nblk;
            p0_tr_item(A.in[13] + (size_t)kv * 2048 * 256, 256, 2048, nullptr, (bf16*)(ws + WS_CW1) + (size_t)kv * 256 * 2048, 32 * nb, 32 * nb, 32, kb, scr, lane); continue; }
        r -= I_C1;
        if (r < I_WS) {
            const int e0 = (r * 64 + lane) * 8; const int s0 = e0 & 127, t = (e0 >> 7) & 127;
            const float* src = A.in[8] + e0; unsigned o[4];
#pragma unroll
            for (int i = 0; i < 4; ++i) { const float a = (s0 + 2 * i <= t) ? src[2 * i] : 0.f, b2 = (s0 + 2 * i + 1 <= t) ? src[2 * i + 1] : 0.f; o[i] = pk2(a, b2); }
            *(v4u*)((bf16*)(ws + WS_WSB) + e0) = (v4u){o[0], o[1], o[2], o[3]}; continue; }
        r -= I_WS;
        if (r >= I_CB) {
            r -= I_CB; const int e0 = (r * 64 + lane) * 8, kv = e0 >> 14, d = (e0 >> 8) & 63, j0 = e0 & 255;
            const float* src = A.in[15] + (size_t)kv * 256 * 64 + d; unsigned o[4];
#pragma unroll
            for (int i = 0; i < 4; ++i) o[i] = pk2(src[(size_t)(j0 + 2 * i) * 64], src[(size_t)(j0 + 2 * i + 1) * 64]);
            *(v4u*)((bf16*)(ws + WS_CW2) + e0) = (v4u){o[0], o[1], o[2], o[3]}; continue; }
        {
            const int kp = r & 7, jb = (r >> 3) & 3, kv = r >> 5, j = jb * 64 + lane;
            const float* pe = A.in[12] + (size_t)kv * 2048; const float* w1 = A.in[13] + (size_t)kv * 2048 * 256;
            float s = (kp == 0) ? A.in[14][kv * 256 + j] : 0.f;
            for (int k = kp * 256; k < kp * 256 + 256; ++k) s += pe[k] * w1[(size_t)k * 256 + j];
            ((float*)(ws + WS_CB1P))[kp * 512 + kv * 256 + j] = s;
        }
    }
    const float* x = A.in[0]; bf16* XB = (bf16*)(ws + WS_XB); float* SS0 = (float*)(ws + WS_SS0);
    for (int m = gw; m < MTOK; m += NGW) {
        const GAS f32x4* xr = (const GAS f32x4*)(x + (size_t)m * DM) + lane;
        GAS unsigned long long* o8 = (GAS unsigned long long*)(XB + (size_t)m * DM) + lane;
        float s = 0.f;
#pragma unroll
        for (int j = 0; j < 4; ++j) { const f32x4 v = xr[64 * j]; s += (v.x * v.x + v.y * v.y) + (v.z * v.z + v.w * v.w);
            o8[64 * j] = (unsigned long long)pk2(v.x, v.y) | ((unsigned long long)pk2(v.z, v.w) << 32); }
        s = wave_sum(s);
        if (lane < 16) SS0[(size_t)m * 16 + lane] = (lane == 0) ? s : 0.f;
    }
}

__device__ __forceinline__ void gmlp_unit(Frame& F, const Args& A, int unit) {
    typedef short bf16x8 __attribute__((ext_vector_type(8)));
    typedef float f32x16 __attribute__((ext_vector_type(16)));
    unsigned char* ws = A.ws;
    const int b = unit >> 5, c = unit & 31, r0 = b * SEQ + c * 128, lane = F.lane, h = F.wave, r = lane & 31, hh = lane >> 5;
    LAS float* rv = (LAS float*)(F.lds + RING_OFF);
    const float* SSV = (const float*)(ws + WS_SSV);
    if (F.tid < 128) { const f32x4 p0 = *(const f32x4*)(SSV + (size_t)(r0 + F.tid) * 8), p1 = *(const f32x4*)(SSV + (size_t)(r0 + F.tid) * 8 + 4);
        const float sm = ((p0[0] + p0[1]) + (p0[2] + p0[3])) + ((p1[0] + p1[1]) + (p1[2] + p1[3]));
        rv[F.tid] = rsq_acc(sm, 1.f / 512.f); }
    __syncthreads();
    const bf16* GVT = (const bf16*)(ws + WS_GVT) + ((size_t)(b * 8 + h) * 64) * SEQ + c * 128;
    const bf16* WSB = (const bf16*)(ws + WS_WSB) + (size_t)h * 128 * 128;
    bf16* Y = (bf16*)(ws + WS_Y);
    f32x16 acc[4][2];
#pragma unroll
    for (int tt = 0; tt < 4; ++tt)
#pragma unroll
        for (int dt = 0; dt < 2; ++dt)
#pragma unroll
            for (int i = 0; i < 16; ++i) acc[tt][dt][i] = 0.f;
#pragma unroll
    for (int ks = 0; ks < 8; ++ks) {
        const int s0 = 16 * ks + 8 * hh;
        bf16x8 vf[2];
        const f32x4 ra = *(const LAS f32x4*)(rv + s0), rb = *(const LAS f32x4*)(rv + s0 + 4);
#pragma unroll
        for (int dt = 0; dt < 2; ++dt) { const v4u raw = *(const v4u*)(GVT + (size_t)(32 * dt + r) * SEQ + s0);
            v4u o; o.x = pk2(__builtin_bit_cast(float, raw.x << 16) * ra[0], __builtin_bit_cast(float, raw.x & 0xffff0000u) * ra[1]);
            o.y = pk2(__builtin_bit_cast(float, raw.y << 16) * ra[2], __builtin_bit_cast(float, raw.y & 0xffff0000u) * ra[3]);
            o.z = pk2(__builtin_bit_cast(float, raw.z << 16) * rb[0], __builtin_bit_cast(float, raw.z & 0xffff0000u) * rb[1]);
            o.w = pk2(__builtin_bit_cast(float, raw.w << 16) * rb[2], __builtin_bit_cast(float, raw.w & 0xffff0000u) * rb[3]);
            vf[dt] = __builtin_bit_cast(bf16x8, o); }
#pragma unroll
        for (int tt = 0; tt < 4; ++tt) {
            if (16 * ks <= 32 * tt + 31) {
                const bf16x8 wf = *(const bf16x8*)(WSB + (size_t)(32 * tt + r) * 128 + s0);
#pragma unroll
                for (int dt = 0; dt < 2; ++dt) acc[tt][dt] = __builtin_amdgcn_mfma_f32_32x32x16_bf16(vf[dt], wf, acc[tt][dt], 0, 0, 0);
            }
        }
    }
    const float* gvn = A.in[7] + h * 64; const float* bs = A.in[9] + h * 128;
#pragma unroll
    for (int tt = 0; tt < 4; ++tt) {
        const int tl = 32 * tt + r; const float bt = bs[tl];
        bf16* yrow = Y + (size_t)(r0 + tl) * DM + h * 64;
#pragma unroll
        for (int dt = 0; dt < 2; ++dt)
#pragma unroll
            for (int q = 0; q < 4; ++q) { const int d = 32 * dt + 8 * q + 4 * hh;
                const f32x4 gg = *(const f32x4*)(gvn + d); const v2u uu = *(const v2u*)(yrow + d);
                const float o0 = __builtin_bit_cast(float, uu.x << 16) * (acc[tt][dt][4 * q] * gg[0] + bt), o1 = __builtin_bit_cast(float, uu.x & 0xffff0000u) * (acc[tt][dt][4 * q + 1] * gg[1] + bt);
                const float o2 = __builtin_bit_cast(float, uu.y << 16) * (acc[tt][dt][4 * q + 2] * gg[2] + bt), o3 = __builtin_bit_cast(float, uu.y & 0xffff0000u) * (acc[tt][dt][4 * q + 3] * gg[3] + bt);
                v2u wv; wv.x = pk2(o0, o1); wv.y = pk2(o2, o3); *(v2u*)(yrow + d) = wv; }
    }
    __syncthreads();
}
__device__ __forceinline__ void cmp_unit(Frame& F, const Args& A, int unit) {
    typedef short bf16x8 __attribute__((ext_vector_type(8)));
    typedef float f32x16 __attribute__((ext_vector_type(16)));
    unsigned char* ws = A.ws;
    const int lane = F.lane, w = F.wave, r = lane & 31, hh = lane >> 5;
    const int row0 = unit * 32, kv = row0 >> 12;
    const bf16* X = (const bf16*)(ws + WS_KCR) + (size_t)(row0 + r) * 1024 + 8 * hh;
    const bf16* W1 = (const bf16*)(ws + WS_CW1) + ((size_t)kv * 256 + 32 * w + r) * 2048 + 8 * hh;
    f32x16 acc;
#pragma unroll
    for (int i = 0; i < 16; ++i) acc[i] = 0.f;
#pragma unroll 8
    for (int ks = 0; ks < 128; ++ks) { const bf16x8 wf = *(const bf16x8*)(W1 + 16 * ks), xf = *(const bf16x8*)(X + 16 * ks);
        acc = __builtin_amdgcn_mfma_f32_32x32x16_bf16(wf, xf, acc, 0, 0, 0); }
    LAS unsigned char* HL = F.lds + RING_OFF;
    const float* cb1p = (const float*)(ws + WS_CB1P) + kv * 256 + 32 * w;
#pragma unroll
    for (int q = 0; q < 4; ++q) { float o[4];
#pragma unroll
        for (int i = 0; i < 4; ++i) { const int col = 8 * q + 4 * hh + i; float bsum = 0.f;
#pragma unroll
            for (int pz = 0; pz < 8; ++pz) bsum += cb1p[pz * 512 + col];
            o[i] = gelu_tanh(acc[4 * q + i] + bsum); }
        *(LAS v2u*)(HL + r * 528 + (32 * w + 8 * q + 4 * hh) * 2) = (v2u){pk2(o[0], o[1]), pk2(o[2], o[3])}; }
    __syncthreads();
    if (w == 0) {
        const bf16* W2 = (const bf16*)(ws + WS_CW2) + (size_t)kv * 64 * 256;
        f32x16 a2[2];
#pragma unroll
        for (int i = 0; i < 16; ++i) { a2[0][i] = 0.f; a2[1][i] = 0.f; }
#pragma unroll
        for (int ks = 0; ks < 16; ++ks) {
            const bf16x8 hf = *(const LAS bf16x8*)(HL + r * 528 + (16 * ks + 8 * hh) * 2);
#pragma unroll
            for (int dt = 0; dt < 2; ++dt) { const bf16x8 wf = *(const bf16x8*)(W2 + (size_t)(32 * dt + r) * 256 + 16 * ks + 8 * hh);
                a2[dt] = __builtin_amdgcn_mfma_f32_32x32x16_bf16(wf, hf, a2[dt], 0, 0, 0); }
        }
        const float* b2 = A.in[16] + kv * 64; const float* kg0 = A.in[11];
        float sq = 0.f;
#pragma unroll
        for (int dt = 0; dt < 2; ++dt)
#pragma unroll
            for (int i = 0; i < 16; ++i) { const int d = 32 * dt + (i & 3) + 8 * (i >> 2) + 4 * hh; a2[dt][i] += b2[d]; sq += a2[dt][i] * a2[dt][i]; }
        const int row = row0 + r, n = row & 255, bg = (row & 4095) >> 8;
        if (kv == 0) {
            sq += __shfl_xor(sq, 32); const float rn = rsq_acc(sq, 1.f / 64.f);
            bf16* dst = (bf16*)(ws + WS_KCMP) + ((size_t)bg * 256 + n) * 64;
#pragma unroll
            for (int dt = 0; dt < 2; ++dt)
#pragma unroll
                for (int q = 0; q < 4; ++q) { const int d = 32 * dt + 8 * q + 4 * hh; const f32x4 gg = *(const f32x4*)(kg0 + d);
                    v2u wv; wv.x = pk2(a2[dt][4 * q] * rn * gg[0], a2[dt][4 * q + 1] * rn * gg[1]); wv.y = pk2(a2[dt][4 * q + 2] * rn * gg[2], a2[dt][4 * q + 3] * rn * gg[3]);
                    *(v2u*)(dst + d) = wv; }
        } else {
            const int np = (n & ~12) | ((n & 4) << 1) | ((n & 8) >> 1);
            bf16* dst = (bf16*)(ws + WS_VCMPT) + (size_t)bg * 64 * 256 + np;
#pragma unroll
            for (int dt = 0; dt < 2; ++dt)
#pragma unroll
                for (int i = 0; i < 16; ++i) { const int d = 32 * dt + (i & 3) + 8 * (i >> 2) + 4 * hh; dst[(size_t)d * 256] = (bf16)f2bf(a2[dt][i]); }
        }
    }
    __syncthreads();
}

#define TSTAMP() __builtin_amdgcn_s_memrealtime()
namespace att {
typedef short bf16x8 __attribute__((ext_vector_type(8)));
typedef short s16x4 __attribute__((ext_vector_type(4)));
typedef float f32x16 __attribute__((ext_vector_type(16)));
typedef float f32x2_t __attribute__((ext_vector_type(2))); typedef __bf16 bf16x2_t __attribute__((ext_vector_type(2)));
constexpr int TILEB = 8192, NSLOT = 6;
constexpr int OFF_KV = 0, OFF_IMP = NSLOT * 2 * TILEB, OFF_MSK = OFF_IMP + 8 * 2048, ATT_LDS = OFF_MSK + 512;
constexpr float NEGBIG = -30000.f;
__device__ __forceinline__ unsigned cvtpk(float lo, float hi) { f32x2_t v = {lo, hi}; bf16x2_t b = __builtin_convertvector(v, bf16x2_t); return __builtin_bit_cast(unsigned, b); }
__device__ __forceinline__ int crow(int r, int hi) { return (r & 3) + 8 * (r >> 2) + 4 * hi; }
__device__ __forceinline__ float xhalf(float x) { return __shfl_xor(x, 32); }
constexpr int TR_D0 = 575, TR_N = 640, OFF_TR = 115712;
enum { FAR = 0, NEARS = 1, NEARW = 2, NEARC = 3 };
#define SBAR() __builtin_amdgcn_sched_barrier(0)
template <int MODE, bool CMP, bool MASKED>
__device__ __forceinline__ void tile(const LAS unsigned char* Kb, const LAS unsigned char* Vb, const bf16x8 (&qf)[4], bool rowsel, const LAS float* trh, int kidx0,
                                     f32x16 (&O)[2], float& l, float (&u)[2][4], float& carry, int r, int hh) {
    constexpr int ES = CMP ? 16 : 1;
    const LAS float* trb = trh + kidx0;
    f32x16 S[2];
    bf16x8 pf[2][2], kf[2][4], vf[4];
    float ls = 0.f;
    const unsigned pmask = rowsel ? 0xffffffffu : 0u;
#define ATT_B(a, i) do { float s_ = S[a][i]; const int e_ = ES * (32 * (a) + ((i) & 3) + 8 * ((i) >> 2)); \
        if (MODE == NEARS || MODE == NEARW) s_ += trb[e_]; \
        if (MODE == NEARC) { int k_ = kidx0 + e_; k_ = k_ < 0 ? 0 : (k_ < TR_N - 1 ? k_ : TR_N - 1); s_ += trh[k_]; } \
        float p_ = __builtin_amdgcn_exp2f(s_); \
        if (MODE == NEARW) p_ = (kidx0 + e_ >= TR_D0 - 511) ? p_ : 0.f; \
        S[a][i] = p_; ls += p_; } while (0)
#define ATT_B4(a, i0) do { ATT_B(a, (i0)); ATT_B(a, (i0) + 1); ATT_B(a, (i0) + 2); ATT_B(a, (i0) + 3); } while (0)
#define ATT_PACK(a) do { _Pragma("unroll") for (int s2 = 0; s2 < 2; ++s2) { v4u w_ = {cvtpk(S[a][8 * s2 + 0], S[a][8 * s2 + 1]), cvtpk(S[a][8 * s2 + 2], S[a][8 * s2 + 3]), cvtpk(S[a][8 * s2 + 4], S[a][8 * s2 + 5]), cvtpk(S[a][8 * s2 + 6], S[a][8 * s2 + 7])}; \
        if (MASKED) { w_.x &= pmask; w_.y &= pmask; w_.z &= pmask; w_.w &= pmask; } \
        pf[a][s2] = __builtin_bit_cast(bf16x8, w_); } } while (0)
#define ATT_U(a) do { if (CMP) { float rq_[4]; _Pragma("unroll") for (int q = 0; q < 4; ++q) rq_[q] = xhalf(S[a][4 * q + 3]); \
        _Pragma("unroll") for (int q = 0; q < 4; ++q) { const float own_ = (S[a][4 * q] + S[a][4 * q + 1]) + (S[a][4 * q + 2] + S[a][4 * q + 3]); \
            const float prev_ = hh ? rq_[q] : (q > 0 ? rq_[q - 1] : carry); u[a][q] = own_ + prev_; } carry = rq_[3]; } } while (0)
#define ATT_VRD(m, a) vf[m] = *(const LAS bf16x8*)(Vb + (32 * ((m) & 1) + r) * 128 + (((4 * (a) + 2 * ((m) >> 1) + hh) ^ (r & 7)) * 16))
    const f32x16 zero = {0.f, 0.f, 0.f, 0.f, 0.f, 0.f, 0.f, 0.f, 0.f, 0.f, 0.f, 0.f, 0.f, 0.f, 0.f, 0.f};
#pragma unroll
    for (int kk = 0; kk < 4; ++kk) kf[0][kk] = *(const LAS bf16x8*)(Kb + r * 128 + (((2 * kk + hh) ^ (r & 7)) * 16));
    SBAR();
#define ATT_KRD(kk) kf[1][kk] = *(const LAS bf16x8*)(Kb + (32 + r) * 128 + (((2 * (kk) + hh) ^ (r & 7)) * 16))
    S[0] = __builtin_amdgcn_mfma_f32_32x32x16_bf16(kf[0][0], qf[0], zero, 0, 0, 0); ATT_KRD(0); SBAR();
    S[0] = __builtin_amdgcn_mfma_f32_32x32x16_bf16(kf[0][1], qf[1], S[0], 0, 0, 0); ATT_KRD(1); SBAR();
    S[0] = __builtin_amdgcn_mfma_f32_32x32x16_bf16(kf[0][2], qf[2], S[0], 0, 0, 0); ATT_KRD(2); SBAR();
    S[0] = __builtin_amdgcn_mfma_f32_32x32x16_bf16(kf[0][3], qf[3], S[0], 0, 0, 0); ATT_KRD(3); SBAR();
#undef ATT_KRD
    S[1] = __builtin_amdgcn_mfma_f32_32x32x16_bf16(kf[1][0], qf[0], zero, 0, 0, 0); ATT_VRD(0, 0); ATT_B4(0, 0); SBAR();
    S[1] = __builtin_amdgcn_mfma_f32_32x32x16_bf16(kf[1][1], qf[1], S[1], 0, 0, 0); ATT_VRD(1, 0); ATT_B4(0, 4); SBAR();
    S[1] = __builtin_amdgcn_mfma_f32_32x32x16_bf16(kf[1][2], qf[2], S[1], 0, 0, 0); ATT_VRD(2, 0); ATT_B4(0, 8); SBAR();
    S[1] = __builtin_amdgcn_mfma_f32_32x32x16_bf16(kf[1][3], qf[3], S[1], 0, 0, 0); ATT_VRD(3, 0); ATT_B4(0, 12); SBAR();
    ATT_U(0); ATT_PACK(0); SBAR();
    O[0] = __builtin_amdgcn_mfma_f32_32x32x16_bf16(vf[0], pf[0][0], O[0], 0, 0, 0); ATT_VRD(0, 1); ATT_B4(1, 0); SBAR();
    O[1] = __builtin_amdgcn_mfma_f32_32x32x16_bf16(vf[1], pf[0][0], O[1], 0, 0, 0); ATT_VRD(1, 1); ATT_B4(1, 4); SBAR();
    O[0] = __builtin_amdgcn_mfma_f32_32x32x16_bf16(vf[2], pf[0][1], O[0], 0, 0, 0); ATT_VRD(2, 1); ATT_B4(1, 8); SBAR();
    O[1] = __builtin_amdgcn_mfma_f32_32x32x16_bf16(vf[3], pf[0][1], O[1], 0, 0, 0); ATT_VRD(3, 1); ATT_B4(1, 12); SBAR();
    ATT_U(1); ATT_PACK(1); SBAR();
    O[0] = __builtin_amdgcn_mfma_f32_32x32x16_bf16(vf[0], pf[1][0], O[0], 0, 0, 0);
    O[1] = __builtin_amdgcn_mfma_f32_32x32x16_bf16(vf[1], pf[1][0], O[1], 0, 0, 0);
    O[0] = __builtin_amdgcn_mfma_f32_32x32x16_bf16(vf[2], pf[1][1], O[0], 0, 0, 0);
    O[1] = __builtin_amdgcn_mfma_f32_32x32x16_bf16(vf[3], pf[1][1], O[1], 0, 0, 0);
    l += (MASKED && !rowsel) ? 0.f : ls;
#undef ATT_B
#undef ATT_B4
#undef ATT_PACK
#undef ATT_U
#undef ATT_VRD
}
#undef SBAR
}

__device__ __forceinline__ void attn_unit(Frame& F, const Args& A, int bg, int c, size_t ydst_off, unsigned long long& tacc) {
    using namespace att;
    unsigned char* ws = A.ws;
    int tid = F.tid; asm volatile("" : "+v"(tid));
    const int lane = tid & 63, w = F.wave, r = lane & 31, hh = lane >> 5, hg = r >> 3, qi = r & 7;
    const int b = bg >> 1, g = bg & 1, h = g * 4 + hg;
    const int t = 64 * c + 8 * w + qi; const size_t tok = (size_t)b * SEQ + t;
    LAS unsigned char* L = F.lds + RING_OFF;
    const LAS float* tblh = (const LAS float*)(F.lds + TBL_OFF) + h * 132;
    const LAS float* trh = (const LAS float*)(L + OFF_TR) + h * TR_N;
    bf16* Y = (bf16*)(ws + WS_Y);
    bf16* yrow = Y + tok * DM + 512 + h * 64;
    if (DBG_T == 60) tacc -= TSTAMP();
    bf16x8 qf[4];
#pragma unroll
    for (int kk = 0; kk < 4; ++kk) qf[kk] = *(const bf16x8*)(yrow + 16 * kk + 8 * hh);
    const int nc = (c >> 4) + 1, ns = c + 1, w0 = c > 8 ? c - 8 : 0, nw = c - w0 + 1, ntile = nc + ns + nw;
    const int srow = tid >> 3, sch = (tid & 7) ^ (srow & 7);
    const unsigned ldsw = (unsigned)w * 1024u;
#define ATT_DMA(i) do { const int i_ = (i); const bf16* kp_; const bf16* vp_; size_t ldv_; \
        if (i_ < nc) { kp_ = (const bf16*)(ws + WS_KCMP) + ((size_t)bg * 256 + 64 * i_) * 64; vp_ = (const bf16*)(ws + WS_VCMPT) + (size_t)bg * 64 * 256 + 64 * i_; ldv_ = 256; } \
        else if (i_ < nc + ns) { const int j_ = i_ - nc; kp_ = (const bf16*)(ws + WS_KS) + ((size_t)bg * SEQ + 64 * j_) * 64; vp_ = (const bf16*)(ws + WS_VST) + (size_t)bg * 64 * SEQ + 64 * j_; ldv_ = SEQ; } \
        else { const int j_ = w0 + i_ - nc - ns; kp_ = (const bf16*)(ws + WS_KW) + ((size_t)bg * SEQ + 64 * j_) * 64; vp_ = (const bf16*)(ws + WS_VWT) + (size_t)bg * 64 * SEQ + 64 * j_; ldv_ = SEQ; } \
        const int sl_ = ((i_ >> 1) % 3) * 2 + (i_ & 1); \
        __builtin_amdgcn_global_load_lds((const unsigned*)(kp_ + srow * 64 + sch * 8), (LAS unsigned*)(L + OFF_KV + sl_ * 2 * TILEB + ldsw), 16, 0, 0); \
        __builtin_amdgcn_global_load_lds((const unsigned*)(vp_ + (size_t)srow * ldv_ + sch * 8), (LAS unsigned*)(L + OFF_KV + sl_ * 2 * TILEB + TILEB + ldsw), 16, 0, 0); } while (0)
#define ATT_WAITN(n) do { const int n_ = (n); if (n_ >= 2) asm volatile("s_waitcnt vmcnt(4) lgkmcnt(0)" ::: "memory"); else if (n_ == 1) asm volatile("s_waitcnt vmcnt(2) lgkmcnt(0)" ::: "memory"); \
        else asm volatile("s_waitcnt vmcnt(0) lgkmcnt(0)" ::: "memory"); } while (0)
#define ATT_NEXT(i) do { if (((i) & 1) == 0) { if ((i) + 4 < ntile) ATT_DMA((i) + 4); if ((i) + 5 < ntile) ATT_DMA((i) + 5); } if (DBG_T == 1) tacc -= TSTAMP(); } while (0)
#define ATT_FLIP(i) do { if (DBG_T == 1) tacc += TSTAMP(); if ((((i) & 1) == 1) || (i) + 1 == ntile) { if (DBG_T == 2) tacc -= TSTAMP(); \
        const int s2_ = ((i) | 1) + 3; ATT_WAITN(s2_ + 1 < ntile ? 2 : (s2_ < ntile ? 1 : 0)); \
        __builtin_amdgcn_s_barrier(); asm volatile("" ::: "memory"); if (DBG_T == 2) tacc += TSTAMP(); } } while (0)
    ATT_DMA(0); if (ntile > 1) ATT_DMA(1); if (ntile > 2) ATT_DMA(2); if (ntile > 3) ATT_DMA(3);
    ATT_WAITN(ntile > 3 ? 2 : (ntile > 2 ? 1 : 0));
    __builtin_amdgcn_s_barrier(); asm volatile("" ::: "memory");
    asm volatile("" : "+v"(qf[0]), "+v"(qf[1]), "+v"(qf[2]), "+v"(qf[3]));
    if (DBG_T == 60) tacc += TSTAMP();
    f32x16 out[2], O[2];
#pragma unroll
    for (int i = 0; i < 16; ++i) { out[0][i] = 0.f; out[1][i] = 0.f; O[0][i] = 0.f; O[1][i] = 0.f; }
    float l = 0.f, carry = 0.f, dummy_u[2][4];
    int it = 0;
    float u[4][2][4];
#pragma unroll
    for (int i = 0; i < 4; ++i)
#pragma unroll
        for (int a = 0; a < 2; ++a)
#pragma unroll
            for (int q = 0; q < 4; ++q) u[i][a][q] = 0.f;
#pragma unroll
    for (int i = 0; i < 4; ++i) {
        if (i < nc) {
            ATT_NEXT(it);
            const LAS unsigned char* Kb = L + OFF_KV + (((it >> 1) % 3) * 2 + (it & 1)) * 2 * TILEB; const LAS unsigned char* Vb = Kb + TILEB;
            const bool far = 64 * c >= 1024 * i + 1167;
            if (far) tile<FAR, true, false>(Kb, Vb, qf, true, trh, 0, O, l, u[i], carry, r, hh);
            else tile<NEARC, true, false>(Kb, Vb, qf, true, trh, TR_D0 - t + 31 + 16 * (64 * i + 4 * hh), O, l, u[i], carry, r, hh);
            ATT_FLIP(it); ++it;
        }
    }
    unsigned long long mask;
    if (DBG_T == 61) tacc -= TSTAMP();
    {
        const float g0 = ((const float*)(ws + WS_GATES))[tok * 24 + h]; const float lt = l + xhalf(l); const float linv = lt > 0.f ? 1.f / lt : 0.f; const float sc = g0 * linv;
#pragma unroll
        for (int i = 0; i < 16; ++i) { out[0][i] += sc * O[0][i]; out[1][i] += sc * O[1][i]; O[0][i] = 0.f; O[1][i] = 0.f; }
        LAS float* impw = (LAS float*)(L + OFF_IMP + w * 2048);
#pragma unroll
        for (int i = 0; i < 4; ++i)
#pragma unroll
            for (int a = 0; a < 2; ++a)
#pragma unroll
                for (int q = 0; q < 4; ++q) {
                    float x = u[i][a][q] * linv;
                    x += __builtin_bit_cast(float, __builtin_amdgcn_update_dpp(0, __builtin_bit_cast(int, x), 0x128, 0xf, 0xf, false));
                    { const unsigned xb = __builtin_bit_cast(unsigned, x); auto pr = __builtin_amdgcn_permlane16_swap(xb, xb, false, false);
                      const unsigned p0 = pr[0], p1 = pr[1];
                      x = __builtin_bit_cast(float, p0) + __builtin_bit_cast(float, p1); }
                    const int j = 8 * (2 * i + a) + 2 * q + hh;
                    const bool forced = (j == 0) || (j == c) || (j == c - 1);
                    x = (j <= c) ? (forced ? 1e6f : x) : -1.f;
                    const unsigned bits = (__builtin_bit_cast(unsigned, x) & ~63u) | (unsigned)(63 - j);
                    impw[qi * 64 + j] = __builtin_bit_cast(float, bits);
                }
        LDS_WAIT(); asm volatile("" ::: "memory");
        const int q2 = lane >> 3, part = lane & 7;
        const LAS float* iq = impw + q2 * 64;
        float mine[8]; int cnt[8];
        { const f32x4 m0 = *(const LAS f32x4*)(iq + 8 * part), m1 = *(const LAS f32x4*)(iq + 8 * part + 4);
#pragma unroll
          for (int i = 0; i < 4; ++i) { mine[i] = m0[i]; mine[4 + i] = m1[i]; cnt[i] = 0; cnt[4 + i] = 0; } }
        unsigned byte = 0xffu;
        if (c >= 16) {
#pragma unroll 1
            for (int k = 0; 4 * k <= c; ++k) { const f32x4 v = *(const LAS f32x4*)(iq + 4 * k);
#pragma unroll
                for (int e = 0; e < 4; ++e)
#pragma unroll
                    for (int i = 0; i < 8; ++i) cnt[i] += (v[e] > mine[i]) ? 1 : 0; }
            byte = 0;
#pragma unroll
            for (int i = 0; i < 8; ++i) byte |= (cnt[i] < 16) ? (1u << i) : 0u;
        }
        LAS unsigned char* mw = (LAS unsigned char*)(L + OFF_MSK + w * 64);
        mw[q2 * 8 + part] = (unsigned char)byte;
        LDS_WAIT(); asm volatile("" ::: "memory");
        mask = *(const LAS unsigned long long*)(mw + qi * 8);
        l = 0.f;
    }
    if (DBG_T == 61) tacc += TSTAMP();
    unsigned long long uni = 0;
#pragma unroll
    for (int q = 0; q < 8; ++q) { uni |= (unsigned long long)(unsigned)__builtin_amdgcn_readlane((int)(unsigned)mask, q) | ((unsigned long long)(unsigned)__builtin_amdgcn_readlane((int)(unsigned)(mask >> 32), q) << 32); }
#pragma unroll 1
    for (int j = 0; j <= c; ++j) {
        ATT_NEXT(it);
        if ((uni >> j) & 1ull) {
            const LAS unsigned char* Kb = L + OFF_KV + (((it >> 1) % 3) * 2 + (it & 1)) * 2 * TILEB; const LAS unsigned char* Vb = Kb + TILEB;
            const bool rs = (mask >> j) & 1ull;
            if (j <= c - 3) tile<FAR, false, true>(Kb, Vb, qf, rs, trh, 0, O, l, dummy_u, carry, r, hh);
            else tile<NEARS, false, true>(Kb, Vb, qf, rs, trh, TR_D0 - t + 64 * j + 4 * hh, O, l, dummy_u, carry, r, hh);
        }
        ATT_FLIP(it); ++it;
    }
    {
        const float g1 = ((const float*)(ws + WS_GATES))[tok * 24 + 8 + h]; const float lt = l + xhalf(l); const float sc = lt > 0.f ? g1 / lt : 0.f;
#pragma unroll
        for (int i = 0; i < 16; ++i) { out[0][i] += sc * O[0][i]; out[1][i] += sc * O[1][i]; O[0][i] = 0.f; O[1][i] = 0.f; }
        l = 0.f;
    }
#pragma unroll 1
    for (int j = w0; j <= c; ++j) {
        ATT_NEXT(it);
        const LAS unsigned char* Kb = L + OFF_KV + (((it >> 1) % 3) * 2 + (it & 1)) * 2 * TILEB; const LAS unsigned char* Vb = Kb + TILEB;
        if (j <= c - 3 && j != c - 8) tile<FAR, false, false>(Kb, Vb, qf, true, trh, 0, O, l, dummy_u, carry, r, hh);
        else if (j == c - 8) tile<NEARW, false, false>(Kb, Vb, qf, true, trh, TR_D0 - t + 64 * j + 4 * hh, O, l, dummy_u, carry, r, hh);
        else tile<NEARS, false, false>(Kb, Vb, qf, true, trh, TR_D0 - t + 64 * j + 4 * hh, O, l, dummy_u, carry, r, hh);
        ATT_FLIP(it); ++it;
    }
    if (DBG_T == 50 || DBG_T == 51) {
        f32x16 Ox[2] = {O[0], O[1]}; float lx = 0.f;
        if (DBG_T == 50 || w < 4) {
            tacc -= TSTAMP();
#pragma unroll 1
            for (int rep = 0; rep < 128; ++rep) tile<FAR, false, true>(L + OFF_KV, L + OFF_KV + TILEB, qf, (mask >> (rep & 63)) & 1ull, trh, 0, Ox, lx, dummy_u, carry, r, hh);
            tacc += TSTAMP();
        }
        asm volatile("" :: "v"(Ox[0]), "v"(Ox[1]), "v"(lx));
    }
    {
        const float g2 = ((const float*)(ws + WS_GATES))[tok * 24 + 16 + h]; const float lt = l + xhalf(l); const float sc = lt > 0.f ? g2 / lt : 0.f;
#pragma unroll
        for (int i = 0; i < 16; ++i) { out[0][i] += sc * O[0][i]; out[1][i] += sc * O[1][i]; }
    }
    if (DBG_T == 62) tacc -= TSTAMP();
    bf16* yout = (bf16*)(ws + WS_Y) + tok * DM + 512 + h * 64;
#pragma unroll
    for (int dt = 0; dt < 2; ++dt)
#pragma unroll
        for (int q = 0; q < 4; ++q) { v2u wv; wv.x = cvtpk(out[dt][4 * q], out[dt][4 * q + 1]); wv.y = cvtpk(out[dt][4 * q + 2], out[dt][4 * q + 3]);
            *(v2u*)((bf16*)((unsigned char*)yout + ydst_off) + 32 * dt + 8 * q + 4 * hh) = wv; }
    __syncthreads();
    if (DBG_T == 62) tacc += TSTAMP();
#undef ATT_DMA
#undef ATT_WAITN
#undef ATT_NEXT
#undef ATT_FLIP
}

__global__ void __launch_bounds__(NWAVES * 64, 2) mk_fwd(Args args) {
    extern __shared__ __attribute__((aligned(16))) unsigned char lds[];
    Frame F;
    F.lds = (LAS unsigned char*)lds;
    F.MISC = (volatile LAS unsigned*)(F.lds + MISC_OFF);
    F.tid = threadIdx.x; F.lane = F.tid & 63; F.wave = __builtin_amdgcn_readfirstlane(F.tid >> 6);
    F.G = gridDim.x; { const int bx = blockIdx.x; F.vcu = (F.G % 8 == 0) ? (bx % 8) * (F.G / 8) + bx / 8 : bx; }
    unsigned char* ws = args.ws;
    F.ctl = (gu32*)(ws + WS_CTL);
    for (int u = F.tid; u < (LDS_BYTES - LDSCTL_OFF) / 4; u += NWAVES * 64) ((LAS unsigned*)(F.lds + LDSCTL_OFF))[u] = 0u;
    __syncthreads();
    if (F.tid < 128) { const int n = F.tid; int bkt = n;
        if (n >= 16) { const float nf = (float)n; int large = 16 + (int)(logf(nf / 16.f) / logf(8.f) * 16.f); bkt = large < 31 ? large : 31; }
        ((LAS unsigned char*)(F.lds + TB_OFF))[n] = (unsigned char)bkt; }
    __syncthreads();
    for (int e = F.tid; e < 8 * 129; e += NWAVES * 64) { const int hh_ = e / 129, x = e % 129; const int bk = x < 128 ? ((LAS unsigned char*)(F.lds + TB_OFF))[x] : 31;
        ((LAS float*)(F.lds + TBL_OFF))[hh_ * 132 + x] = args.in[17][hh_ * 32 + bk] * 1.4426950408889634f; }
    __syncthreads();
    XcdBarrier bar; bar.bar = (unsigned*)(F.ctl + CW_BAR) + args.li * XCD_BAR_WORDS; bar.x = 0; bar.st = nullptr;
    if (N_LAUNCHES != PER_PHASE) bar = xcd_barrier_post((unsigned*)(F.ctl + CW_BAR) + args.li * XCD_BAR_WORDS, F.MISC + 8);
#define GRID_BAR() do { if (N_LAUNCHES != PER_PHASE) xcd_barrier(bar); } while (0)
    const int lo = args.ph_lo, hi = args.ph_hi;
#define IN(k) (lo <= (k) && (k) < hi)
#define BOTH(k) (IN(k) && IN((k) + 1))
    bf16* XB = (bf16*)(ws + WS_XB); bf16* ACT = (bf16*)(ws + WS_ACT); bf16* Y = (bf16*)(ws + WS_Y);
    float* SS0 = (float*)(ws + WS_SS0); float* SS1 = (float*)(ws + WS_SS1); float* SS2 = (float*)(ws + WS_SS2); float* SS3 = (float*)(ws + WS_SS3);

    unsigned long long tacc = 0;
#define PT0(k) do { if (DBG_T == 10 + (k)) tacc -= TSTAMP(); if (DBG_T == 30 + (k)) tacc += TSTAMP(); } while (0)
#define PT1(k) do { if (DBG_T == 10 + (k)) tacc += TSTAMP(); if (DBG_T == 31 + (k)) tacc -= TSTAMP(); } while (0)
    if (IN(0)) { PT0(0); NREP(0) p0_prologue(F, args); PT1(0); if (BOTH(0)) GRID_BAR(); }
    if (IN(1)) {
        PT0(1);
        pg8::Gemm g{XB, (const bf16*)(ws + WS_WGU1), MTOK, NGU, DM, DM, DM}; pg8::StaticOrder S; S.init(MTOK, NGU, F.G, (int)blockIdx.x);
        EpiSwiGLU E{SS0, ACT};
        NREP(1) pg8::gemm_phase<EpiSwiGLU, pg8::StaticOrder, true, true>(F.lds + RING_OFF, g, S, E);
        PT1(1);
        if (BOTH(1)) GRID_BAR();
    }
    if (IN(2)) {
        PT0(2);
        pg8::Gemm g{ACT, (const bf16*)(ws + WS_WD1), MTOK, DM, DFF, DFF, DFF}; pg8::StaticOrder S; S.init(MTOK, DM, F.G, (int)blockIdx.x);
        EpiResid E{args.in[0], args.out, XB, SS1, 0.5f};
        NREP(2) pg8::gemm_phase<EpiResid, pg8::StaticOrder, true, true>(F.lds + RING_OFF, g, S, E);
        PT1(2);
        if (BOTH(2)) GRID_BAR();
    }
    if (IN(3)) {
        PT0(3);
        pg8::Gemm g{XB, (const bf16*)(ws + WS_WIN), MTOK, NIN, DM, DM, DM}; pg8::StaticOrder S; S.init(MTOK, NIN, F.G, (int)blockIdx.x);
        EpiMix E{SS1, ws, args.in[10], args.in[11]};
        NREP(3) pg8::gemm_phase<EpiMix, pg8::StaticOrder, true, true>(F.lds + RING_OFF, g, S, E);
        PT1(3);
        if (BOTH(3)) GRID_BAR();
    }
    if (IN(4)) {
        PT0(4);
        for (int u = F.vcu; u < 256; u += F.G) cmp_unit(F, args, u);
        for (int u = F.vcu; u < 256; u += F.G) gmlp_unit(F, args, u);
        PT1(4);
        if (BOTH(4)) GRID_BAR();
    }
    if (IN(5)) {
        PT0(5);
        if (DBG_T == 3) tacc -= TSTAMP();
        if (DBG_T == 63) tacc -= TSTAMP();
        {
            LAS float* TR = (LAS float*)(F.lds + RING_OFF + att::OFF_TR); const LAS float* tbl = (const LAS float*)(F.lds + TBL_OFF);
            for (int e = F.tid; e < 8 * att::TR_N; e += NWAVES * 64) { const int hh_ = e / att::TR_N, k = e % att::TR_N, dist = att::TR_D0 - k;
                TR[e] = dist < 0 ? att::NEGBIG : tbl[hh_ * 132 + (dist < 128 ? dist : 128)] - tbl[hh_ * 132 + 128]; }
            __syncthreads();
        }
        if (DBG_T == 63) tacc += TSTAMP();
#if DBG_REP == 5
#pragma unroll 1
        for (int n = F.vcu; n < NBG * 64; n += F.G) { const int v = n & 255, i = n >> 8, x = v >> 5, lv = v & 31; attn_unit(F, args, 2 * x + (i & 1), i < 2 ? 63 - lv : lv, (size_t)(300 - 120) * MiB, tacc); }
#endif
        if (F.G % 8 == 0) {
            const int x = (int)blockIdx.x & 7; gu32* head = F.ctl + CW_Q + 64 * x;
#pragma unroll 1
            for (;;) {
                if (F.tid == 0) F.MISC[0] = __hip_atomic_fetch_add(head, 1u, RLX_AGENT);
                __syncthreads(); const int u = (int)F.MISC[0]; __syncthreads();
                if (u >= 128) break;
                attn_unit(F, args, 2 * x + (u & 1), 63 - (u >> 1), (size_t)0, tacc);
            }
        } else {
#pragma unroll 1
            for (int n = (int)blockIdx.x; n < NBG * 64; n += F.G) attn_unit(F, args, n & 15, 63 - (n >> 4), (size_t)0, tacc);
        }
        if (DBG_T == 3) tacc += TSTAMP();
        PT1(5);
        if (BOTH(5)) GRID_BAR();
    }
    if (IN(6)) {
        PT0(6);
        pg8::Gemm g{Y, (const bf16*)(ws + WS_WOUT), MTOK, DM, DM, DM, DM}; pg8::StaticOrder S; S.init(MTOK, DM, F.G, (int)blockIdx.x);
        EpiResid E{args.out, args.out, XB, SS2, 1.0f};
        pg8::gemm_phase<EpiResid, pg8::StaticOrder, true, true>(F.lds + RING_OFF, g, S, E);
        PT1(6);
        if (BOTH(6)) GRID_BAR();
    }
    if (IN(7)) {
        PT0(7);
        pg8::Gemm g{XB, (const bf16*)(ws + WS_WGU2), MTOK, NGU, DM, DM, DM}; pg8::StaticOrder S; S.init(MTOK, NGU, F.G, (int)blockIdx.x);
        EpiSwiGLU E{SS2, ACT};
        pg8::gemm_phase<EpiSwiGLU, pg8::StaticOrder, true, true>(F.lds + RING_OFF, g, S, E);
        PT1(7);
        if (BOTH(7)) GRID_BAR();
    }
    if (IN(8)) {
        PT0(8);
        pg8::Gemm g{ACT, (const bf16*)(ws + WS_WD2), MTOK, DM, DFF, DFF, DFF}; pg8::StaticOrder S; S.init(MTOK, DM, F.G, (int)blockIdx.x);
        EpiResid E{args.out, args.out, nullptr, SS3, 0.5f};
        pg8::gemm_phase<EpiResid, pg8::StaticOrder, true, true>(F.lds + RING_OFF, g, S, E);
        PT1(8);
        if (BOTH(8)) GRID_BAR();
    }
    if (IN(9)) {
        PT0(9);
        const int gw = F.vcu * NWAVES + F.wave, NGW = F.G * NWAVES; const float* gf = args.in[23];
        for (int m = gw; m < MTOK; m += NGW) {
            float s = (F.lane < 16) ? SS3[(size_t)m * 16 + F.lane] : 0.f; s = wave_sum(s);
            const float ri = rsq_acc(s, 1.f / DM);
            GAS f32x4* xr = (GAS f32x4*)(args.out + (size_t)m * DM) + F.lane;
#pragma unroll
            for (int j = 0; j < 4; ++j) { f32x4 v = xr[64 * j]; const f32x4 gg = *((const f32x4*)gf + F.lane + 64 * j); v = v * ri * gg; xr[64 * j] = v; }
        }
        PT1(9);
    }
    if (DBG_T != 0) { __syncthreads(); if (F.lane == 0) { F.MISC[16 + 2 * F.wave] = (unsigned)tacc; F.MISC[17 + 2 * F.wave] = (unsigned)(tacc >> 32); } __syncthreads();
        if (blockIdx.x == 0 && F.tid == 0) { const unsigned long long tw = (unsigned long long)F.MISC[16 + 2 * (DBG_TW)] | ((unsigned long long)F.MISC[17 + 2 * (DBG_TW)] << 32);
            const unsigned long long t0 = TSTAMP(); while (TSTAMP() - t0 < 16ull * tw) __builtin_amdgcn_s_sleep(8); } }
#undef IN
#undef BOTH
#undef GRID_BAR
}

extern "C" void kernel_launch(void* const* d_in, const int* in_sizes, int n_in, void* d_out, int out_size, void* d_ws, size_t ws_size, hipStream_t stream) {
    static int grid = 0;
    if (grid == 0) {
        if (n_in != 24 || in_sizes[0] != MTOK * DM || out_size != MTOK * DM || ws_size < WS_END) { fprintf(stderr, "kernel_launch: unexpected shapes (n_in %d, in0 %d, out %d, ws %zu)\n", n_in, n_in > 0 ? in_sizes[0] : -1, out_size, ws_size); grid = -1; return; }
        int dev = 0, cus = 0, per_cu = 0;
        if (hipGetDevice(&dev) != hipSuccess || hipDeviceGetAttribute(&cus, hipDeviceAttributeMultiprocessorCount, dev) != hipSuccess) { grid = -1; return; }
        if (hipFuncSetAttribute((const void*)mk_fwd, hipFuncAttributeMaxDynamicSharedMemorySize, LDS_BYTES) != hipSuccess) { fprintf(stderr, "kernel_launch: hipFuncSetAttribute failed\n"); grid = -1; return; }
        if (hipOccupancyMaxActiveBlocksPerMultiprocessor(&per_cu, (const void*)mk_fwd, NWAVES * 64, LDS_BYTES) != hipSuccess || per_cu < 1) { fprintf(stderr, "kernel_launch: occupancy query says %d blocks per CU\n", per_cu); (void)hipGetLastError(); grid = -1; return; }
        grid = cus;
    }
    if (grid < 0) return;
    (void)hipMemsetAsync((char*)d_ws + WS_CTL, 0, CTL_ZERO_BYTES, stream);
    Args a{};
    for (int i = 0; i < 24; ++i) a.in[i] = (const float*)d_in[i];
    a.out = (float*)d_out; a.ws = (unsigned char*)d_ws;
    if (N_LAUNCHES == 1) {
        a.ph_lo = 0; a.ph_hi = PER_PHASE; a.li = 0;
        void* kargs[] = {&a};
        hipError_t e = hipLaunchCooperativeKernel((const void*)mk_fwd, dim3(grid), dim3(NWAVES * 64), kargs, LDS_BYTES, stream);
        if (e != hipSuccess) fprintf(stderr, "kernel_launch: cooperative launch failed: %s (grid %d)\n", hipGetErrorString(e), grid);
    } else {
        for (int li = 0; li < PER_PHASE; ++li) { a.ph_lo = li; a.ph_hi = li + 1; a.li = 0;
            hipLaunchKernelGGL(mk_fwd, dim3(grid), dim3(NWAVES * 64), LDS_BYTES, stream, a); }
    }
}
```

```cpp
#include <hip/hip_runtime.h>
#include <cstdio>
#include <cstdint>

#ifndef DBG_REP
#define DBG_REP -1
#endif
#ifndef DBG_TW
#define DBG_TW 0
#endif
#ifndef DBG_T
#define DBG_T 0
#endif
#define NREP(k) for (int rep_ = 0; rep_ < ((DBG_REP) == (k) ? 2 : 1); ++rep_)
#ifndef MK_N_LAUNCHES
#define MK_N_LAUNCHES 1
#endif

namespace pg8 {
#define PG8_LAS __attribute__((address_space(3)))
typedef unsigned short bf16_t;
typedef short bf16x8 __attribute__((ext_vector_type(8)));
typedef float f32x4 __attribute__((ext_vector_type(4)));
typedef unsigned u32x4 __attribute__((ext_vector_type(4)));
typedef unsigned u32x2 __attribute__((ext_vector_type(2)));
constexpr int BM = 256, BK = 64, HALF = 128, HTB = HALF * BK * 2, STAGE_BYTES = 8 * HTB, NXCD = 8, WGM = 8;

__host__ __device__ __forceinline__ int lds_byte(int r, int c) { const int st = (r >> 4) * 2 + (c >> 5), rr = r & 15, cc = c & 31, ob = rr * 64 + cc * 2; return st * 1024 + (ob ^ (((ob >> 9) & 1) << 5)); }
__host__ __device__ __forceinline__ void stage_rc(int b, int& R, int& C) { const int st = b / 1024, sb = b % 1024, swz = sb ^ (((sb >> 9) & 1) << 5); R = (st >> 1) * 16 + swz / 64; C = (st & 1) * 32 + (swz % 64) / 2; }
__host__ __device__ __forceinline__ int perm32(int rho) { const int n = rho >> 4, i = rho & 15; return 8 * (i >> 2) + 4 * n + (i & 3); }

struct Unit { int pm, pn; };
struct Gemm { const bf16_t* A; const bf16_t* Bt; int M, N, K, lda, ldb; };

struct StaticOrder {
    int nM, nN, nwg, G, c;
    __host__ __device__ void init(int M, int N, int G_, int c_) { nM = M / BM; nN = N / BM; nwg = nM * nN; G = G_; c = c_; }
    __host__ __device__ bool next(int i, Unit& u) const {
        const long L = (long)i * G + c; if (L >= nwg) return false;
        int wgid = (int)L; { const int q = nwg / NXCD, r = nwg % NXCD, xcd = wgid % NXCD, off = wgid / NXCD; wgid = (xcd < r ? xcd * (q + 1) : r * (q + 1) + (xcd - r) * q) + off; }
        const int nig = WGM * nN, gid = wgid / nig, fm = gid * WGM, gsz = (nM - fm) < WGM ? (nM - fm) : WGM;
        u.pm = fm + ((wgid % nig) % gsz); u.pn = (wgid % nig) / gsz; return true;
    }
};
struct CmpOrder {
    int c;
    __device__ bool next(int i, Unit& u) const { if (i != 0 || c >= 32) return false; u.pm = c; u.pn = c >> 4; return true; }
};

__device__ __forceinline__ unsigned cvt_pk_bf16(float lo, float hi) { unsigned r; asm volatile("v_cvt_pk_bf16_f32 %0, %1, %2" : "=v"(r) : "v"(lo), "v"(hi)); return r; }

template <class Epi, class Sched, bool ALIGN_EPI = false, bool SP2 = false>
__device__ __forceinline__ void gemm_phase(PG8_LAS unsigned char* lds, const Gemm g, const Sched& S, const Epi& E) {
    const int tid = threadIdx.x, wid = __builtin_amdgcn_readfirstlane(tid >> 6), lane = tid & 63, wr = wid >> 2, wc = wid & 3, fr = lane & 15, fq = lane >> 4;
    const int K = g.K, nt = K / BK;
    unsigned voffA[2], voffB[2];
#pragma unroll
    for (int i = 0; i < 2; ++i) { int R, C; stage_rc(tid * 16 + i * 8192, R, C); const int Rb = Epi::PERM ? ((R & ~31) + perm32(R & 31)) : R;
        voffA[i] = (unsigned)(R * g.lda + C) * 2u; voffB[i] = (unsigned)(Rb * g.ldb + C) * 2u; }
    const size_t kstep = (size_t)(BK * 2);
    const size_t hstepA = (size_t)HALF * g.lda * 2, hstepB = (size_t)HALF * g.ldb * 2;
    const size_t tstepA = 2 * hstepA, tstepB = 2 * hstepB;
    const unsigned ldsw = (unsigned)wid * 1024u;
    const int aoff = lds_byte(wr * 64 + fr, fq * 8), boff = lds_byte(wc * 32 + fr, fq * 8);
#define PG8_SA(b, h) (((b) * 2 + (h)) * HTB)
#define PG8_SB(b, h) ((4 + (b) * 2 + (h)) * HTB)
#define PG8_STAGE(bufoff, gbase, voff) do { _Pragma("unroll") for (int _i = 0; _i < 2; ++_i) \
        __builtin_amdgcn_global_load_lds((const unsigned*)((const char*)(gbase) + (voff)[_i]), (PG8_LAS unsigned*)(lds + (bufoff) + ldsw + _i * 8192), 16, 0, 0); } while (0)
#define PG8_LDA(dst, b, h) do { _Pragma("unroll") for (int m = 0; m < 4; ++m) _Pragma("unroll") for (int k = 0; k < 2; ++k) dst[m][k] = *(const PG8_LAS bf16x8*)(lds + PG8_SA(b, h) + aoff + m * 2048 + k * 1024); } while (0)
#define PG8_LDB(dst, b, h) do { _Pragma("unroll") for (int n = 0; n < 2; ++n) _Pragma("unroll") for (int k = 0; k < 2; ++k) dst[n][k] = *(const PG8_LAS bf16x8*)(lds + PG8_SB(b, h) + boff + n * 2048 + k * 1024); } while (0)
#define PG8_MMA(ai, bj, At, Bt) do { __builtin_amdgcn_s_setprio(1); _Pragma("unroll") for (int m = 0; m < 4; ++m) _Pragma("unroll") for (int n = 0; n < 2; ++n) _Pragma("unroll") for (int k = 0; k < 2; ++k) \
        acc[ai][bj][m][n] = __builtin_amdgcn_mfma_f32_16x16x32_bf16(Bt[n][k], At[m][k], acc[ai][bj][m][n], 0, 0, 0); __builtin_amdgcn_s_setprio(0); } while (0)
#define PG8_WAIT_V(n) asm volatile("s_waitcnt vmcnt(" #n ")" ::: "memory")
#define PG8_WAIT_L(n) asm volatile("s_waitcnt lgkmcnt(" #n ")" ::: "memory")
#define PG8_BAR __builtin_amdgcn_s_barrier()
#define PG8_SCHED __builtin_amdgcn_sched_barrier(0)
    Unit cur, nxt; int ui = 0;
    if (!S.next(0, cur)) return;
    f32x4 acc[2][2][4][2];
#pragma unroll
    for (int a = 0; a < 2; ++a)
#pragma unroll
        for (int b = 0; b < 2; ++b)
#pragma unroll
            for (int m = 0; m < 4; ++m)
#pragma unroll
                for (int n = 0; n < 2; ++n) acc[a][b][m][n] = (f32x4){0.f, 0.f, 0.f, 0.f};
    bf16x8 At[4][2], B0[2][2], B1[2][2];
    const char* cA = (const char*)g.A + (size_t)cur.pm * tstepA; const char* cB = (const char*)g.Bt + (size_t)cur.pn * tstepB;
    if constexpr (SP2) {
        PG8_STAGE(PG8_SB(0, 0), cB, voffB); PG8_STAGE(PG8_SB(0, 1), cB + hstepB, voffB); PG8_STAGE(PG8_SA(0, 0), cA, voffA); PG8_STAGE(PG8_SA(0, 1), cA + hstepA, voffA);
        if (wr == 1) PG8_BAR;
        PG8_WAIT_V(2); PG8_BAR;
        PG8_STAGE(PG8_SB(1, 0), cB + kstep, voffB); PG8_STAGE(PG8_SA(1, 0), cA + kstep, voffA); PG8_STAGE(PG8_SB(1, 1), cB + hstepB + kstep, voffB);
        PG8_WAIT_V(6); PG8_BAR;
    } else {
        PG8_STAGE(PG8_SB(0, 0), cB, voffB); PG8_STAGE(PG8_SA(0, 0), cA, voffA); PG8_STAGE(PG8_SB(0, 1), cB + hstepB, voffB); PG8_STAGE(PG8_SA(0, 1), cA + hstepA, voffA);
        if (wr == 1) PG8_BAR;
        PG8_WAIT_V(4); PG8_BAR;
        PG8_STAGE(PG8_SB(1, 0), cB + kstep, voffB); PG8_STAGE(PG8_SA(1, 0), cA + kstep, voffA); PG8_STAGE(PG8_SB(1, 1), cB + hstepB + kstep, voffB);
        PG8_WAIT_V(6); PG8_BAR;
    }
    for (;;) {
        const bool has_next = S.next(ui + 1, nxt);
        const char* nA = has_next ? (const char*)g.A + (size_t)nxt.pm * tstepA : cA; const char* nB = has_next ? (const char*)g.Bt + (size_t)nxt.pn * tstepB : cB;
        for (int t = 0; t < nt; t += 2) {
            const bool last = (t == nt - 2);
            const char* a1 = cA + (size_t)(t + 1) * kstep;
            const char* a2 = last ? nA : cA + (size_t)(t + 2) * kstep; const char* b2 = last ? nB : cB + (size_t)(t + 2) * kstep;
            const char* a3 = a2 + kstep; const char* b3 = b2 + kstep;
            if constexpr (SP2) {
            PG8_LDB(B0, 0, 0); PG8_LDB(B1, 0, 1); PG8_SCHED; PG8_LDA(At, 0, 0); PG8_STAGE(PG8_SA(1, 1), a1 + hstepA, voffA);
            PG8_WAIT_V(8); PG8_WAIT_L(0); PG8_BAR; PG8_MMA(0, 0, At, B0); PG8_MMA(0, 1, At, B1); PG8_BAR; PG8_SCHED;
            PG8_LDA(At, 0, 1); PG8_STAGE(PG8_SB(0, 0), b2, voffB); PG8_STAGE(PG8_SB(0, 1), b2 + hstepB, voffB); PG8_STAGE(PG8_SA(0, 0), a2, voffA);
            PG8_WAIT_V(8); PG8_WAIT_L(0); PG8_BAR; PG8_MMA(1, 0, At, B0); PG8_MMA(1, 1, At, B1); PG8_BAR; PG8_SCHED;
            PG8_LDB(B0, 1, 0); PG8_LDB(B1, 1, 1); PG8_SCHED; PG8_LDA(At, 1, 0); PG8_STAGE(PG8_SA(0, 1), a2 + hstepA, voffA);
            PG8_WAIT_V(8); PG8_WAIT_L(0); PG8_BAR; PG8_MMA(0, 0, At, B0); PG8_MMA(0, 1, At, B1); PG8_BAR; PG8_SCHED;
            PG8_LDA(At, 1, 1); PG8_STAGE(PG8_SB(1, 0), b3, voffB); PG8_STAGE(PG8_SB(1, 1), b3 + hstepB, voffB); PG8_STAGE(PG8_SA(1, 0), a3, voffA);
            PG8_WAIT_V(8); PG8_WAIT_L(0); PG8_BAR; PG8_MMA(1, 0, At, B0); PG8_MMA(1, 1, At, B1); PG8_BAR; PG8_SCHED;
            } else {
            PG8_LDB(B0, 0, 0); PG8_SCHED; PG8_LDA(At, 0, 0); PG8_STAGE(PG8_SA(1, 1), a1 + hstepA, voffA);
            PG8_WAIT_L(8); PG8_BAR; PG8_WAIT_L(0); PG8_MMA(0, 0, At, B0); PG8_BAR; PG8_SCHED;
            PG8_LDB(B1, 0, 1); PG8_STAGE(PG8_SB(0, 0), b2, voffB);
            PG8_BAR; PG8_WAIT_L(0); PG8_MMA(0, 1, At, B1); PG8_BAR;
            PG8_LDA(At, 0, 1); PG8_STAGE(PG8_SA(0, 0), a2, voffA);
            PG8_BAR; PG8_WAIT_L(0); PG8_MMA(1, 0, At, B0); PG8_BAR; PG8_SCHED;
            PG8_STAGE(PG8_SB(0, 1), b2 + hstepB, voffB);
            PG8_WAIT_V(6); PG8_BAR; PG8_MMA(1, 1, At, B1); PG8_BAR;
            PG8_LDB(B0, 1, 0); PG8_SCHED; PG8_LDA(At, 1, 0); PG8_STAGE(PG8_SA(0, 1), a2 + hstepA, voffA);
            PG8_WAIT_L(8); PG8_BAR; PG8_WAIT_L(0); PG8_MMA(0, 0, At, B0); PG8_BAR; PG8_SCHED;
            PG8_LDB(B1, 1, 1); PG8_STAGE(PG8_SB(1, 0), b3, voffB);
            PG8_BAR; PG8_WAIT_L(0); PG8_MMA(0, 1, At, B1); PG8_BAR;
            PG8_LDA(At, 1, 1); PG8_STAGE(PG8_SA(1, 0), a3, voffA);
            PG8_BAR; PG8_WAIT_L(0); PG8_MMA(1, 0, At, B0); PG8_BAR; PG8_SCHED;
            PG8_STAGE(PG8_SB(1, 1), b3 + hstepB, voffB);
            PG8_WAIT_V(6); PG8_BAR; PG8_MMA(1, 1, At, B1); PG8_BAR;
            }
        }
        if constexpr (ALIGN_EPI) { if (wr == 0) PG8_BAR; }
        E(acc, cur, wr, wc, fr, fq);
        if (!has_next) break;
#pragma unroll
        for (int a = 0; a < 2; ++a)
#pragma unroll
            for (int b = 0; b < 2; ++b)
#pragma unroll
                for (int m = 0; m < 4; ++m)
#pragma unroll
                    for (int n = 0; n < 2; ++n) acc[a][b][m][n] = (f32x4){0.f, 0.f, 0.f, 0.f};
        cur = nxt; cA = nA; cB = nB; ++ui;
        if constexpr (ALIGN_EPI) { if (wr == 1) PG8_BAR; }
    }
    PG8_WAIT_V(0);
    if constexpr (!ALIGN_EPI) { if (wr == 0) PG8_BAR; }
    PG8_BAR;
#undef PG8_SA
#undef PG8_SB
#undef PG8_STAGE
#undef PG8_LDA
#undef PG8_LDB
#undef PG8_MMA
#undef PG8_WAIT_V
#undef PG8_WAIT_L
#undef PG8_BAR
#undef PG8_SCHED
}
}

constexpr int NWAVES = 8;
constexpr int BATCH = 8, SEQ = 4096, DM = 1024, MTOK = BATCH * SEQ;
constexpr int DFF = 2816, NGU = 2 * DFF, INC = 2328, NIN = 2560;
constexpr int HD = 64, NBG = 16, NCMP = 255;
constexpr float EPS = 1e-6f;
constexpr int PER_PHASE = 10;
constexpr int N_LAUNCHES = MK_N_LAUNCHES;

constexpr size_t MiB = 1u << 20;
constexpr size_t WS_CTL = 0, CTL_ZERO_BYTES = 1 * MiB;
constexpr size_t WS_WGU1 = 2 * MiB, WS_WD1 = 13 * MiB, WS_WGU2 = 19 * MiB, WS_WD2 = 30 * MiB, WS_WIN = 36 * MiB, WS_WOUT = 41 * MiB, WS_CW1 = 43 * MiB;
constexpr size_t WS_WSB = 45 * MiB, WS_CB1P = 45 * MiB + 512 * 1024, WS_CW2 = 45 * MiB + 768 * 1024;
constexpr size_t WS_SS0 = 46 * MiB, WS_SS1 = 48 * MiB, WS_SS2 = 50 * MiB, WS_SS3 = 52 * MiB, WS_SSV = 54 * MiB;
constexpr size_t WS_XB = 56 * MiB;
constexpr size_t WS_ACT = 120 * MiB;
constexpr size_t WS_Y = 120 * MiB, WS_GVT = 184 * MiB, WS_KCR = 216 * MiB, WS_VCR = 224 * MiB, WS_KS = 232 * MiB, WS_VST = 240 * MiB, WS_KW = 248 * MiB, WS_VWT = 256 * MiB;
constexpr size_t WS_GATES = 264 * MiB, WS_H1 = 268 * MiB, WS_KCMP = 272 * MiB, WS_VCMPT = 272 * MiB + 512 * 1024;
constexpr size_t WS_END = 296 * MiB;
constexpr int CW_BAR = 4096;
constexpr int CW_Q = 8192;

constexpr int RING_OFF = 0, RING_BYTES = 147456;
constexpr int LDSCTL_OFF = RING_BYTES, MISC_OFF = LDSCTL_OFF + 320;
constexpr int TB_OFF = LDSCTL_OFF + 1024;
constexpr int TBL_OFF = LDSCTL_OFF + 2048;
constexpr int LDS_BYTES = 163840;

#define GAS __attribute__((address_space(1)))
#define LAS __attribute__((address_space(3)))
typedef unsigned short bf16;
typedef unsigned v4u __attribute__((ext_vector_type(4)));
typedef unsigned v2u __attribute__((ext_vector_type(2)));
typedef float f32x4 __attribute__((ext_vector_type(4)));
typedef GAS unsigned gu32;
#define RLX_AGENT __ATOMIC_RELAXED, __HIP_MEMORY_SCOPE_AGENT
#define LDS_WAIT() asm volatile("s_waitcnt lgkmcnt(0)" ::: "memory")
#define VM_WAIT() asm volatile("s_waitcnt vmcnt(0)" ::: "memory")
__device__ __forceinline__ unsigned f2bf(float f) { unsigned u = __builtin_bit_cast(unsigned, f); return (u + 0x7fffu + ((u >> 16) & 1u)) >> 16; }
__device__ __forceinline__ unsigned pk2(float lo, float hi) { return f2bf(lo) | (f2bf(hi) << 16); }
__device__ __forceinline__ float bf2f(unsigned short b) { return __builtin_bit_cast(float, (unsigned)b << 16); }
__device__ __forceinline__ float wave_sum(float v) {
#pragma unroll
    for (int o = 1; o < 64; o <<= 1) v += __shfl_xor(v, o);
    return v;
}
__device__ __forceinline__ float wave_max(float v) {
#pragma unroll
    for (int o = 1; o < 64; o <<= 1) v = fmaxf(v, __shfl_xor(v, o));
    return v;
}
__device__ __forceinline__ float gelu_tanh(float x) { const float u2 = 1.5957691216057308f * (x + 0.044715f * x * x * x); return x / (1.f + __expf(-u2)); }
__device__ __forceinline__ float sigmoidf_(float x) { return 1.f / (1.f + __expf(-x)); }

#define XB_TMO      128
#define XB_XCNT(j)  (256  + 64 * (j))
#define XB_XSUB(j)  (1280 + 64 * (j))
#define XB_XGEN(j)  (2304 + 64 * (j))
#define XB_TOP      3328
#define XB_TOPGEN   3392
#define XCD_BAR_WORDS 3456
#define XB_SPIN_CAP (1u << 22)
__device__ __forceinline__ unsigned xb_ld(unsigned* p)              { return __hip_atomic_load(p, __ATOMIC_RELAXED, __HIP_MEMORY_SCOPE_AGENT); }
__device__ __forceinline__ unsigned xb_add(unsigned* p, unsigned v) { return __hip_atomic_fetch_add(p, v, __ATOMIC_RELAXED, __HIP_MEMORY_SCOPE_AGENT); }
__device__ __forceinline__ unsigned xb_xcc_id() { return (unsigned)__builtin_amdgcn_s_getreg((3 << 11) | 20) & 0xFu; }
#define XB_SPIN(cond, bar) do { unsigned _sp = 0; while (cond) { __builtin_amdgcn_s_sleep(1); \
    if ((++_sp & 255u) == 0u) { if (xb_ld(&(bar)[XB_TMO])) break; if (_sp > XB_SPIN_CAP) { atomicAdd(&(bar)[XB_TMO], 1u); break; } } } } while (0)
struct XcdBarrier { unsigned* bar; unsigned x; volatile LAS unsigned* st; };
__device__ __forceinline__ XcdBarrier xcd_barrier_post(unsigned* bar, volatile LAS unsigned* st) {
    XcdBarrier b; b.bar = bar; b.x = xb_xcc_id(); b.st = st;
    if (threadIdx.x == 0) (void)xb_add(&bar[XB_XCNT(b.x)], 1u);
    return b;
}
__device__ __forceinline__ void xcd_barrier_complete(unsigned* bar, unsigned x, unsigned& nloc, unsigned& nx) {
    const unsigned G = gridDim.x * gridDim.y * gridDim.z;
    unsigned sum, cnt, mine, sp = 0u;
    for (;;) {
        sum = 0u; cnt = 0u; mine = 0u;
#pragma unroll
        for (unsigned j = 0; j < 16; ++j) { const unsigned c = xb_ld(&bar[XB_XCNT(j)]); sum += c; cnt += (c > 0u) ? 1u : 0u; mine = (j == x) ? c : mine; }
        if (sum == G) break;
        __builtin_amdgcn_s_sleep(1);
        if ((++sp & 255u) == 0u) { if (xb_ld(&bar[XB_TMO])) break; if (sp > XB_SPIN_CAP) { atomicAdd(&bar[XB_TMO], 1u); break; } }
    }
    nloc = mine > 0u ? mine : 1u; nx = cnt > 0u ? cnt : 1u;
}
__device__ __forceinline__ void xcd_barrier(const XcdBarrier& b) {
    asm volatile("s_waitcnt vmcnt(0)" ::: "memory");
    __syncthreads();
    if (threadIdx.x == 0) {
        unsigned* bar = b.bar;
        __builtin_amdgcn_s_waitcnt(0);
        unsigned nloc = b.st[0], nx = b.st[1];
        if (nloc == 0u) { xcd_barrier_complete(bar, b.x, nloc, nx); b.st[0] = nloc; b.st[1] = nx; }
        const unsigned old = xb_add(&bar[XB_XSUB(b.x)], 1u);
        const unsigned gen = old / nloc;
        if (old + 1u == (gen + 1u) * nloc) {
            __builtin_amdgcn_fence(__ATOMIC_RELEASE, "agent");
            asm volatile("s_waitcnt vmcnt(0)" ::: "memory");
            const unsigned og = xb_add(&bar[XB_TOP], 1u);
            const unsigned tg = og / nx;
            if (og + 1u == (tg + 1u) * nx) xb_add(&bar[XB_TOPGEN], 1u);
            else XB_SPIN(xb_ld(&bar[XB_TOPGEN]) == tg, bar);
            __builtin_amdgcn_fence(__ATOMIC_ACQUIRE, "agent");
            xb_add(&bar[XB_XGEN(b.x)], 1u);
            asm volatile("s_waitcnt vmcnt(0)" ::: "memory");
        } else {
            XB_SPIN(xb_ld(&bar[XB_XGEN(b.x)]) == gen, bar);
            __builtin_amdgcn_fence(__ATOMIC_ACQUIRE, "agent");
            asm volatile("s_waitcnt vmcnt(0)" ::: "memory");
        }
    }
    __syncthreads();
}

__device__ __forceinline__ float row_rinv(const float* ss, int row, int fq) {
    const f32x4 p = *(const f32x4*)(ss + (size_t)row * 16 + 4 * fq);
    float s = (p[0] + p[1]) + (p[2] + p[3]);
    s += __shfl_xor(s, 16); s += __shfl_xor(s, 32);
    return __builtin_amdgcn_rsqf(s * (1.f / DM) + EPS);
}
__device__ __forceinline__ float rsq_acc(float s, float invn) { return 1.0f / sqrtf(s * invn + EPS); }

struct EpiSwiGLU {
    static constexpr bool PERM = true;
    const float* ss; bf16* act;
    __device__ __forceinline__ void operator()(const f32x4 (&acc)[2][2][4][2], const pg8::Unit& u, int wr, int wc, int fr, int fq) const {
#pragma unroll
        for (int ai = 0; ai < 2; ++ai)
#pragma unroll
            for (int m = 0; m < 4; ++m) {
                const int row = u.pm * 256 + ai * 128 + wr * 64 + m * 16 + fr;
                const float ri = row_rinv(ss, row, fq);
                float o[8];
#pragma unroll
                for (int n = 0; n < 2; ++n)
#pragma unroll
                    for (int i = 0; i < 4; ++i) { const float g = acc[ai][0][m][n][i] * ri, up = acc[ai][1][m][n][i] * ri; o[n * 4 + i] = g * sigmoidf_(g) * up; }
                v4u w; w.x = pk2(o[0], o[1]); w.y = pk2(o[2], o[3]); w.z = pk2(o[4], o[5]); w.w = pk2(o[6], o[7]);
                *(v4u*)(act + (size_t)row * DFF + u.pn * 128 + wc * 32 + fq * 8) = w;
            }
    }
};
struct EpiResid {
    static constexpr bool PERM = false;
    const float* base; float* out; bf16* xb; float* ssp; float scale;
    __device__ __forceinline__ void operator()(const f32x4 (&acc)[2][2][4][2], const pg8::Unit& u, int wr, int wc, int fr, int fq) const {
#pragma unroll
        for (int ai = 0; ai < 2; ++ai)
#pragma unroll
            for (int m = 0; m < 4; ++m) {
                const int row = u.pm * 256 + ai * 128 + wr * 64 + m * 16 + fr;
                float sq = 0.f;
#pragma unroll
                for (int bj = 0; bj < 2; ++bj)
#pragma unroll
                    for (int n = 0; n < 2; ++n) {
                        const size_t off = (size_t)row * DM + u.pn * 256 + bj * 128 + wc * 32 + n * 16 + fq * 4;
                        const f32x4 b = *(const f32x4*)(base + off);
                        const f32x4 o = b + acc[ai][bj][m][n] * scale;
                        *(f32x4*)(out + off) = o;
                        if (xb) { v2u w; w.x = pk2(o[0], o[1]); w.y = pk2(o[2], o[3]); *(v2u*)(xb + off) = w; }
                        sq += (o[0] * o[0] + o[1] * o[1]) + (o[2] * o[2] + o[3] * o[3]);
                    }
                sq += __shfl_xor(sq, 16); sq += __shfl_xor(sq, 32);
                if (fq == 0) ssp[(size_t)row * 16 + u.pn * 4 + wc] = sq;
            }
    }
};
struct EpiMix {
    static constexpr bool PERM = true;
    const float* ss; unsigned char* ws; const float* qg; const float* kg;
    __device__ __forceinline__ void operator()(const f32x4 (&acc)[2][2][4][2], const pg8::Unit& u, int wr, int wc, int fr, int fq) const {
        const int pn = u.pn;
        bf16* const Y = (bf16*)(ws + WS_Y); bf16* const GVT = (bf16*)(ws + WS_GVT); float* const SSV = (float*)(ws + WS_SSV); bf16* const KCR = (bf16*)(ws + WS_KCR); bf16* const VCR = (bf16*)(ws + WS_VCR);
        bf16* const KS = (bf16*)(ws + WS_KS); bf16* const VST = (bf16*)(ws + WS_VST); bf16* const KW = (bf16*)(ws + WS_KW); bf16* const VWT = (bf16*)(ws + WS_VWT); float* const GATES = (float*)(ws + WS_GATES);
        float gn[2][2][4];
        const float* gsrc = nullptr;
        if (pn == 4 || pn == 5) gsrc = qg; else if (pn == 7 && wc < 2) gsrc = kg + 64; else if (pn == 8 && wc < 2) gsrc = kg + 128;
#pragma unroll
        for (int bj = 0; bj < 2; ++bj)
#pragma unroll
            for (int n = 0; n < 2; ++n)
#pragma unroll
                for (int i = 0; i < 4; ++i) gn[bj][n][i] = gsrc ? gsrc[32 * bj + 8 * fq + 4 * n + i] : 1.f;
#pragma unroll
        for (int ai = 0; ai < 2; ++ai)
#pragma unroll
            for (int m = 0; m < 4; ++m) {
                const int row = u.pm * 256 + ai * 128 + wr * 64 + m * 16 + fr;
                const int b = row >> 12, t = row & 4095;
                const float ri = row_rinv(ss, row, fq);
                float v[2][2][4];
#pragma unroll
                for (int bj = 0; bj < 2; ++bj)
#pragma unroll
                    for (int n = 0; n < 2; ++n)
#pragma unroll
                        for (int i = 0; i < 4; ++i) v[bj][n][i] = acc[ai][bj][m][n][i] * ri;
                if (pn < 4) {
                    float sq = 0.f;
#pragma unroll
                    for (int bj = 0; bj < 2; ++bj)
#pragma unroll
                        for (int n = 0; n < 2; ++n)
#pragma unroll
                            for (int i = 0; i < 4; ++i) { const float x = gelu_tanh(v[bj][n][i]); v[bj][n][i] = x; sq += x * x; }
                    if (pn < 2) {
#pragma unroll
                        for (int bj = 0; bj < 2; ++bj) { v4u w; w.x = pk2(v[bj][0][0], v[bj][0][1]); w.y = pk2(v[bj][0][2], v[bj][0][3]); w.z = pk2(v[bj][1][0], v[bj][1][1]); w.w = pk2(v[bj][1][2], v[bj][1][3]);
                            *(v4u*)(Y + (size_t)row * DM + pn * 256 + wc * 64 + bj * 32 + fq * 8) = w; }
                    } else {
                        const int h = (pn - 2) * 4 + wc;
                        bf16* dst = GVT + ((size_t)(b * 8 + h) * 64) * SEQ + t;
#pragma unroll
                        for (int bj = 0; bj < 2; ++bj)
#pragma unroll
                            for (int n = 0; n < 2; ++n)
#pragma unroll
                                for (int i = 0; i < 4; ++i) dst[(size_t)(32 * bj + 8 * fq + 4 * n + i) * SEQ] = (bf16)f2bf(v[bj][n][i]);
                        sq += __shfl_xor(sq, 16); sq += __shfl_xor(sq, 32);
                        if (fq == 0) SSV[(size_t)row * 8 + (pn - 2) * 4 + wc] = sq;
                    }
                } else if (pn < 9) {
                    const bool is_q = (pn == 4 || pn == 5);
                    const bool is_k = (wc < 2);
                    const bool normed = is_q || ((pn == 7 || pn == 8) && is_k);
                    if (normed) {
                        float sq = 0.f;
#pragma unroll
                        for (int bj = 0; bj < 2; ++bj)
#pragma unroll
                            for (int n = 0; n < 2; ++n)
#pragma unroll
                                for (int i = 0; i < 4; ++i) sq += v[bj][n][i] * v[bj][n][i];
                        sq += __shfl_xor(sq, 16); sq += __shfl_xor(sq, 32);
                        const float rh = rsq_acc(sq, 1.f / 64.f) * (is_q ? 0.125f * 1.4426950408889634f : 1.f);
#pragma unroll
                        for (int bj = 0; bj < 2; ++bj)
#pragma unroll
                            for (int n = 0; n < 2; ++n)
#pragma unroll
                                for (int i = 0; i < 4; ++i) v[bj][n][i] *= rh * gn[bj][n][i];
                    }
                    if (is_q || is_k) {
                        bf16* dst;
                        if (is_q) dst = Y + (size_t)row * DM + 512 + (pn - 4) * 256 + wc * 64;
                        else { bf16* kb = (pn == 6) ? KCR : (pn == 7) ? KS : KW; dst = kb + ((size_t)(b * 2 + wc) * SEQ + t) * 64; }
#pragma unroll
                        for (int bj = 0; bj < 2; ++bj) { v4u w; w.x = pk2(v[bj][0][0], v[bj][0][1]); w.y = pk2(v[bj][0][2], v[bj][0][3]); w.z = pk2(v[bj][1][0], v[bj][1][1]); w.w = pk2(v[bj][1][2], v[bj][1][3]);
                            *(v4u*)(dst + bj * 32 + fq * 8) = w; }
                    } else if (pn == 6) {
                        bf16* dst = VCR + ((size_t)(b * 2 + (wc - 2)) * SEQ + t) * 64;
#pragma unroll
                        for (int bj = 0; bj < 2; ++bj) { v4u w; w.x = pk2(v[bj][0][0], v[bj][0][1]); w.y = pk2(v[bj][0][2], v[bj][0][3]); w.z = pk2(v[bj][1][0], v[bj][1][1]); w.w = pk2(v[bj][1][2], v[bj][1][3]);
                            *(v4u*)(dst + bj * 32 + fq * 8) = w; }
                    } else {
                        bf16* vb = (pn == 7) ? VST : VWT;
                        const int tp = (t & ~12) | ((t & 4) << 1) | ((t & 8) >> 1);
                        bf16* dst = vb + ((size_t)(b * 2 + (wc - 2)) * 64) * SEQ + tp;
#pragma unroll
                        for (int bj = 0; bj < 2; ++bj)
#pragma unroll
                            for (int n = 0; n < 2; ++n)
#pragma unroll
                                for (int i = 0; i < 4; ++i) dst[(size_t)(32 * bj + 8 * fq + 4 * n + i) * SEQ] = (bf16)f2bf(v[bj][n][i]);
                    }
                } else {
                    if (wc == 0 && fq < 3) {
                        f32x4 g0, g1;
#pragma unroll
                        for (int i = 0; i < 4; ++i) { g0[i] = sigmoidf_(v[0][0][i]); g1[i] = sigmoidf_(v[0][1][i]); }
                        *(f32x4*)(GATES + (size_t)row * 24 + fq * 8) = g0; *(f32x4*)(GATES + (size_t)row * 24 + fq * 8 + 4) = g1;
                    }
                }
            }
    }
};
struct EpiCmp {
    static constexpr bool PERM = true;
    const float* cb1p; bf16* H1;
    __device__ __forceinline__ void operator()(const f32x4 (&acc)[2][2][4][2], const pg8::Unit& u, int wr, int wc, int fr, int fq) const {
        float bias[2][2][4];
#pragma unroll
        for (int bj = 0; bj < 2; ++bj)
#pragma unroll
            for (int n = 0; n < 2; ++n)
#pragma unroll
                for (int i = 0; i < 4; ++i) { const int col = u.pn * 256 + bj * 128 + wc * 32 + fq * 8 + n * 4 + i; float s = 0.f;
#pragma unroll
                    for (int p = 0; p < 8; ++p) s += cb1p[p * 512 + col];
                    bias[bj][n][i] = s; }
#pragma unroll
        for (int ai = 0; ai < 2; ++ai)
#pragma unroll
            for (int m = 0; m < 4; ++m) {
                const int row = u.pm * 256 + ai * 128 + wr * 64 + m * 16 + fr;
#pragma unroll
                for (int bj = 0; bj < 2; ++bj) { float o[8];
#pragma unroll
                    for (int n = 0; n < 2; ++n)
#pragma unroll
                        for (int i = 0; i < 4; ++i) o[n * 4 + i] = gelu_tanh(acc[ai][bj][m][n][i] + bias[bj][n][i]);
                    v4u w; w.x = pk2(o[0], o[1]); w.y = pk2(o[2], o[3]); w.z = pk2(o[4], o[5]); w.w = pk2(o[6], o[7]);
                    *(v4u*)(H1 + (size_t)row * 256 + bj * 128 + wc * 32 + fq * 8) = w; }
            }
    }
};

struct Frame {
    LAS unsigned char* lds; volatile LAS unsigned* MISC; gu32* ctl;
    int tid, lane, wave, vcu, G;
};
struct Args { const float* in[24]; float* out; unsigned char* ws; int ph_lo, ph_hi, li, pad; };

__device__ __forceinline__ void p0_tr_item(const float* W, int ldw, int K, const float* gain, bf16* WT, int n0d, int sc0, int nv0, int sc1, int nv1, int kb, LAS float* scr, int lane) {
    const int k0 = 64 * kb, c16 = lane & 15, half = c16 >> 3, cc = (c16 & 7) * 4;
    const int sc = half ? sc1 : sc0, nv = half ? nv1 : nv0;
#pragma unroll 8
    for (int i = 0; i < 16; ++i) { const int kk = 4 * i + (lane >> 4);
        f32x4 x = {0.f, 0.f, 0.f, 0.f};
        if (cc < nv) { x = *(const f32x4*)(W + (size_t)(k0 + kk) * ldw + sc + cc); if (gain) x = x * gain[k0 + kk]; }
        *(LAS f32x4*)(scr + kk * 68 + c16 * 4) = x; }
    LDS_WAIT(); asm volatile("" ::: "memory");
#pragma unroll
    for (int kc = 0; kc < 8; ++kc) { const LAS float* sp = scr + (8 * kc) * 68 + lane;
        v4u o; o.x = pk2(sp[0 * 68], sp[1 * 68]); o.y = pk2(sp[2 * 68], sp[3 * 68]); o.z = pk2(sp[4 * 68], sp[5 * 68]); o.w = pk2(sp[6 * 68], sp[7 * 68]);
        *(GAS v4u*)(WT + (size_t)(n0d + lane) * K + k0 + 8 * kc) = o; }
    LDS_WAIT(); asm volatile("" ::: "memory");
}

__device__ __forceinline__ void p0_prologue(Frame& F, const Args& A) {
    unsigned char* ws = A.ws;
    LAS float* scr = (LAS float*)(F.lds + RING_OFF + F.wave * 17408);
    const int gw = F.vcu * NWAVES + F.wave, NGW = F.G * NWAVES, lane = F.lane;
    constexpr int I_GU = (DM / 64) * (NGU / 64), I_D = (DFF / 64) * (DM / 64), I_IN = (DM / 64) * (NIN / 64), I_OUT = (DM / 64) * (DM / 64), I_C1 = 2 * (2048 / 64) * (256 / 64);
    constexpr int I_WS = 8 * 128 * 128 / 64 / 8;
    constexpr int I_CB = 64, I_C2 = 64;
    constexpr int NITEMS = 2 * I_GU + 2 * I_D + I_IN + I_OUT + I_C1 + I_WS + I_CB + I_C2;
    for (int it = gw; it < NITEMS; it += NGW) {
        int r = it;
        if (r < 2 * I_GU) {
            const int f = r / I_GU; r -= f * I_GU; const int nblk = NGU / 64, kb = r / nblk, nb = r % nblk, n0 = 64 * nb, pn = n0 >> 8, bj = (n0 >> 7) & 1, j = n0 & 127;
            const float* W = f ? (bj ? A.in[21] : A.in[20]) : (bj ? A.in[3] : A.in[2]);
            p0_tr_item(W, DFF, DM, f ? A.in[19] : A.in[1], (bf16*)(ws + (f ? WS_WGU2 : WS_WGU1)), n0, 128 * pn + j, 32, 128 * pn + j + 32, 32, kb, scr, lane); continue; }
        r -= 2 * I_GU;
        if (r < 2 * I_D) {
            const int f = r / I_D; r -= f * I_D; const int nblk = DM / 64, kb = r / nblk, nb = r % nblk;
            p0_tr_item(f ? A.in[22] : A.in[4], DM, DFF, nullptr, (bf16*)(ws + (f ? WS_WD2 : WS_WD1)), 64 * nb, 64 * nb, 32, 64 * nb + 32, 32, kb, scr, lane); continue; }
        r -= 2 * I_D;
        if (r < I_IN) {
            const int nblk = NIN / 64, kb = r / nblk, nb = r % nblk, n0 = 64 * nb, pn = n0 >> 8, tc = n0 & 255;
            const int col0 = 256 * pn + 64 * ((tc >> 5) & 3) + 32 * (tc >> 7), col1 = 256 * pn + 64 * (((tc + 32) >> 5) & 3) + 32 * ((tc + 32) >> 7);
            int nv0 = INC - col0; nv0 = nv0 < 0 ? 0 : (nv0 > 32 ? 32 : nv0); int nv1 = INC - col1; nv1 = nv1 < 0 ? 0 : (nv1 > 32 ? 32 : nv1);
            p0_tr_item(A.in[6], INC, DM, A.in[5], (bf16*)(ws + WS_WIN), n0, col0, nv0, col1, nv1, kb, scr, lane); continue; }
        r -= I_IN;
        if (r < I_OUT) { const int nblk = DM / 64, kb = r / nblk, nb = r % nblk;
            p0_tr_item(A.in[18], DM, DM, nullptr, (bf16*)(ws + WS_WOUT), 64 * nb, 64 * nb, 32, 64 * nb + 32, 32, kb, scr, lane); continue; }
        r -= I_OUT;
        if (r < I_C1) { const int kv = r / (I_C1 / 2); r -= kv * (I_C1 / 2); const int nblk = 256 / 64, kb = r / nblk, nb = r % nblk;
            p0_tr_item(A.in[13] + (size_t)kv * 2048 * 256, 256, 2048, nullptr, (bf16*)(ws + WS_CW1) + (size_t)kv * 256 * 2048, 64 * nb, 64 * nb, 32, 64 * nb + 32, 32, kb, scr, lane); continue; }
        r -= I_C1;
        if (r < I_WS) {
            const int e0 = (r * 64 + lane) * 8; const int s0 = e0 & 127, t = (e0 >> 7) & 127;
            const float* src = A.in[8] + e0; unsigned o[4];
#pragma unroll
            for (int i = 0; i < 4; ++i) { const float a = (s0 + 2 * i <= t) ? src[2 * i] : 0.f, b2 = (s0 + 2 * i + 1 <= t) ? src[2 * i + 1] : 0.f; o[i] = pk2(a, b2); }
            *(v4u*)((bf16*)(ws + WS_WSB) + e0) = (v4u){o[0], o[1], o[2], o[3]}; continue; }
        r -= I_WS;
        if (r >= I_CB) {
            r -= I_CB; const int e0 = (r * 64 + lane) * 8, kv = e0 >> 14, d = (e0 >> 8) & 63, j0 = e0 & 255;
            const float* src = A.in[15] + (size_t)kv * 256 * 64 + d; unsigned o[4];
#pragma unroll
            for (int i = 0; i < 4; ++i) o[i] = pk2(src[(size_t)(j0 + 2 * i) * 64], src[(size_t)(j0 + 2 * i + 1) * 64]);
            *(v4u*)((bf16*)(ws + WS_CW2) + e0) = (v4u){o[0], o[1], o[2], o[3]}; continue; }
        {
            const int kp = r & 7, jb = (r >> 3) & 3, kv = r >> 5, j = jb * 64 + lane;
            const float* pe = A.in[12] + (size_t)kv * 2048; const float* w1 = A.in[13] + (size_t)kv * 2048 * 256;
            float s = (kp == 0) ? A.in[14][kv * 256 + j] : 0.f;
            for (int k = kp * 256; k < kp * 256 + 256; ++k) s += pe[k] * w1[(size_t)k * 256 + j];
            ((float*)(ws + WS_CB1P))[kp * 512 + kv * 256 + j] = s;
        }
    }
    const float* x = A.in[0]; bf16* XB = (bf16*)(ws + WS_XB); float* SS0 = (float*)(ws + WS_SS0);
    for (int m0 = 2 * gw; m0 < MTOK; m0 += 2 * NGW) {
        f32x4 v[2][4];
#pragma unroll
        for (int rr = 0; rr < 2; ++rr) { const GAS f32x4* xr = (const GAS f32x4*)(x + (size_t)(m0 + rr) * DM) + lane;
#pragma unroll
            for (int j = 0; j < 4; ++j) v[rr][j] = xr[64 * j]; }
#pragma unroll
        for (int rr = 0; rr < 2; ++rr) { GAS unsigned long long* o8 = (GAS unsigned long long*)(XB + (size_t)(m0 + rr) * DM) + lane; float sq = 0.f;
#pragma unroll
            for (int j = 0; j < 4; ++j) { const f32x4 t = v[rr][j]; sq += (t.x * t.x + t.y * t.y) + (t.z * t.z + t.w * t.w);
                o8[64 * j] = (unsigned long long)pk2(t.x, t.y) | ((unsigned long long)pk2(t.z, t.w) << 32); }
            sq = wave_sum(sq);
            if (lane < 16) SS0[(size_t)(m0 + rr) * 16 + lane] = (lane == 0) ? sq : 0.f; }
    }
}

__device__ __forceinline__ void gmlp_unit(Frame& F, const Args& A, int unit) {
    typedef short bf16x8 __attribute__((ext_vector_type(8)));
    typedef float f32x16 __attribute__((ext_vector_type(16)));
    unsigned char* ws = A.ws;
    const int b = unit >> 5, c = unit & 31, r0 = b * SEQ + c * 128, lane = F.lane, h = F.wave, r = lane & 31, hh = lane >> 5;
    LAS float* rv = (LAS float*)(F.lds + RING_OFF);
    const float* SSV = (const float*)(ws + WS_SSV);
    if (F.tid < 128) { const f32x4 p0 = *(const f32x4*)(SSV + (size_t)(r0 + F.tid) * 8), p1 = *(const f32x4*)(SSV + (size_t)(r0 + F.tid) * 8 + 4);
        const float sm = ((p0[0] + p0[1]) + (p0[2] + p0[3])) + ((p1[0] + p1[1]) + (p1[2] + p1[3]));
        rv[F.tid] = rsq_acc(sm, 1.f / 512.f); }
    __syncthreads();
    const bf16* GVT = (const bf16*)(ws + WS_GVT) + ((size_t)(b * 8 + h) * 64) * SEQ + c * 128;
    const bf16* WSB = (const bf16*)(ws + WS_WSB) + (size_t)h * 128 * 128;
    bf16* Y = (bf16*)(ws + WS_Y);
    f32x16 acc[4][2];
#pragma unroll
    for (int tt = 0; tt < 4; ++tt)
#pragma unroll
        for (int dt = 0; dt < 2; ++dt)
#pragma unroll
            for (int i = 0; i < 16; ++i) acc[tt][dt][i] = 0.f;
#pragma unroll
    for (int ks = 0; ks < 8; ++ks) {
        const int s0 = 16 * ks + 8 * hh;
        bf16x8 vf[2];
        const f32x4 ra = *(const LAS f32x4*)(rv + s0), rb = *(const LAS f32x4*)(rv + s0 + 4);
#pragma unroll
        for (int dt = 0; dt < 2; ++dt) { const v4u raw = *(const v4u*)(GVT + (size_t)(32 * dt + r) * SEQ + s0);
            v4u o; o.x = pk2(__builtin_bit_cast(float, raw.x << 16) * ra[0], __builtin_bit_cast(float, raw.x & 0xffff0000u) * ra[1]);
            o.y = pk2(__builtin_bit_cast(float, raw.y << 16) * ra[2], __builtin_bit_cast(float, raw.y & 0xffff0000u) * ra[3]);
            o.z = pk2(__builtin_bit_cast(float, raw.z << 16) * rb[0], __builtin_bit_cast(float, raw.z & 0xffff0000u) * rb[1]);
            o.w = pk2(__builtin_bit_cast(float, raw.w << 16) * rb[2], __builtin_bit_cast(float, raw.w & 0xffff0000u) * rb[3]);
            vf[dt] = __builtin_bit_cast(bf16x8, o); }
#pragma unroll
        for (int tt = 0; tt < 4; ++tt) {
            if (16 * ks <= 32 * tt + 31) {
                const bf16x8 wf = *(const bf16x8*)(WSB + (size_t)(32 * tt + r) * 128 + s0);
#pragma unroll
                for (int dt = 0; dt < 2; ++dt) acc[tt][dt] = __builtin_amdgcn_mfma_f32_32x32x16_bf16(vf[dt], wf, acc[tt][dt], 0, 0, 0);
            }
        }
    }
    const float* gvn = A.in[7] + h * 64; const float* bs = A.in[9] + h * 128;
#pragma unroll
    for (int tt = 0; tt < 4; ++tt) {
        const int tl = 32 * tt + r; const float bt = bs[tl];
        bf16* yrow = Y + (size_t)(r0 + tl) * DM + h * 64;
#pragma unroll
        for (int dt = 0; dt < 2; ++dt)
#pragma unroll
            for (int q = 0; q < 4; ++q) { const int d = 32 * dt + 8 * q + 4 * hh;
                const f32x4 gg = *(const f32x4*)(gvn + d); const v2u uu = *(const v2u*)(yrow + d);
                const float o0 = __builtin_bit_cast(float, uu.x << 16) * (acc[tt][dt][4 * q] * gg[0] + bt), o1 = __builtin_bit_cast(float, uu.x & 0xffff0000u) * (acc[tt][dt][4 * q + 1] * gg[1] + bt);
                const float o2 = __builtin_bit_cast(float, uu.y << 16) * (acc[tt][dt][4 * q + 2] * gg[2] + bt), o3 = __builtin_bit_cast(float, uu.y & 0xffff0000u) * (acc[tt][dt][4 * q + 3] * gg[3] + bt);
                v2u wv; wv.x = pk2(o0, o1); wv.y = pk2(o2, o3); *(v2u*)(yrow + d) = wv; }
    }
    __syncthreads();
}
__device__ __forceinline__ void cmp_unit(Frame& F, const Args& A, int unit) {
    typedef short bf16x8 __attribute__((ext_vector_type(8)));
    typedef float f32x16 __attribute__((ext_vector_type(16)));
    unsigned char* ws = A.ws;
    const int lane = F.lane, w = F.wave, r = lane & 31, hh = lane >> 5;
    const int row0 = unit * 32, kv = row0 >> 12;
    const bf16* X = (const bf16*)(ws + WS_KCR) + (size_t)(row0 + r) * 1024 + 8 * hh;
    const bf16* W1 = (const bf16*)(ws + WS_CW1) + ((size_t)kv * 256 + 32 * w + r) * 2048 + 8 * hh;
    f32x16 acc;
#pragma unroll
    for (int i = 0; i < 16; ++i) acc[i] = 0.f;
#pragma unroll 8
    for (int ks = 0; ks < 128; ++ks) { const bf16x8 wf = *(const bf16x8*)(W1 + 16 * ks), xf = *(const bf16x8*)(X + 16 * ks);
        acc = __builtin_amdgcn_mfma_f32_32x32x16_bf16(wf, xf, acc, 0, 0, 0); }
    LAS unsigned char* HL = F.lds + RING_OFF;
    const float* cb1p = (const float*)(ws + WS_CB1P) + kv * 256 + 32 * w;
#pragma unroll
    for (int q = 0; q < 4; ++q) { float o[4];
#pragma unroll
        for (int i = 0; i < 4; ++i) { const int col = 8 * q + 4 * hh + i; float bsum = 0.f;
#pragma unroll
            for (int pz = 0; pz < 8; ++pz) bsum += cb1p[pz * 512 + col];
            o[i] = gelu_tanh(acc[4 * q + i] + bsum); }
        *(LAS v2u*)(HL + r * 528 + (32 * w + 8 * q + 4 * hh) * 2) = (v2u){pk2(o[0], o[1]), pk2(o[2], o[3])}; }
    __syncthreads();
    if (w == 0) {
        const bf16* W2 = (const bf16*)(ws + WS_CW2) + (size_t)kv * 64 * 256;
        f32x16 a2[2];
#pragma unroll
        for (int i = 0; i < 16; ++i) { a2[0][i] = 0.f; a2[1][i] = 0.f; }
#pragma unroll
        for (int ks = 0; ks < 16; ++ks) {
            const bf16x8 hf = *(const LAS bf16x8*)(HL + r * 528 + (16 * ks + 8 * hh) * 2);
#pragma unroll
            for (int dt = 0; dt < 2; ++dt) { const bf16x8 wf = *(const bf16x8*)(W2 + (size_t)(32 * dt + r) * 256 + 16 * ks + 8 * hh);
                a2[dt] = __builtin_amdgcn_mfma_f32_32x32x16_bf16(wf, hf, a2[dt], 0, 0, 0); }
        }
        const float* b2 = A.in[16] + kv * 64; const float* kg0 = A.in[11];
        float sq = 0.f;
#pragma unroll
        for (int dt = 0; dt < 2; ++dt)
#pragma unroll
            for (int i = 0; i < 16; ++i) { const int d = 32 * dt + (i & 3) + 8 * (i >> 2) + 4 * hh; a2[dt][i] += b2[d]; sq += a2[dt][i] * a2[dt][i]; }
        const int row = row0 + r, n = row & 255, bg = (row & 4095) >> 8;
        if (kv == 0) {
            sq += __shfl_xor(sq, 32); const float rn = rsq_acc(sq, 1.f / 64.f);
            bf16* dst = (bf16*)(ws + WS_KCMP) + ((size_t)bg * 256 + n) * 64;
#pragma unroll
            for (int dt = 0; dt < 2; ++dt)
#pragma unroll
                for (int q = 0; q < 4; ++q) { const int d = 32 * dt + 8 * q + 4 * hh; const f32x4 gg = *(const f32x4*)(kg0 + d);
                    v2u wv; wv.x = pk2(a2[dt][4 * q] * rn * gg[0], a2[dt][4 * q + 1] * rn * gg[1]); wv.y = pk2(a2[dt][4 * q + 2] * rn * gg[2], a2[dt][4 * q + 3] * rn * gg[3]);
                    *(v2u*)(dst + d) = wv; }
        } else {
            const int np = (n & ~12) | ((n & 4) << 1) | ((n & 8) >> 1);
            bf16* dst = (bf16*)(ws + WS_VCMPT) + (size_t)bg * 64 * 256 + np;
#pragma unroll
            for (int dt = 0; dt < 2; ++dt)
#pragma unroll
                for (int i = 0; i < 16; ++i) { const int d = 32 * dt + (i & 3) + 8 * (i >> 2) + 4 * hh; dst[(size_t)d * 256] = (bf16)f2bf(a2[dt][i]); }
        }
    }
    __syncthreads();
}

#define TSTAMP() __builtin_amdgcn_s_memrealtime()
namespace att {
typedef short bf16x8 __attribute__((ext_vector_type(8)));
typedef short s16x4 __attribute__((ext_vector_type(4)));
typedef float f32x16 __attribute__((ext_vector_type(16)));
typedef float f32x2_t __attribute__((ext_vector_type(2))); typedef __bf16 bf16x2_t __attribute__((ext_vector_type(2)));
constexpr int TILEB = 8192, NSLOT = 6;
constexpr int OFF_KV = 0, OFF_IMP = NSLOT * 2 * TILEB, OFF_MSK = OFF_IMP + 8 * 2048, ATT_LDS = OFF_MSK + 512;
constexpr float NEGBIG = -30000.f;
__device__ __forceinline__ unsigned cvtpk(float lo, float hi) { f32x2_t v = {lo, hi}; bf16x2_t b = __builtin_convertvector(v, bf16x2_t); return __builtin_bit_cast(unsigned, b); }
__device__ __forceinline__ int crow(int r, int hi) { return (r & 3) + 8 * (r >> 2) + 4 * hi; }
__device__ __forceinline__ float xhalf(float x) { return __shfl_xor(x, 32); }
constexpr int TR_D0 = 575, TR_N = 640, OFF_TR = 115712;
enum { FAR = 0, NEARS = 1, NEARW = 2, NEARC = 3 };
#define SBAR() __builtin_amdgcn_sched_barrier(0)
template <int MODE, bool CMP, bool MASKED>
__device__ __forceinline__ void tile(const LAS unsigned char* Kb, const LAS unsigned char* Vb, const bf16x8 (&qf)[4], bool rowsel, const LAS float* trh, int kidx0,
                                     f32x16 (&O)[2], float& l, float (&u)[2][4], float& carry, int r, int hh) {
    constexpr int ES = CMP ? 16 : 1;
    const LAS float* trb = trh + kidx0;
    f32x16 S[2];
    bf16x8 pf[2][2], kf[2][4], vf[4];
    float ls = 0.f;
    const unsigned pmask = rowsel ? 0xffffffffu : 0u;
#define ATT_B(a, i) do { float s_ = S[a][i]; const int e_ = ES * (32 * (a) + ((i) & 3) + 8 * ((i) >> 2)); \
        if (MODE == NEARS || MODE == NEARW) s_ += trb[e_]; \
        if (MODE == NEARC) { int k_ = kidx0 + e_; k_ = k_ < 0 ? 0 : (k_ < TR_N - 1 ? k_ : TR_N - 1); s_ += trh[k_]; } \
        float p_ = __builtin_amdgcn_exp2f(s_); \
        if (MODE == NEARW) p_ = (kidx0 + e_ >= TR_D0 - 511) ? p_ : 0.f; \
        S[a][i] = p_; ls += p_; } while (0)
#define ATT_B4(a, i0) do { ATT_B(a, (i0)); ATT_B(a, (i0) + 1); ATT_B(a, (i0) + 2); ATT_B(a, (i0) + 3); } while (0)
#define ATT_PACK(a) do { _Pragma("unroll") for (int s2 = 0; s2 < 2; ++s2) { v4u w_ = {cvtpk(S[a][8 * s2 + 0], S[a][8 * s2 + 1]), cvtpk(S[a][8 * s2 + 2], S[a][8 * s2 + 3]), cvtpk(S[a][8 * s2 + 4], S[a][8 * s2 + 5]), cvtpk(S[a][8 * s2 + 6], S[a][8 * s2 + 7])}; \
        if (MASKED) { w_.x &= pmask; w_.y &= pmask; w_.z &= pmask; w_.w &= pmask; } \
        pf[a][s2] = __builtin_bit_cast(bf16x8, w_); } } while (0)
#define ATT_U(a) do { if (CMP) { float rq_[4]; _Pragma("unroll") for (int q = 0; q < 4; ++q) rq_[q] = xhalf(S[a][4 * q + 3]); \
        _Pragma("unroll") for (int q = 0; q < 4; ++q) { const float own_ = (S[a][4 * q] + S[a][4 * q + 1]) + (S[a][4 * q + 2] + S[a][4 * q + 3]); \
            const float prev_ = hh ? rq_[q] : (q > 0 ? rq_[q - 1] : carry); u[a][q] = own_ + prev_; } carry = rq_[3]; } } while (0)
#define ATT_VRD(m, a) vf[m] = *(const LAS bf16x8*)(Vb + (32 * ((m) & 1) + r) * 128 + (((4 * (a) + 2 * ((m) >> 1) + hh) ^ (r & 7)) * 16))
    const f32x16 zero = {0.f, 0.f, 0.f, 0.f, 0.f, 0.f, 0.f, 0.f, 0.f, 0.f, 0.f, 0.f, 0.f, 0.f, 0.f, 0.f};
#pragma unroll
    for (int kk = 0; kk < 4; ++kk) kf[0][kk] = *(const LAS bf16x8*)(Kb + r * 128 + (((2 * kk + hh) ^ (r & 7)) * 16));
    SBAR();
#define ATT_KRD(kk) kf[1][kk] = *(const LAS bf16x8*)(Kb + (32 + r) * 128 + (((2 * (kk) + hh) ^ (r & 7)) * 16))
    S[0] = __builtin_amdgcn_mfma_f32_32x32x16_bf16(kf[0][0], qf[0], zero, 0, 0, 0); ATT_KRD(0); SBAR();
    S[0] = __builtin_amdgcn_mfma_f32_32x32x16_bf16(kf[0][1], qf[1], S[0], 0, 0, 0); ATT_KRD(1); SBAR();
    S[0] = __builtin_amdgcn_mfma_f32_32x32x16_bf16(kf[0][2], qf[2], S[0], 0, 0, 0); ATT_KRD(2); SBAR();
    S[0] = __builtin_amdgcn_mfma_f32_32x32x16_bf16(kf[0][3], qf[3], S[0], 0, 0, 0); ATT_KRD(3); SBAR();
#undef ATT_KRD
    S[1] = __builtin_amdgcn_mfma_f32_32x32x16_bf16(kf[1][0], qf[0], zero, 0, 0, 0); ATT_VRD(0, 0); ATT_B4(0, 0); SBAR();
    S[1] = __builtin_amdgcn_mfma_f32_32x32x16_bf16(kf[1][1], qf[1], S[1], 0, 0, 0); ATT_VRD(1, 0); ATT_B4(0, 4); SBAR();
    S[1] = __builtin_amdgcn_mfma_f32_32x32x16_bf16(kf[1][2], qf[2], S[1], 0, 0, 0); ATT_VRD(2, 0); ATT_B4(0, 8); SBAR();
    S[1] = __builtin_amdgcn_mfma_f32_32x32x16_bf16(kf[1][3], qf[3], S[1], 0, 0, 0); ATT_VRD(3, 0); ATT_B4(0, 12); SBAR();
    ATT_U(0); ATT_PACK(0); SBAR();
    O[0] = __builtin_amdgcn_mfma_f32_32x32x16_bf16(vf[0], pf[0][0], O[0], 0, 0, 0); ATT_VRD(0, 1); ATT_B4(1, 0); SBAR();
    O[1] = __builtin_amdgcn_mfma_f32_32x32x16_bf16(vf[1], pf[0][0], O[1], 0, 0, 0); ATT_VRD(1, 1); ATT_B4(1, 4); SBAR();
    O[0] = __builtin_amdgcn_mfma_f32_32x32x16_bf16(vf[2], pf[0][1], O[0], 0, 0, 0); ATT_VRD(2, 1); ATT_B4(1, 8); SBAR();
    O[1] = __builtin_amdgcn_mfma_f32_32x32x16_bf16(vf[3], pf[0][1], O[1], 0, 0, 0); ATT_VRD(3, 1); ATT_B4(1, 12); SBAR();
    ATT_U(1); ATT_PACK(1); SBAR();
    O[0] = __builtin_amdgcn_mfma_f32_32x32x16_bf16(vf[0], pf[1][0], O[0], 0, 0, 0);
    O[1] = __builtin_amdgcn_mfma_f32_32x32x16_bf16(vf[1], pf[1][0], O[1], 0, 0, 0);
    O[0] = __builtin_amdgcn_mfma_f32_32x32x16_bf16(vf[2], pf[1][1], O[0], 0, 0, 0);
    O[1] = __builtin_amdgcn_mfma_f32_32x32x16_bf16(vf[3], pf[1][1], O[1], 0, 0, 0);
    l += (MASKED && !rowsel) ? 0.f : ls;
#undef ATT_B
#undef ATT_B4
#undef ATT_PACK
#undef ATT_U
#undef ATT_VRD
}
#undef SBAR
}

__device__ __forceinline__ void attn_unit(Frame& F, const Args& A, int bg, int c, size_t ydst_off, unsigned long long& tacc) {
    using namespace att;
    unsigned char* ws = A.ws;
    int tid = F.tid; asm volatile("" : "+v"(tid));
    const int lane = tid & 63, w = F.wave, r = lane & 31, hh = lane >> 5, hg = r >> 3, qi = r & 7;
    const int b = bg >> 1, g = bg & 1, h = g * 4 + hg;
    const int t = 64 * c + 8 * w + qi; const size_t tok = (size_t)b * SEQ + t;
    LAS unsigned char* L = F.lds + RING_OFF;
    const LAS float* tblh = (const LAS float*)(F.lds + TBL_OFF) + h * 132;
    const LAS float* trh = (const LAS float*)(L + OFF_TR) + h * TR_N;
    bf16* Y = (bf16*)(ws + WS_Y);
    bf16* yrow = Y + tok * DM + 512 + h * 64;
    if (DBG_T == 60) tacc -= TSTAMP();
    bf16x8 qf[4];
#pragma unroll
    for (int kk = 0; kk < 4; ++kk) qf[kk] = *(const bf16x8*)(yrow + 16 * kk + 8 * hh);
    const int nc = (c >> 4) + 1, ns = c + 1, w0 = c > 8 ? c - 8 : 0, nw = c - w0 + 1, ntile = nc + ns + nw;
    const int srow = tid >> 3, sch = (tid & 7) ^ (srow & 7);
    const unsigned ldsw = (unsigned)w * 1024u;
#define ATT_DMA(i) do { const int i_ = (i); const bf16* kp_; const bf16* vp_; size_t ldv_; \
        if (i_ < nc) { kp_ = (const bf16*)(ws + WS_KCMP) + ((size_t)bg * 256 + 64 * i_) * 64; vp_ = (const bf16*)(ws + WS_VCMPT) + (size_t)bg * 64 * 256 + 64 * i_; ldv_ = 256; } \
        else if (i_ < nc + ns) { const int j_ = i_ - nc; kp_ = (const bf16*)(ws + WS_KS) + ((size_t)bg * SEQ + 64 * j_) * 64; vp_ = (const bf16*)(ws + WS_VST) + (size_t)bg * 64 * SEQ + 64 * j_; ldv_ = SEQ; } \
        else { const int j_ = w0 + i_ - nc - ns; kp_ = (const bf16*)(ws + WS_KW) + ((size_t)bg * SEQ + 64 * j_) * 64; vp_ = (const bf16*)(ws + WS_VWT) + (size_t)bg * 64 * SEQ + 64 * j_; ldv_ = SEQ; } \
        const int sl_ = ((i_ >> 1) % 3) * 2 + (i_ & 1); \
        __builtin_amdgcn_global_load_lds((const unsigned*)(kp_ + srow * 64 + sch * 8), (LAS unsigned*)(L + OFF_KV + sl_ * 2 * TILEB + ldsw), 16, 0, 0); \
        __builtin_amdgcn_global_load_lds((const unsigned*)(vp_ + (size_t)srow * ldv_ + sch * 8), (LAS unsigned*)(L + OFF_KV + sl_ * 2 * TILEB + TILEB + ldsw), 16, 0, 0); } while (0)
#define ATT_WAITN(n) do { const int n_ = (n); if (n_ >= 2) asm volatile("s_waitcnt vmcnt(4) lgkmcnt(0)" ::: "memory"); else if (n_ == 1) asm volatile("s_waitcnt vmcnt(2) lgkmcnt(0)" ::: "memory"); \
        else asm volatile("s_waitcnt vmcnt(0) lgkmcnt(0)" ::: "memory"); } while (0)
#define ATT_NEXT(i) do { if (((i) & 1) == 0) { if ((i) + 4 < ntile) ATT_DMA((i) + 4); if ((i) + 5 < ntile) ATT_DMA((i) + 5); } if (DBG_T == 1) tacc -= TSTAMP(); } while (0)
#define ATT_FLIP(i) do { if (DBG_T == 1) tacc += TSTAMP(); if ((((i) & 1) == 1) || (i) + 1 == ntile) { if (DBG_T == 2) tacc -= TSTAMP(); \
        const int s2_ = ((i) | 1) + 3; ATT_WAITN(s2_ + 1 < ntile ? 2 : (s2_ < ntile ? 1 : 0)); \
        __builtin_amdgcn_s_barrier(); asm volatile("" ::: "memory"); if (DBG_T == 2) tacc += TSTAMP(); } } while (0)
    ATT_DMA(0); if (ntile > 1) ATT_DMA(1); if (ntile > 2) ATT_DMA(2); if (ntile > 3) ATT_DMA(3);
    ATT_WAITN(ntile > 3 ? 2 : (ntile > 2 ? 1 : 0));
    __builtin_amdgcn_s_barrier(); asm volatile("" ::: "memory");
    asm volatile("" : "+v"(qf[0]), "+v"(qf[1]), "+v"(qf[2]), "+v"(qf[3]));
    if (DBG_T == 60) tacc += TSTAMP();
    f32x16 out[2], O[2];
#pragma unroll
    for (int i = 0; i < 16; ++i) { out[0][i] = 0.f; out[1][i] = 0.f; O[0][i] = 0.f; O[1][i] = 0.f; }
    float l = 0.f, carry = 0.f, dummy_u[2][4];
    int it = 0;
    float u[4][2][4];
#pragma unroll
    for (int i = 0; i < 4; ++i)
#pragma unroll
        for (int a = 0; a < 2; ++a)
#pragma unroll
            for (int q = 0; q < 4; ++q) u[i][a][q] = 0.f;
#pragma unroll
    for (int i = 0; i < 4; ++i) {
        if (i < nc) {
            ATT_NEXT(it);
            const LAS unsigned char* Kb = L + OFF_KV + (((it >> 1) % 3) * 2 + (it & 1)) * 2 * TILEB; const LAS unsigned char* Vb = Kb + TILEB;
            const bool far = 64 * c >= 1024 * i + 1167;
            if (far) tile<FAR, true, false>(Kb, Vb, qf, true, trh, 0, O, l, u[i], carry, r, hh);
            else tile<NEARC, true, false>(Kb, Vb, qf, true, trh, TR_D0 - t + 31 + 16 * (64 * i + 4 * hh), O, l, u[i], carry, r, hh);
            ATT_FLIP(it); ++it;
        }
    }
    unsigned long long mask;
    if (DBG_T == 61) tacc -= TSTAMP();
    {
        const float g0 = ((const float*)(ws + WS_GATES))[tok * 24 + h]; const float lt = l + xhalf(l); const float linv = lt > 0.f ? 1.f / lt : 0.f; const float sc = g0 * linv;
#pragma unroll
        for (int i = 0; i < 16; ++i) { out[0][i] += sc * O[0][i]; out[1][i] += sc * O[1][i]; O[0][i] = 0.f; O[1][i] = 0.f; }
        LAS float* impw = (LAS float*)(L + OFF_IMP + w * 2048);
#pragma unroll
        for (int i = 0; i < 4; ++i)
#pragma unroll
            for (int a = 0; a < 2; ++a)
#pragma unroll
                for (int q = 0; q < 4; ++q) {
                    float x = u[i][a][q] * linv;
                    x += __builtin_bit_cast(float, __builtin_amdgcn_update_dpp(0, __builtin_bit_cast(int, x), 0x128, 0xf, 0xf, false));
                    { const unsigned xb = __builtin_bit_cast(unsigned, x); auto pr = __builtin_amdgcn_permlane16_swap(xb, xb, false, false);
                      const unsigned p0 = pr[0], p1 = pr[1];
                      x = __builtin_bit_cast(float, p0) + __builtin_bit_cast(float, p1); }
                    const int j = 8 * (2 * i + a) + 2 * q + hh;
                    const bool forced = (j == 0) || (j == c) || (j == c - 1);
                    x = (j <= c) ? (forced ? 1e6f : x) : -1.f;
                    const unsigned bits = (__builtin_bit_cast(unsigned, x) & ~63u) | (unsigned)(63 - j);
                    impw[qi * 64 + j] = __builtin_bit_cast(float, bits);
                }
        LDS_WAIT(); asm volatile("" ::: "memory");
        const int q2 = lane >> 3, part = lane & 7;
        const LAS float* iq = impw + q2 * 64;
        float mine[8]; int cnt[8];
        { const f32x4 m0 = *(const LAS f32x4*)(iq + 8 * part), m1 = *(const LAS f32x4*)(iq + 8 * part + 4);
#pragma unroll
          for (int i = 0; i < 4; ++i) { mine[i] = m0[i]; mine[4 + i] = m1[i]; cnt[i] = 0; cnt[4 + i] = 0; } }
        unsigned byte = 0xffu;
        if (c >= 16) {
#pragma unroll 1
            for (int k = 0; 4 * k <= c; ++k) { const f32x4 v = *(const LAS f32x4*)(iq + 4 * k);
#pragma unroll
                for (int e = 0; e < 4; ++e)
#pragma unroll
                    for (int i = 0; i < 8; ++i) cnt[i] += (v[e] > mine[i]) ? 1 : 0; }
            byte = 0;
#pragma unroll
            for (int i = 0; i < 8; ++i) byte |= (cnt[i] < 16) ? (1u << i) : 0u;
        }
        LAS unsigned char* mw = (LAS unsigned char*)(L + OFF_MSK + w * 64);
        mw[q2 * 8 + part] = (unsigned char)byte;
        LDS_WAIT(); asm volatile("" ::: "memory");
        mask = *(const LAS unsigned long long*)(mw + qi * 8);
        l = 0.f;
    }
    if (DBG_T == 61) tacc += TSTAMP();
    unsigned long long uni = 0;
#pragma unroll
    for (int q = 0; q < 8; ++q) { uni |= (unsigned long long)(unsigned)__builtin_amdgcn_readlane((int)(unsigned)mask, q) | ((unsigned long long)(unsigned)__builtin_amdgcn_readlane((int)(unsigned)(mask >> 32), q) << 32); }
#pragma unroll 1
    for (int j = 0; j <= c; ++j) {
        ATT_NEXT(it);
        if ((uni >> j) & 1ull) {
            const LAS unsigned char* Kb = L + OFF_KV + (((it >> 1) % 3) * 2 + (it & 1)) * 2 * TILEB; const LAS unsigned char* Vb = Kb + TILEB;
            const bool rs = (mask >> j) & 1ull;
            if (j <= c - 3) tile<FAR, false, true>(Kb, Vb, qf, rs, trh, 0, O, l, dummy_u, carry, r, hh);
            else tile<NEARS, false, true>(Kb, Vb, qf, rs, trh, TR_D0 - t + 64 * j + 4 * hh, O, l, dummy_u, carry, r, hh);
        }
        ATT_FLIP(it); ++it;
    }
    {
        const float g1 = ((const float*)(ws + WS_GATES))[tok * 24 + 8 + h]; const float lt = l + xhalf(l); const float sc = lt > 0.f ? g1 / lt : 0.f;
#pragma unroll
        for (int i = 0; i < 16; ++i) { out[0][i] += sc * O[0][i]; out[1][i] += sc * O[1][i]; O[0][i] = 0.f; O[1][i] = 0.f; }
        l = 0.f;
    }
#pragma unroll 1
    for (int j = w0; j <= c; ++j) {
        ATT_NEXT(it);
        const LAS unsigned char* Kb = L + OFF_KV + (((it >> 1) % 3) * 2 + (it & 1)) * 2 * TILEB; const LAS unsigned char* Vb = Kb + TILEB;
        if (j <= c - 3 && j != c - 8) tile<FAR, false, false>(Kb, Vb, qf, true, trh, 0, O, l, dummy_u, carry, r, hh);
        else if (j == c - 8) tile<NEARW, false, false>(Kb, Vb, qf, true, trh, TR_D0 - t + 64 * j + 4 * hh, O, l, dummy_u, carry, r, hh);
        else tile<NEARS, false, false>(Kb, Vb, qf, true, trh, TR_D0 - t + 64 * j + 4 * hh, O, l, dummy_u, carry, r, hh);
        ATT_FLIP(it); ++it;
    }
    if (DBG_T == 50 || DBG_T == 51) {
        f32x16 Ox[2] = {O[0], O[1]}; float lx = 0.f;
        if (DBG_T == 50 || w < 4) {
            tacc -= TSTAMP();
#pragma unroll 1
            for (int rep = 0; rep < 128; ++rep) tile<FAR, false, true>(L + OFF_KV, L + OFF_KV + TILEB, qf, (mask >> (rep & 63)) & 1ull, trh, 0, Ox, lx, dummy_u, carry, r, hh);
            tacc += TSTAMP();
        }
        asm volatile("" :: "v"(Ox[0]), "v"(Ox[1]), "v"(lx));
    }
    {
        const float g2 = ((const float*)(ws + WS_GATES))[tok * 24 + 16 + h]; const float lt = l + xhalf(l); const float sc = lt > 0.f ? g2 / lt : 0.f;
#pragma unroll
        for (int i = 0; i < 16; ++i) { out[0][i] += sc * O[0][i]; out[1][i] += sc * O[1][i]; }
    }
    if (DBG_T == 62) tacc -= TSTAMP();
    bf16* yout = (bf16*)(ws + WS_Y) + tok * DM + 512 + h * 64;
#pragma unroll
    for (int dt = 0; dt < 2; ++dt)
#pragma unroll
        for (int q = 0; q < 4; ++q) { v2u wv; wv.x = cvtpk(out[dt][4 * q], out[dt][4 * q + 1]); wv.y = cvtpk(out[dt][4 * q + 2], out[dt][4 * q + 3]);
            *(v2u*)((bf16*)((unsigned char*)yout + ydst_off) + 32 * dt + 8 * q + 4 * hh) = wv; }
    __syncthreads();
    if (DBG_T == 62) tacc += TSTAMP();
#undef ATT_DMA
#undef ATT_WAITN
#undef ATT_NEXT
#undef ATT_FLIP
}

__global__ void __launch_bounds__(NWAVES * 64, 2) mk_fwd(Args args) {
    extern __shared__ __attribute__((aligned(16))) unsigned char lds[];
    Frame F;
    F.lds = (LAS unsigned char*)lds;
    F.MISC = (volatile LAS unsigned*)(F.lds + MISC_OFF);
    F.tid = threadIdx.x; F.lane = F.tid & 63; F.wave = __builtin_amdgcn_readfirstlane(F.tid >> 6);
    F.G = gridDim.x; { const int bx = blockIdx.x; F.vcu = (F.G % 8 == 0) ? (bx % 8) * (F.G / 8) + bx / 8 : bx; }
    unsigned char* ws = args.ws;
    F.ctl = (gu32*)(ws + WS_CTL);
    for (int u = F.tid; u < (LDS_BYTES - LDSCTL_OFF) / 4; u += NWAVES * 64) ((LAS unsigned*)(F.lds + LDSCTL_OFF))[u] = 0u;
    __syncthreads();
    if (F.tid < 128) { const int n = F.tid; int bkt = n;
        if (n >= 16) { const float nf = (float)n; int large = 16 + (int)(logf(nf / 16.f) / logf(8.f) * 16.f); bkt = large < 31 ? large : 31; }
        ((LAS unsigned char*)(F.lds + TB_OFF))[n] = (unsigned char)bkt; }
    __syncthreads();
    for (int e = F.tid; e < 8 * 129; e += NWAVES * 64) { const int hh_ = e / 129, x = e % 129; const int bk = x < 128 ? ((LAS unsigned char*)(F.lds + TB_OFF))[x] : 31;
        ((LAS float*)(F.lds + TBL_OFF))[hh_ * 132 + x] = args.in[17][hh_ * 32 + bk] * 1.4426950408889634f; }
    __syncthreads();
    XcdBarrier bar; bar.bar = (unsigned*)(F.ctl + CW_BAR) + args.li * XCD_BAR_WORDS; bar.x = 0; bar.st = nullptr;
    if (N_LAUNCHES != PER_PHASE) bar = xcd_barrier_post((unsigned*)(F.ctl + CW_BAR) + args.li * XCD_BAR_WORDS, F.MISC + 8);
#define GRID_BAR() do { if (N_LAUNCHES != PER_PHASE) xcd_barrier(bar); } while (0)
    const int lo = args.ph_lo, hi = args.ph_hi;
#define IN(k) (lo <= (k) && (k) < hi)
#define BOTH(k) (IN(k) && IN((k) + 1))
    bf16* XB = (bf16*)(ws + WS_XB); bf16* ACT = (bf16*)(ws + WS_ACT); bf16* Y = (bf16*)(ws + WS_Y);
    float* SS0 = (float*)(ws + WS_SS0); float* SS1 = (float*)(ws + WS_SS1); float* SS2 = (float*)(ws + WS_SS2); float* SS3 = (float*)(ws + WS_SS3);

    unsigned long long tacc = 0;
#define PT0(k) do { if (DBG_T == 10 + (k)) tacc -= TSTAMP(); if (DBG_T == 30 + (k)) tacc += TSTAMP(); } while (0)
#define PT1(k) do { if (DBG_T == 10 + (k)) tacc += TSTAMP(); if (DBG_T == 31 + (k)) tacc -= TSTAMP(); } while (0)
    if (IN(0)) { PT0(0); NREP(0) p0_prologue(F, args); PT1(0); if (BOTH(0)) GRID_BAR(); }
    if (IN(1)) {
        PT0(1);
        pg8::Gemm g{XB, (const bf16*)(ws + WS_WGU1), MTOK, NGU, DM, DM, DM}; pg8::StaticOrder S; S.init(MTOK, NGU, F.G, (int)blockIdx.x);
        EpiSwiGLU E{SS0, ACT};
        NREP(1) pg8::gemm_phase<EpiSwiGLU, pg8::StaticOrder, true, true>(F.lds + RING_OFF, g, S, E);
        PT1(1);
        if (BOTH(1)) GRID_BAR();
    }
    if (IN(2)) {
        PT0(2);
        pg8::Gemm g{ACT, (const bf16*)(ws + WS_WD1), MTOK, DM, DFF, DFF, DFF}; pg8::StaticOrder S; S.init(MTOK, DM, F.G, (int)blockIdx.x);
        EpiResid E{args.in[0], args.out, XB, SS1, 0.5f};
        NREP(2) pg8::gemm_phase<EpiResid, pg8::StaticOrder, true, true>(F.lds + RING_OFF, g, S, E);
        PT1(2);
        if (BOTH(2)) GRID_BAR();
    }
    if (IN(3)) {
        PT0(3);
        pg8::Gemm g{XB, (const bf16*)(ws + WS_WIN), MTOK, NIN, DM, DM, DM}; pg8::StaticOrder S; S.init(MTOK, NIN, F.G, (int)blockIdx.x);
        EpiMix E{SS1, ws, args.in[10], args.in[11]};
        NREP(3) pg8::gemm_phase<EpiMix, pg8::StaticOrder, true, true>(F.lds + RING_OFF, g, S, E);
        PT1(3);
        if (BOTH(3)) GRID_BAR();
    }
    if (IN(4)) {
        PT0(4);
        for (int u = F.vcu; u < 256; u += F.G) cmp_unit(F, args, u);
        for (int u = F.vcu; u < 256; u += F.G) gmlp_unit(F, args, u);
        PT1(4);
        if (BOTH(4)) GRID_BAR();
    }
    if (IN(5)) {
        PT0(5);
        if (DBG_T == 3) tacc -= TSTAMP();
        if (DBG_T == 63) tacc -= TSTAMP();
        {
            LAS float* TR = (LAS float*)(F.lds + RING_OFF + att::OFF_TR); const LAS float* tbl = (const LAS float*)(F.lds + TBL_OFF);
            for (int e = F.tid; e < 8 * att::TR_N; e += NWAVES * 64) { const int hh_ = e / att::TR_N, k = e % att::TR_N, dist = att::TR_D0 - k;
                TR[e] = dist < 0 ? att::NEGBIG : tbl[hh_ * 132 + (dist < 128 ? dist : 128)] - tbl[hh_ * 132 + 128]; }
            __syncthreads();
        }
        if (DBG_T == 63) tacc += TSTAMP();
#if DBG_REP == 5
#pragma unroll 1
        for (int n = F.vcu; n < NBG * 64; n += F.G) { const int v = n & 255, i = n >> 8, x = v >> 5, lv = v & 31; attn_unit(F, args, 2 * x + (i & 1), i < 2 ? 63 - lv : lv, (size_t)(300 - 120) * MiB, tacc); }
#endif
        if (F.G % 8 == 0) {
            const int x = (int)blockIdx.x & 7; gu32* head = F.ctl + CW_Q + 64 * x;
#pragma unroll 1
            for (;;) {
                if (F.tid == 0) F.MISC[0] = __hip_atomic_fetch_add(head, 1u, RLX_AGENT);
                __syncthreads(); const int u = (int)F.MISC[0]; __syncthreads();
                if (u >= 128) break;
                attn_unit(F, args, 2 * x + (u & 1), 63 - (u >> 1), (size_t)0, tacc);
            }
        } else {
#pragma unroll 1
            for (int n = (int)blockIdx.x; n < NBG * 64; n += F.G) attn_unit(F, args, n & 15, 63 - (n >> 4), (size_t)0, tacc);
        }
        if (DBG_T == 3) tacc += TSTAMP();
        PT1(5);
        if (BOTH(5)) GRID_BAR();
    }
    if (IN(6)) {
        PT0(6);
        pg8::Gemm g{Y, (const bf16*)(ws + WS_WOUT), MTOK, DM, DM, DM, DM}; pg8::StaticOrder S; S.init(MTOK, DM, F.G, (int)blockIdx.x);
        EpiResid E{args.out, args.out, XB, SS2, 1.0f};
        pg8::gemm_phase<EpiResid, pg8::StaticOrder, true, true>(F.lds + RING_OFF, g, S, E);
        PT1(6);
        if (BOTH(6)) GRID_BAR();
    }
    if (IN(7)) {
        PT0(7);
        pg8::Gemm g{XB, (const bf16*)(ws + WS_WGU2), MTOK, NGU, DM, DM, DM}; pg8::StaticOrder S; S.init(MTOK, NGU, F.G, (int)blockIdx.x);
        EpiSwiGLU E{SS2, ACT};
        pg8::gemm_phase<EpiSwiGLU, pg8::StaticOrder, true, true>(F.lds + RING_OFF, g, S, E);
        PT1(7);
        if (BOTH(7)) GRID_BAR();
    }
    if (IN(8)) {
        PT0(8);
        pg8::Gemm g{ACT, (const bf16*)(ws + WS_WD2), MTOK, DM, DFF, DFF, DFF}; pg8::StaticOrder S; S.init(MTOK, DM, F.G, (int)blockIdx.x);
        EpiResid E{args.out, args.out, nullptr, SS3, 0.5f};
        pg8::gemm_phase<EpiResid, pg8::StaticOrder, true, true>(F.lds + RING_OFF, g, S, E);
        PT1(8);
        if (BOTH(8)) GRID_BAR();
    }
    if (IN(9)) {
        PT0(9);
        const int gw = F.vcu * NWAVES + F.wave, NGW = F.G * NWAVES; const float* gf = args.in[23];
        for (int m = gw; m < MTOK; m += NGW) {
            float s = (F.lane < 16) ? SS3[(size_t)m * 16 + F.lane] : 0.f; s = wave_sum(s);
            const float ri = rsq_acc(s, 1.f / DM);
            GAS f32x4* xr = (GAS f32x4*)(args.out + (size_t)m * DM) + F.lane;
#pragma unroll
            for (int j = 0; j < 4; ++j) { f32x4 v = xr[64 * j]; const f32x4 gg = *((const f32x4*)gf + F.lane + 64 * j); v = v * ri * gg; xr[64 * j] = v; }
        }
        PT1(9);
    }
    if (DBG_T != 0) { __syncthreads(); if (F.lane == 0) { F.MISC[16 + 2 * F.wave] = (unsigned)tacc; F.MISC[17 + 2 * F.wave] = (unsigned)(tacc >> 32); } __syncthreads();
        if (blockIdx.x == 0 && F.tid == 0) { const unsigned long long tw = (unsigned long long)F.MISC[16 + 2 * (DBG_TW)] | ((unsigned long long)F.MISC[17 + 2 * (DBG_TW)] << 32);
            const unsigned long long t0 = TSTAMP(); while (TSTAMP() - t0 < 16ull * tw) __builtin_amdgcn_s_sleep(8); } }
#undef IN
#undef BOTH
#undef GRID_BAR
}

extern "C" void kernel_launch(void* const* d_in, const int* in_sizes, int n_in, void* d_out, int out_size, void* d_ws, size_t ws_size, hipStream_t stream) {
    static int grid = 0;
    if (grid == 0) {
        if (n_in != 24 || in_sizes[0] != MTOK * DM || out_size != MTOK * DM || ws_size < WS_END) { fprintf(stderr, "kernel_launch: unexpected shapes (n_in %d, in0 %d, out %d, ws %zu)\n", n_in, n_in > 0 ? in_sizes[0] : -1, out_size, ws_size); grid = -1; return; }
        int dev = 0, cus = 0, per_cu = 0;
        if (hipGetDevice(&dev) != hipSuccess || hipDeviceGetAttribute(&cus, hipDeviceAttributeMultiprocessorCount, dev) != hipSuccess) { grid = -1; return; }
        if (hipFuncSetAttribute((const void*)mk_fwd, hipFuncAttributeMaxDynamicSharedMemorySize, LDS_BYTES) != hipSuccess) { fprintf(stderr, "kernel_launch: hipFuncSetAttribute failed\n"); grid = -1; return; }
        if (hipOccupancyMaxActiveBlocksPerMultiprocessor(&per_cu, (const void*)mk_fwd, NWAVES * 64, LDS_BYTES) != hipSuccess || per_cu < 1) { fprintf(stderr, "kernel_launch: occupancy query says %d blocks per CU\n", per_cu); (void)hipGetLastError(); grid = -1; return; }
        grid = cus;
    }
    if (grid < 0) return;
    (void)hipMemsetAsync((char*)d_ws + WS_CTL, 0, CTL_ZERO_BYTES, stream);
    Args a{};
    for (int i = 0; i < 24; ++i) a.in[i] = (const float*)d_in[i];
    a.out = (float*)d_out; a.ws = (unsigned char*)d_ws;
    if (N_LAUNCHES == 1) {
        a.ph_lo = 0; a.ph_hi = PER_PHASE; a.li = 0;
        void* kargs[] = {&a};
        hipError_t e = hipLaunchCooperativeKernel((const void*)mk_fwd, dim3(grid), dim3(NWAVES * 64), kargs, LDS_BYTES, stream);
        if (e != hipSuccess) fprintf(stderr, "kernel_launch: cooperative launch failed: %s (grid %d)\n", hipGetErrorString(e), grid);
    } else {
        for (int li = 0; li < PER_PHASE; ++li) { a.ph_lo = li; a.ph_hi = li + 1; a.li = 0;
            hipLaunchKernelGGL(mk_fwd, dim3(grid), dim3(NWAVES * 64), LDS_BYTES, stream, a); }
    }
}
```

```cpp
#include <hip/hip_runtime.h>
#include <cstdio>
#include <cstdint>

#ifndef DBG_REP
#define DBG_REP -1
#endif
#ifndef DBG_TW
#define DBG_TW 0
#endif
#ifndef DBG_T
#define DBG_T 0
#endif
#define NREP(k) for (int rep_ = 0; rep_ < ((DBG_REP) == (k) ? 2 : 1); ++rep_)
#ifndef MK_N_LAUNCHES
#define MK_N_LAUNCHES 1
#endif

namespace pg8 {
#define PG8_LAS __attribute__((address_space(3)))
typedef unsigned short bf16_t;
typedef short bf16x8 __attribute__((ext_vector_type(8)));
typedef float f32x4 __attribute__((ext_vector_type(4)));
typedef unsigned u32x4 __attribute__((ext_vector_type(4)));
typedef unsigned u32x2 __attribute__((ext_vector_type(2)));
constexpr int BM = 256, BK = 64, HALF = 128, HTB = HALF * BK * 2, STAGE_BYTES = 8 * HTB, NXCD = 8, WGM = 8;

__host__ __device__ __forceinline__ int lds_byte(int r, int c) { const int st = (r >> 4) * 2 + (c >> 5), rr = r & 15, cc = c & 31, ob = rr * 64 + cc * 2; return st * 1024 + (ob ^ (((ob >> 9) & 1) << 5)); }
__host__ __device__ __forceinline__ void stage_rc(int b, int& R, int& C) { const int st = b / 1024, sb = b % 1024, swz = sb ^ (((sb >> 9) & 1) << 5); R = (st >> 1) * 16 + swz / 64; C = (st & 1) * 32 + (swz % 64) / 2; }
__host__ __device__ __forceinline__ int perm32(int rho) { const int n = rho >> 4, i = rho & 15; return 8 * (i >> 2) + 4 * n + (i & 3); }

struct Unit { int pm, pn; };
struct Gemm { const bf16_t* A; const bf16_t* Bt; int M, N, K, lda, ldb; };

struct StaticOrder {
    int nM, nN, nwg, G, c;
    __host__ __device__ void init(int M, int N, int G_, int c_) { nM = M / BM; nN = N / BM; nwg = nM * nN; G = G_; c = c_; }
    __host__ __device__ bool next(int i, Unit& u) const {
        const long L = (long)i * G + c; if (L >= nwg) return false;
        int wgid = (int)L; { const int q = nwg / NXCD, r = nwg % NXCD, xcd = wgid % NXCD, off = wgid / NXCD; wgid = (xcd < r ? xcd * (q + 1) : r * (q + 1) + (xcd - r) * q) + off; }
        const int nig = WGM * nN, gid = wgid / nig, fm = gid * WGM, gsz = (nM - fm) < WGM ? (nM - fm) : WGM;
        u.pm = fm + ((wgid % nig) % gsz); u.pn = (wgid % nig) / gsz; return true;
    }
};
struct CmpOrder {
    int c;
    __device__ bool next(int i, Unit& u) const { if (i != 0 || c >= 32) return false; u.pm = c; u.pn = c >> 4; return true; }
};

__device__ __forceinline__ unsigned cvt_pk_bf16(float lo, float hi) { unsigned r; asm volatile("v_cvt_pk_bf16_f32 %0, %1, %2" : "=v"(r) : "v"(lo), "v"(hi)); return r; }

template <class Epi, class Sched, bool ALIGN_EPI = false, bool SP2 = false>
__device__ __forceinline__ void gemm_phase(PG8_LAS unsigned char* lds, const Gemm g, const Sched& S, const Epi& E) {
    const int tid = threadIdx.x, wid = __builtin_amdgcn_readfirstlane(tid >> 6), lane = tid & 63, wr = wid >> 2, wc = wid & 3, fr = lane & 15, fq = lane >> 4;
    const int K = g.K, nt = K / BK;
    unsigned voffA[2], voffB[2];
#pragma unroll
    for (int i = 0; i < 2; ++i) { int R, C; stage_rc(tid * 16 + i * 8192, R, C); const int Rb = Epi::PERM ? ((R & ~31) + perm32(R & 31)) : R;
        voffA[i] = (unsigned)(R * g.lda + C) * 2u; voffB[i] = (unsigned)(Rb * g.ldb + C) * 2u; }
    const size_t kstep = (size_t)(BK * 2);
    const size_t hstepA = (size_t)HALF * g.lda * 2, hstepB = (size_t)HALF * g.ldb * 2;
    const size_t tstepA = 2 * hstepA, tstepB = 2 * hstepB;
    const unsigned ldsw = (unsigned)wid * 1024u;
    const int aoff = lds_byte(wr * 64 + fr, fq * 8), boff = lds_byte(wc * 32 + fr, fq * 8);
#define PG8_SA(b, h) (((b) * 2 + (h)) * HTB)
#define PG8_SB(b, h) ((4 + (b) * 2 + (h)) * HTB)
#define PG8_STAGE(bufoff, gbase, voff) do { _Pragma("unroll") for (int _i = 0; _i < 2; ++_i) \
        __builtin_amdgcn_global_load_lds((const unsigned*)((const char*)(gbase) + (voff)[_i]), (PG8_LAS unsigned*)(lds + (bufoff) + ldsw + _i * 8192), 16, 0, 0); } while (0)
#define PG8_LDA(dst, b, h) do { _Pragma("unroll") for (int m = 0; m < 4; ++m) _Pragma("unroll") for (int k = 0; k < 2; ++k) dst[m][k] = *(const PG8_LAS bf16x8*)(lds + PG8_SA(b, h) + aoff + m * 2048 + k * 1024); } while (0)
#define PG8_LDB(dst, b, h) do { _Pragma("unroll") for (int n = 0; n < 2; ++n) _Pragma("unroll") for (int k = 0; k < 2; ++k) dst[n][k] = *(const PG8_LAS bf16x8*)(lds + PG8_SB(b, h) + boff + n * 2048 + k * 1024); } while (0)
#define PG8_MMA(ai, bj, At, Bt) do { __builtin_amdgcn_s_setprio(1); _Pragma("unroll") for (int m = 0; m < 4; ++m) _Pragma("unroll") for (int n = 0; n < 2; ++n) _Pragma("unroll") for (int k = 0; k < 2; ++k) \
        acc[ai][bj][m][n] = __builtin_amdgcn_mfma_f32_16x16x32_bf16(Bt[n][k], At[m][k], acc[ai][bj][m][n], 0, 0, 0); __builtin_amdgcn_s_setprio(0); } while (0)
#define PG8_WAIT_V(n) asm volatile("s_waitcnt vmcnt(" #n ")" ::: "memory")
#define PG8_WAIT_L(n) asm volatile("s_waitcnt lgkmcnt(" #n ")" ::: "memory")
#define PG8_BAR __builtin_amdgcn_s_barrier()
#define PG8_SCHED __builtin_amdgcn_sched_barrier(0)
    Unit cur, nxt; int ui = 0;
    if (!S.next(0, cur)) return;
    f32x4 acc[2][2][4][2];
#pragma unroll
    for (int a = 0; a < 2; ++a)
#pragma unroll
        for (int b = 0; b < 2; ++b)
#pragma unroll
            for (int m = 0; m < 4; ++m)
#pragma unroll
                for (int n = 0; n < 2; ++n) acc[a][b][m][n] = (f32x4){0.f, 0.f, 0.f, 0.f};
    bf16x8 At[4][2], B0[2][2], B1[2][2];
    const char* cA = (const char*)g.A + (size_t)cur.pm * tstepA; const char* cB = (const char*)g.Bt + (size_t)cur.pn * tstepB;
    if constexpr (SP2) {
        PG8_STAGE(PG8_SB(0, 0), cB, voffB); PG8_STAGE(PG8_SB(0, 1), cB + hstepB, voffB); PG8_STAGE(PG8_SA(0, 0), cA, voffA); PG8_STAGE(PG8_SA(0, 1), cA + hstepA, voffA);
        if (wr == 1) PG8_BAR;
        PG8_WAIT_V(2); PG8_BAR;
        PG8_STAGE(PG8_SB(1, 0), cB + kstep, voffB); PG8_STAGE(PG8_SA(1, 0), cA + kstep, voffA); PG8_STAGE(PG8_SB(1, 1), cB + hstepB + kstep, voffB);
        PG8_WAIT_V(6); PG8_BAR;
    } else {
        PG8_STAGE(PG8_SB(0, 0), cB, voffB); PG8_STAGE(PG8_SA(0, 0), cA, voffA); PG8_STAGE(PG8_SB(0, 1), cB + hstepB, voffB); PG8_STAGE(PG8_SA(0, 1), cA + hstepA, voffA);
        if (wr == 1) PG8_BAR;
        PG8_WAIT_V(4); PG8_BAR;
        PG8_STAGE(PG8_SB(1, 0), cB + kstep, voffB); PG8_STAGE(PG8_SA(1, 0), cA + kstep, voffA); PG8_STAGE(PG8_SB(1, 1), cB + hstepB + kstep, voffB);
        PG8_WAIT_V(6); PG8_BAR;
    }
    for (;;) {
        const bool has_next = S.next(ui + 1, nxt);
        const char* nA = has_next ? (const char*)g.A + (size_t)nxt.pm * tstepA : cA; const char* nB = has_next ? (const char*)g.Bt + (size_t)nxt.pn * tstepB : cB;
        for (int t = 0; t < nt; t += 2) {
            const bool last = (t == nt - 2);
            const char* a1 = cA + (size_t)(t + 1) * kstep;
            const char* a2 = last ? nA : cA + (size_t)(t + 2) * kstep; const char* b2 = last ? nB : cB + (size_t)(t + 2) * kstep;
            const char* a3 = a2 + kstep; const char* b3 = b2 + kstep;
            if constexpr (SP2) {
            PG8_LDB(B0, 0, 0); PG8_LDB(B1, 0, 1); PG8_SCHED; PG8_LDA(At, 0, 0); PG8_STAGE(PG8_SA(1, 1), a1 + hstepA, voffA);
            PG8_WAIT_V(8); PG8_WAIT_L(0); PG8_BAR; PG8_MMA(0, 0, At, B0); PG8_MMA(0, 1, At, B1); PG8_BAR; PG8_SCHED;
            PG8_LDA(At, 0, 1); PG8_STAGE(PG8_SB(0, 0), b2, voffB); PG8_STAGE(PG8_SB(0, 1), b2 + hstepB, voffB); PG8_STAGE(PG8_SA(0, 0), a2, voffA);
            PG8_WAIT_V(8); PG8_WAIT_L(0); PG8_BAR; PG8_MMA(1, 0, At, B0); PG8_MMA(1, 1, At, B1); PG8_BAR; PG8_SCHED;
            PG8_LDB(B0, 1, 0); PG8_LDB(B1, 1, 1); PG8_SCHED; PG8_LDA(At, 1, 0); PG8_STAGE(PG8_SA(0, 1), a2 + hstepA, voffA);
            PG8_WAIT_V(8); PG8_WAIT_L(0); PG8_BAR; PG8_MMA(0, 0, At, B0); PG8_MMA(0, 1, At, B1); PG8_BAR; PG8_SCHED;
            PG8_LDA(At, 1, 1); PG8_STAGE(PG8_SB(1, 0), b3, voffB); PG8_STAGE(PG8_SB(1, 1), b3 + hstepB, voffB); PG8_STAGE(PG8_SA(1, 0), a3, voffA);
            PG8_WAIT_V(8); PG8_WAIT_L(0); PG8_BAR; PG8_MMA(1, 0, At, B0); PG8_MMA(1, 1, At, B1); PG8_BAR; PG8_SCHED;
            } else {
            PG8_LDB(B0, 0, 0); PG8_SCHED; PG8_LDA(At, 0, 0); PG8_STAGE(PG8_SA(1, 1), a1 + hstepA, voffA);
            PG8_WAIT_L(8); PG8_BAR; PG8_WAIT_L(0); PG8_MMA(0, 0, At, B0); PG8_BAR; PG8_SCHED;
            PG8_LDB(B1, 0, 1); PG8_STAGE(PG8_SB(0, 0), b2, voffB);
            PG8_BAR; PG8_WAIT_L(0); PG8_MMA(0, 1, At, B1); PG8_BAR;
            PG8_LDA(At, 0, 1); PG8_STAGE(PG8_SA(0, 0), a2, voffA);
            PG8_BAR; PG8_WAIT_L(0); PG8_MMA(1, 0, At, B0); PG8_BAR; PG8_SCHED;
            PG8_STAGE(PG8_SB(0, 1), b2 + hstepB, voffB);
            PG8_WAIT_V(6); PG8_BAR; PG8_MMA(1, 1, At, B1); PG8_BAR;
            PG8_LDB(B0, 1, 0); PG8_SCHED; PG8_LDA(At, 1, 0); PG8_STAGE(PG8_SA(0, 1), a2 + hstepA, voffA);
            PG8_WAIT_L(8); PG8_BAR; PG8_WAIT_L(0); PG8_MMA(0, 0, At, B0); PG8_BAR; PG8_SCHED;
            PG8_LDB(B1, 1, 1); PG8_STAGE(PG8_SB(1, 0), b3, voffB);
            PG8_BAR; PG8_WAIT_L(0); PG8_MMA(0, 1, At, B1); PG8_BAR;
            PG8_LDA(At, 1, 1); PG8_STAGE(PG8_SA(1, 0), a3, voffA);
            PG8_BAR; PG8_WAIT_L(0); PG8_MMA(1, 0, At, B0); PG8_BAR; PG8_SCHED;
            PG8_STAGE(PG8_SB(1, 1), b3 + hstepB, voffB);
            PG8_WAIT_V(6); PG8_BAR; PG8_MMA(1, 1, At, B1); PG8_BAR;
            }
        }
        if constexpr (ALIGN_EPI) { if (wr == 0) PG8_BAR; }
        E(acc, cur, wr, wc, fr, fq);
        if (!has_next) break;
#pragma unroll
        for (int a = 0; a < 2; ++a)
#pragma unroll
            for (int b = 0; b < 2; ++b)
#pragma unroll
                for (int m = 0; m < 4; ++m)
#pragma unroll
                    for (int n = 0; n < 2; ++n) acc[a][b][m][n] = (f32x4){0.f, 0.f, 0.f, 0.f};
        cur = nxt; cA = nA; cB = nB; ++ui;
        if constexpr (ALIGN_EPI) { if (wr == 1) PG8_BAR; }
    }
    PG8_WAIT_V(0);
    if constexpr (!ALIGN_EPI) { if (wr == 0) PG8_BAR; }
    PG8_BAR;
#undef PG8_SA
#undef PG8_SB
#undef PG8_STAGE
#undef PG8_LDA
#undef PG8_LDB
#undef PG8_MMA
#undef PG8_WAIT_V
#undef PG8_WAIT_L
#undef PG8_BAR
#undef PG8_SCHED
}
}

constexpr int NWAVES = 8;
constexpr int BATCH = 8, SEQ = 4096, DM = 1024, MTOK = BATCH * SEQ;
constexpr int DFF = 2816, NGU = 2 * DFF, INC = 2328, NIN = 2560;
constexpr int HD = 64, NBG = 16, NCMP = 255;
constexpr float EPS = 1e-6f;
constexpr int PER_PHASE = 10;
constexpr int N_LAUNCHES = MK_N_LAUNCHES;

constexpr size_t MiB = 1u << 20;
constexpr size_t WS_CTL = 0, CTL_ZERO_BYTES = 1 * MiB;
constexpr size_t WS_WGU1 = 2 * MiB, WS_WD1 = 13 * MiB, WS_WGU2 = 19 * MiB, WS_WD2 = 30 * MiB, WS_WIN = 36 * MiB, WS_WOUT = 41 * MiB, WS_CW1 = 43 * MiB;
constexpr size_t WS_WSB = 45 * MiB, WS_CB1P = 45 * MiB + 512 * 1024, WS_CW2 = 45 * MiB + 768 * 1024;
constexpr size_t WS_SS0 = 46 * MiB, WS_SS1 = 48 * MiB, WS_SS2 = 50 * MiB, WS_SS3 = 52 * MiB, WS_SSV = 54 * MiB;
constexpr size_t WS_XB = 56 * MiB;
constexpr size_t WS_ACT = 120 * MiB;
constexpr size_t WS_Y = 120 * MiB, WS_GVT = 184 * MiB, WS_KCR = 216 * MiB, WS_VCR = 224 * MiB, WS_KS = 232 * MiB, WS_VST = 240 * MiB, WS_KW = 248 * MiB, WS_VWT = 256 * MiB;
constexpr size_t WS_GATES = 264 * MiB, WS_H1 = 268 * MiB, WS_KCMP = 272 * MiB, WS_VCMPT = 272 * MiB + 512 * 1024;
constexpr size_t WS_END = 296 * MiB;
constexpr int CW_BAR = 4096;
constexpr int CW_Q = 8192;

constexpr int RING_OFF = 0, RING_BYTES = 147456;
constexpr int LDSCTL_OFF = RING_BYTES, MISC_OFF = LDSCTL_OFF + 320;
constexpr int TB_OFF = LDSCTL_OFF + 1024;
constexpr int TBL_OFF = LDSCTL_OFF + 2048;
constexpr int LDS_BYTES = 163840;

#define GAS __attribute__((address_space(1)))
#define LAS __attribute__((address_space(3)))
typedef unsigned short bf16;
typedef unsigned v4u __attribute__((ext_vector_type(4)));
typedef unsigned v2u __attribute__((ext_vector_type(2)));
typedef float f32x4 __attribute__((ext_vector_type(4)));
typedef GAS unsigned gu32;
#define RLX_AGENT __ATOMIC_RELAXED, __HIP_MEMORY_SCOPE_AGENT
#define LDS_WAIT() asm volatile("s_waitcnt lgkmcnt(0)" ::: "memory")
#define VM_WAIT() asm volatile("s_waitcnt vmcnt(0)" ::: "memory")
__device__ __forceinline__ unsigned f2bf(float f) { unsigned u = __builtin_bit_cast(unsigned, f); return (u + 0x7fffu + ((u >> 16) & 1u)) >> 16; }
__device__ __forceinline__ unsigned pk2(float lo, float hi) { return f2bf(lo) | (f2bf(hi) << 16); }
__device__ __forceinline__ float bf2f(unsigned short b) { return __builtin_bit_cast(float, (unsigned)b << 16); }
__device__ __forceinline__ float wave_sum(float v) {
#pragma unroll
    for (int o = 1; o < 64; o <<= 1) v += __shfl_xor(v, o);
    return v;
}
__device__ __forceinline__ float wave_max(float v) {
#pragma unroll
    for (int o = 1; o < 64; o <<= 1) v = fmaxf(v, __shfl_xor(v, o));
    return v;
}
__device__ __forceinline__ float gelu_tanh(float x) { const float u2 = 1.5957691216057308f * (x + 0.044715f * x * x * x); return x / (1.f + __expf(-u2)); }
__device__ __forceinline__ float sigmoidf_(float x) { return 1.f / (1.f + __expf(-x)); }

#define XB_TMO      128
#define XB_XCNT(j)  (256  + 64 * (j))
#define XB_XSUB(j)  (1280 + 64 * (j))
#define XB_XGEN(j)  (2304 + 64 * (j))
#define XB_TOP      3328
#define XB_TOPGEN   3392
#define XCD_BAR_WORDS 3456
#define XB_SPIN_CAP (1u << 22)
__device__ __forceinline__ unsigned xb_ld(unsigned* p)              { return __hip_atomic_load(p, __ATOMIC_RELAXED, __HIP_MEMORY_SCOPE_AGENT); }
__device__ __forceinline__ unsigned xb_add(unsigned* p, unsigned v) { return __hip_atomic_fetch_add(p, v, __ATOMIC_RELAXED, __HIP_MEMORY_SCOPE_AGENT); }
__device__ __forceinline__ unsigned xb_xcc_id() { return (unsigned)__builtin_amdgcn_s_getreg((3 << 11) | 20) & 0xFu; }
#define XB_SPIN(cond, bar) do { unsigned _sp = 0; while (cond) { __builtin_amdgcn_s_sleep(1); \
    if ((++_sp & 255u) == 0u) { if (xb_ld(&(bar)[XB_TMO])) break; if (_sp > XB_SPIN_CAP) { atomicAdd(&(bar)[XB_TMO], 1u); break; } } } } while (0)
struct XcdBarrier { unsigned* bar; unsigned x; volatile LAS unsigned* st; };
__device__ __forceinline__ XcdBarrier xcd_barrier_post(unsigned* bar, volatile LAS unsigned* st) {
    XcdBarrier b; b.bar = bar; b.x = xb_xcc_id(); b.st = st;
    if (threadIdx.x == 0) (void)xb_add(&bar[XB_XCNT(b.x)], 1u);
    return b;
}
__device__ __forceinline__ void xcd_barrier_complete(unsigned* bar, unsigned x, unsigned& nloc, unsigned& nx) {
    const unsigned G = gridDim.x * gridDim.y * gridDim.z;
    unsigned sum, cnt, mine, sp = 0u;
    for (;;) {
        sum = 0u; cnt = 0u; mine = 0u;
#pragma unroll
        for (unsigned j = 0; j < 16; ++j) { const unsigned c = xb_ld(&bar[XB_XCNT(j)]); sum += c; cnt += (c > 0u) ? 1u : 0u; mine = (j == x) ? c : mine; }
        if (sum == G) break;
        __builtin_amdgcn_s_sleep(1);
        if ((++sp & 255u) == 0u) { if (xb_ld(&bar[XB_TMO])) break; if (sp > XB_SPIN_CAP) { atomicAdd(&bar[XB_TMO], 1u); break; } }
    }
    nloc = mine > 0u ? mine : 1u; nx = cnt > 0u ? cnt : 1u;
}
__device__ __forceinline__ void xcd_barrier(const XcdBarrier& b) {
    asm volatile("s_waitcnt vmcnt(0)" ::: "memory");
    __syncthreads();
    if (threadIdx.x == 0) {
        unsigned* bar = b.bar;
        __builtin_amdgcn_s_waitcnt(0);
        unsigned nloc = b.st[0], nx = b.st[1];
        if (nloc == 0u) { xcd_barrier_complete(bar, b.x, nloc, nx); b.st[0] = nloc; b.st[1] = nx; }
        const unsigned old = xb_add(&bar[XB_XSUB(b.x)], 1u);
        const unsigned gen = old / nloc;
        if (old + 1u == (gen + 1u) * nloc) {
            __builtin_amdgcn_fence(__ATOMIC_RELEASE, "agent");
            asm volatile("s_waitcnt vmcnt(0)" ::: "memory");
            const unsigned og = xb_add(&bar[XB_TOP], 1u);
            const unsigned tg = og / nx;
            if (og + 1u == (tg + 1u) * nx) xb_add(&bar[XB_TOPGEN], 1u);
            else XB_SPIN(xb_ld(&bar[XB_TOPGEN]) == tg, bar);
            __builtin_amdgcn_fence(__ATOMIC_ACQUIRE, "agent");
            xb_add(&bar[XB_XGEN(b.x)], 1u);
            asm volatile("s_waitcnt vmcnt(0)" ::: "memory");
        } else {
            XB_SPIN(xb_ld(&bar[XB_XGEN(b.x)]) == gen, bar);
            __builtin_amdgcn_fence(__ATOMIC_ACQUIRE, "agent");
            asm volatile("s_waitcnt vmcnt(0)" ::: "memory");
        }
    }
    __syncthreads();
}

__device__ __forceinline__ float row_rinv(const float* ss, int row, int fq) {
    const f32x4 p = *(const f32x4*)(ss + (size_t)row * 16 + 4 * fq);
    float s = (p[0] + p[1]) + (p[2] + p[3]);
    s += __shfl_xor(s, 16); s += __shfl_xor(s, 32);
    return __builtin_amdgcn_rsqf(s * (1.f / DM) + EPS);
}
__device__ __forceinline__ float rsq_acc(float s, float invn) { return 1.0f / sqrtf(s * invn + EPS); }

struct EpiSwiGLU {
    static constexpr bool PERM = true;
    const float* ss; bf16* act;
    __device__ __forceinline__ void operator()(const f32x4 (&acc)[2][2][4][2], const pg8::Unit& u, int wr, int wc, int fr, int fq) const {
#pragma unroll
        for (int ai = 0; ai < 2; ++ai)
#pragma unroll
            for (int m = 0; m < 4; ++m) {
                const int row = u.pm * 256 + ai * 128 + wr * 64 + m * 16 + fr;
                const float ri = row_rinv(ss, row, fq);
                float o[8];
#pragma unroll
                for (int n = 0; n < 2; ++n)
#pragma unroll
                    for (int i = 0; i < 4; ++i) { const float g = acc[ai][0][m][n][i] * ri, up = acc[ai][1][m][n][i] * ri; o[n * 4 + i] = g * sigmoidf_(g) * up; }
                v4u w; w.x = pk2(o[0], o[1]); w.y = pk2(o[2], o[3]); w.z = pk2(o[4], o[5]); w.w = pk2(o[6], o[7]);
                *(v4u*)(act + (size_t)row * DFF + u.pn * 128 + wc * 32 + fq * 8) = w;
            }
    }
};
struct EpiResid {
    static constexpr bool PERM = false;
    const float* base; float* out; bf16* xb; float* ssp; float scale;
    __device__ __forceinline__ void operator()(const f32x4 (&acc)[2][2][4][2], const pg8::Unit& u, int wr, int wc, int fr, int fq) const {
#pragma unroll
        for (int ai = 0; ai < 2; ++ai)
#pragma unroll
            for (int m = 0; m < 4; ++m) {
                const int row = u.pm * 256 + ai * 128 + wr * 64 + m * 16 + fr;
                float sq = 0.f;
#pragma unroll
                for (int bj = 0; bj < 2; ++bj)
#pragma unroll
                    for (int n = 0; n < 2; ++n) {
                        const size_t off = (size_t)row * DM + u.pn * 256 + bj * 128 + wc * 32 + n * 16 + fq * 4;
                        const f32x4 b = *(const f32x4*)(base + off);
                        const f32x4 o = b + acc[ai][bj][m][n] * scale;
                        *(f32x4*)(out + off) = o;
                        if (xb) { v2u w; w.x = pk2(o[0], o[1]); w.y = pk2(o[2], o[3]); *(v2u*)(xb + off) = w; }
                        sq += (o[0] * o[0] + o[1] * o[1]) + (o[2] * o[2] + o[3] * o[3]);
                    }
                sq += __shfl_xor(sq, 16); sq += __shfl_xor(sq, 32);
                if (fq == 0) ssp[(size_t)row * 16 + u.pn * 4 + wc] = sq;
            }
    }
};
struct EpiMix {
    static constexpr bool PERM = true;
    const float* ss; unsigned char* ws; const float* qg; const float* kg;
    __device__ __forceinline__ void operator()(const f32x4 (&acc)[2][2][4][2], const pg8::Unit& u, int wr, int wc, int fr, int fq) const {
        const int pn = u.pn;
        bf16* const Y = (bf16*)(ws + WS_Y); bf16* const GVT = (bf16*)(ws + WS_GVT); float* const SSV = (float*)(ws + WS_SSV); bf16* const KCR = (bf16*)(ws + WS_KCR); bf16* const VCR = (bf16*)(ws + WS_VCR);
        bf16* const KS = (bf16*)(ws + WS_KS); bf16* const VST = (bf16*)(ws + WS_VST); bf16* const KW = (bf16*)(ws + WS_KW); bf16* const VWT = (bf16*)(ws + WS_VWT); float* const GATES = (float*)(ws + WS_GATES);
        float gn[2][2][4];
        const float* gsrc = nullptr;
        if (pn == 4 || pn == 5) gsrc = qg; else if (pn == 7 && wc < 2) gsrc = kg + 64; else if (pn == 8 && wc < 2) gsrc = kg + 128;
#pragma unroll
        for (int bj = 0; bj < 2; ++bj)
#pragma unroll
            for (int n = 0; n < 2; ++n)
#pragma unroll
                for (int i = 0; i < 4; ++i) gn[bj][n][i] = gsrc ? gsrc[32 * bj + 8 * fq + 4 * n + i] : 1.f;
#pragma unroll
        for (int ai = 0; ai < 2; ++ai)
#pragma unroll
            for (int m = 0; m < 4; ++m) {
                const int row = u.pm * 256 + ai * 128 + wr * 64 + m * 16 + fr;
                const int b = row >> 12, t = row & 4095;
                const float ri = row_rinv(ss, row, fq);
                float v[2][2][4];
#pragma unroll
                for (int bj = 0; bj < 2; ++bj)
#pragma unroll
                    for (int n = 0; n < 2; ++n)
#pragma unroll
                        for (int i = 0; i < 4; ++i) v[bj][n][i] = acc[ai][bj][m][n][i] * ri;
                if (pn < 4) {
                    float sq = 0.f;
#pragma unroll
                    for (int bj = 0; bj < 2; ++bj)
#pragma unroll
                        for (int n = 0; n < 2; ++n)
#pragma unroll
                            for (int i = 0; i < 4; ++i) { const float x = gelu_tanh(v[bj][n][i]); v[bj][n][i] = x; sq += x * x; }
                    if (pn < 2) {
#pragma unroll
                        for (int bj = 0; bj < 2; ++bj) { v4u w; w.x = pk2(v[bj][0][0], v[bj][0][1]); w.y = pk2(v[bj][0][2], v[bj][0][3]); w.z = pk2(v[bj][1][0], v[bj][1][1]); w.w = pk2(v[bj][1][2], v[bj][1][3]);
                            *(v4u*)(Y + (size_t)row * DM + pn * 256 + wc * 64 + bj * 32 + fq * 8) = w; }
                    } else {
                        const int h = (pn - 2) * 4 + wc;
                        bf16* dst = GVT + ((size_t)(b * 8 + h) * 64) * SEQ + t;
#pragma unroll
                        for (int bj = 0; bj < 2; ++bj)
#pragma unroll
                            for (int n = 0; n < 2; ++n)
#pragma unroll
                                for (int i = 0; i < 4; ++i) dst[(size_t)(32 * bj + 8 * fq + 4 * n + i) * SEQ] = (bf16)f2bf(v[bj][n][i]);
                        sq += __shfl_xor(sq, 16); sq += __shfl_xor(sq, 32);
                        if (fq == 0) SSV[(size_t)row * 8 + (pn - 2) * 4 + wc] = sq;
                    }
                } else if (pn < 9) {
                    const bool is_q = (pn == 4 || pn == 5);
                    const bool is_k = (wc < 2);
                    const bool normed = is_q || ((pn == 7 || pn == 8) && is_k);
                    if (normed) {
                        float sq = 0.f;
#pragma unroll
                        for (int bj = 0; bj < 2; ++bj)
#pragma unroll
                            for (int n = 0; n < 2; ++n)
#pragma unroll
                                for (int i = 0; i < 4; ++i) sq += v[bj][n][i] * v[bj][n][i];
                        sq += __shfl_xor(sq, 16); sq += __shfl_xor(sq, 32);
                        const float rh = rsq_acc(sq, 1.f / 64.f) * (is_q ? 0.125f * 1.4426950408889634f : 1.f);
#pragma unroll
                        for (int bj = 0; bj < 2; ++bj)
#pragma unroll
                            for (int n = 0; n < 2; ++n)
#pragma unroll
                                for (int i = 0; i < 4; ++i) v[bj][n][i] *= rh * gn[bj][n][i];
                    }
                    if (is_q || is_k) {
                        bf16* dst;
                        if (is_q) dst = Y + (size_t)row * DM + 512 + (pn - 4) * 256 + wc * 64;
                        else { bf16* kb = (pn == 6) ? KCR : (pn == 7) ? KS : KW; dst = kb + ((size_t)(b * 2 + wc) * SEQ + t) * 64; }
#pragma unroll
                        for (int bj = 0; bj < 2; ++bj) { v4u w; w.x = pk2(v[bj][0][0], v[bj][0][1]); w.y = pk2(v[bj][0][2], v[bj][0][3]); w.z = pk2(v[bj][1][0], v[bj][1][1]); w.w = pk2(v[bj][1][2], v[bj][1][3]);
                            *(v4u*)(dst + bj * 32 + fq * 8) = w; }
                    } else if (pn == 6) {
                        bf16* dst = VCR + ((size_t)(b * 2 + (wc - 2)) * SEQ + t) * 64;
#pragma unroll
                        for (int bj = 0; bj < 2; ++bj) { v4u w; w.x = pk2(v[bj][0][0], v[bj][0][1]); w.y = pk2(v[bj][0][2], v[bj][0][3]); w.z = pk2(v[bj][1][0], v[bj][1][1]); w.w = pk2(v[bj][1][2], v[bj][1][3]);
                            *(v4u*)(dst + bj * 32 + fq * 8) = w; }
                    } else {
                        bf16* vb = (pn == 7) ? VST : VWT;
                        const int tp = (t & ~12) | ((t & 4) << 1) | ((t & 8) >> 1);
                        bf16* dst = vb + ((size_t)(b * 2 + (wc - 2)) * 64) * SEQ + tp;
#pragma unroll
                        for (int bj = 0; bj < 2; ++bj)
#pragma unroll
                            for (int n = 0; n < 2; ++n)
#pragma unroll
                                for (int i = 0; i < 4; ++i) dst[(size_t)(32 * bj + 8 * fq + 4 * n + i) * SEQ] = (bf16)f2bf(v[bj][n][i]);
                    }
                } else {
                    if (wc == 0 && fq < 3) {
                        f32x4 g0, g1;
#pragma unroll
                        for (int i = 0; i < 4; ++i) { g0[i] = sigmoidf_(v[0][0][i]); g1[i] = sigmoidf_(v[0][1][i]); }
                        *(f32x4*)(GATES + (size_t)row * 24 + fq * 8) = g0; *(f32x4*)(GATES + (size_t)row * 24 + fq * 8 + 4) = g1;
                    }
                }
            }
    }
};
struct EpiCmp {
    static constexpr bool PERM = true;
    const float* cb1p; bf16* H1;
    __device__ __forceinline__ void operator()(const f32x4 (&acc)[2][2][4][2], const pg8::Unit& u, int wr, int wc, int fr, int fq) const {
        float bias[2][2][4];
#pragma unroll
        for (int bj = 0; bj < 2; ++bj)
#pragma unroll
            for (int n = 0; n < 2; ++n)
#pragma unroll
                for (int i = 0; i < 4; ++i) { const int col = u.pn * 256 + bj * 128 + wc * 32 + fq * 8 + n * 4 + i; float s = 0.f;
#pragma unroll
                    for (int p = 0; p < 8; ++p) s += cb1p[p * 512 + col];
                    bias[bj][n][i] = s; }
#pragma unroll
        for (int ai = 0; ai < 2; ++ai)
#pragma unroll
            for (int m = 0; m < 4; ++m) {
                const int row = u.pm * 256 + ai * 128 + wr * 64 + m * 16 + fr;
#pragma unroll
                for (int bj = 0; bj < 2; ++bj) { float o[8];
#pragma unroll
                    for (int n = 0; n < 2; ++n)
#pragma unroll
                        for (int i = 0; i < 4; ++i) o[n * 4 + i] = gelu_tanh(acc[ai][bj][m][n][i] + bias[bj][n][i]);
                    v4u w; w.x = pk2(o[0], o[1]); w.y = pk2(o[2], o[3]); w.z = pk2(o[4], o[5]); w.w = pk2(o[6], o[7]);
                    *(v4u*)(H1 + (size_t)row * 256 + bj * 128 + wc * 32 + fq * 8) = w; }
            }
    }
};

struct Frame {
    LAS unsigned char* lds; volatile LAS unsigned* MISC; gu32* ctl;
    int tid, lane, wave, vcu, G;
};
struct Args { const float* in[24]; float* out; unsigned char* ws; int ph_lo, ph_hi, li, pad; };

__device__ __forceinline__ void p0_tr_item(const float* W, int ldw, int K, const float* gain, bf16* WT, int n0d, int sc0, int nv0, int sc1, int nv1, int kb, LAS float* scr, int lane) {
    const int k0 = 64 * kb, c16 = lane & 15, half = c16 >> 3, cc = (c16 & 7) * 4;
    const int sc = half ? sc1 : sc0, nv = half ? nv1 : nv0;
#pragma unroll 8
    for (int i = 0; i < 16; ++i) { const int kk = 4 * i + (lane >> 4);
        f32x4 x = {0.f, 0.f, 0.f, 0.f};
        if (cc < nv) { x = *(const f32x4*)(W + (size_t)(k0 + kk) * ldw + sc + cc); if (gain) x = x * gain[k0 + kk]; }
        *(LAS f32x4*)(scr + kk * 68 + c16 * 4) = x; }
    LDS_WAIT(); asm volatile("" ::: "memory");
#pragma unroll
    for (int kc = 0; kc < 8; ++kc) { const LAS float* sp = scr + (8 * kc) * 68 + lane;
        v4u o; o.x = pk2(sp[0 * 68], sp[1 * 68]); o.y = pk2(sp[2 * 68], sp[3 * 68]); o.z = pk2(sp[4 * 68], sp[5 * 68]); o.w = pk2(sp[6 * 68], sp[7 * 68]);
        *(GAS v4u*)(WT + (size_t)(n0d + lane) * K + k0 + 8 * kc) = o; }
    LDS_WAIT(); asm volatile("" ::: "memory");
}

__device__ __forceinline__ void p0_prologue(Frame& F, const Args& A) {
    unsigned char* ws = A.ws;
    LAS float* scr = (LAS float*)(F.lds + RING_OFF + F.wave * 17408);
    const int gw = F.vcu * NWAVES + F.wave, NGW = F.G * NWAVES, lane = F.lane;
    constexpr int I_GU = (DM / 64) * (NGU / 64), I_D = (DFF / 64) * (DM / 64), I_IN = (DM / 64) * (NIN / 64), I_OUT = (DM / 64) * (DM / 64), I_C1 = 2 * (2048 / 64) * (256 / 64);
    constexpr int I_WS = 8 * 128 * 128 / 64 / 8;
    constexpr int I_CB = 64, I_C2 = 64;
    constexpr int NITEMS = 2 * I_GU + 2 * I_D + I_IN + I_OUT + I_C1 + I_WS + I_CB + I_C2;
    for (int it = gw; it < NITEMS; it += NGW) {
        int r = it;
        if (r < 2 * I_GU) {
            const int f = r / I_GU; r -= f * I_GU; const int nblk = NGU / 64, kb = r / nblk, nb = r % nblk, n0 = 64 * nb, pn = n0 >> 8, bj = (n0 >> 7) & 1, j = n0 & 127;
            const float* W = f ? (bj ? A.in[21] : A.in[20]) : (bj ? A.in[3] : A.in[2]);
            p0_tr_item(W, DFF, DM, f ? A.in[19] : A.in[1], (bf16*)(ws + (f ? WS_WGU2 : WS_WGU1)), n0, 128 * pn + j, 32, 128 * pn + j + 32, 32, kb, scr, lane); continue; }
        r -= 2 * I_GU;
        if (r < 2 * I_D) {
            const int f = r / I_D; r -= f * I_D; const int nblk = DM / 64, kb = r / nblk, nb = r % nblk;
            p0_tr_item(f ? A.in[22] : A.in[4], DM, DFF, nullptr, (bf16*)(ws + (f ? WS_WD2 : WS_WD1)), 64 * nb, 64 * nb, 32, 64 * nb + 32, 32, kb, scr, lane); continue; }
        r -= 2 * I_D;
        if (r < I_IN) {
            const int nblk = NIN / 64, kb = r / nblk, nb = r % nblk, n0 = 64 * nb, pn = n0 >> 8, tc = n0 & 255;
            const int col0 = 256 * pn + 64 * ((tc >> 5) & 3) + 32 * (tc >> 7), col1 = 256 * pn + 64 * (((tc + 32) >> 5) & 3) + 32 * ((tc + 32) >> 7);
            int nv0 = INC - col0; nv0 = nv0 < 0 ? 0 : (nv0 > 32 ? 32 : nv0); int nv1 = INC - col1; nv1 = nv1 < 0 ? 0 : (nv1 > 32 ? 32 : nv1);
            p0_tr_item(A.in[6], INC, DM, A.in[5], (bf16*)(ws + WS_WIN), n0, col0, nv0, col1, nv1, kb, scr, lane); continue; }
        r -= I_IN;
        if (r < I_OUT) { const int nblk = DM / 64, kb = r / nblk, nb = r % nblk;
            p0_tr_item(A.in[18], DM, DM, nullptr, (bf16*)(ws + WS_WOUT), 64 * nb, 64 * nb, 32, 64 * nb + 32, 32, kb, scr, lane); continue; }
        r -= I_OUT;
        if (r < I_C1) { const int kv = r / (I_C1 / 2); r -= kv * (I_C1 / 2); const int nblk = 256 / 64, kb = r / nblk, nb = r % nblk;
            p0_tr_item(A.in[13] + (size_t)kv * 2048 * 256, 256, 2048, nullptr, (bf16*)(ws + WS_CW1) + (size_t)kv * 256 * 2048, 64 * nb, 64 * nb, 32, 64 * nb + 32, 32, kb, scr, lane); continue; }
        r -= I_C1;
        if (r < I_WS) {
            const int e0 = (r * 64 + lane) * 8; const int s0 = e0 & 127, t = (e0 >> 7) & 127;
            const float* src = A.in[8] + e0; unsigned o[4];
#pragma unroll
            for (int i = 0; i < 4; ++i) { const float a = (s0 + 2 * i <= t) ? src[2 * i] : 0.f, b2 = (s0 + 2 * i + 1 <= t) ? src[2 * i + 1] : 0.f; o[i] = pk2(a, b2); }
            *(v4u*)((bf16*)(ws + WS_WSB) + e0) = (v4u){o[0], o[1], o[2], o[3]}; continue; }
        r -= I_WS;
        if (r >= I_CB) {
            r -= I_CB; const int e0 = (r * 64 + lane) * 8, kv = e0 >> 14, d = (e0 >> 8) & 63, j0 = e0 & 255;
            const float* src = A.in[15] + (size_t)kv * 256 * 64 + d; unsigned o[4];
#pragma unroll
            for (int i = 0; i < 4; ++i) o[i] = pk2(src[(size_t)(j0 + 2 * i) * 64], src[(size_t)(j0 + 2 * i + 1) * 64]);
            *(v4u*)((bf16*)(ws + WS_CW2) + e0) = (v4u){o[0], o[1], o[2], o[3]}; continue; }
        {
            const int kp = r & 7, jb = (r >> 3) & 3, kv = r >> 5, j = jb * 64 + lane;
            const float* pe = A.in[12] + (size_t)kv * 2048; const float* w1 = A.in[13] + (size_t)kv * 2048 * 256;
            float s = (kp == 0) ? A.in[14][kv * 256 + j] : 0.f;
            for (int k = kp * 256; k < kp * 256 + 256; ++k) s += pe[k] * w1[(size_t)k * 256 + j];
            ((float*)(ws + WS_CB1P))[kp * 512 + kv * 256 + j] = s;
        }
    }
    const float* x = A.in[0]; bf16* XB = (bf16*)(ws + WS_XB); float* SS0 = (float*)(ws + WS_SS0);
    for (int m0 = 2 * gw; m0 < MTOK; m0 += 2 * NGW) {
        f32x4 v[2][4];
#pragma unroll
        for (int rr = 0; rr < 2; ++rr) { const GAS f32x4* xr = (const GAS f32x4*)(x + (size_t)(m0 + rr) * DM) + lane;
#pragma unroll
            for (int j = 0; j < 4; ++j) v[rr][j] = xr[64 * j]; }
#pragma unroll
        for (int rr = 0; rr < 2; ++rr) { GAS unsigned long long* o8 = (GAS unsigned long long*)(XB + (size_t)(m0 + rr) * DM) + lane; float sq = 0.f;
#pragma unroll
            for (int j = 0; j < 4; ++j) { const f32x4 t = v[rr][j]; sq += (t.x * t.x + t.y * t.y) + (t.z * t.z + t.w * t.w);
                o8[64 * j] = (unsigned long long)pk2(t.x, t.y) | ((unsigned long long)pk2(t.z, t.w) << 32); }
            sq = wave_sum(sq);
            if (lane < 16) SS0[(size_t)(m0 + rr) * 16 + lane] = (lane == 0) ? sq : 0.f; }
    }
}

__device__ __forceinline__ void gmlp_unit(Frame& F, const Args& A, int unit) {
    typedef short bf16x8 __attribute__((ext_vector_type(8)));
    typedef float f32x16 __attribute__((ext_vector_type(16)));
    unsigned char* ws = A.ws;
    const int b = unit >> 5, c = unit & 31, r0 = b * SEQ + c * 128, tid = F.tid, lane = F.lane, w = F.wave, r = lane & 31, hh = lane >> 5, tt = w >> 1, dt = w & 1;
    LAS unsigned char* L = F.lds + RING_OFF;
    LAS float* rv = (LAS float*)(L + 131072); LAS float* gvl = rv + 128; LAS float* bsl = gvl + 512;
    { const float* SSV = (const float*)(ws + WS_SSV);
      if (tid < 128) { const f32x4 p0 = *(const f32x4*)(SSV + (size_t)(r0 + tid) * 8), p1 = *(const f32x4*)(SSV + (size_t)(r0 + tid) * 8 + 4);
          rv[tid] = rsq_acc(((p0[0] + p0[1]) + (p0[2] + p0[3])) + ((p1[0] + p1[1]) + (p1[2] + p1[3])), 1.f / 512.f); }
      gvl[tid] = A.in[7][tid]; bsl[tid] = A.in[9][tid]; bsl[512 + tid] = A.in[9][512 + tid]; }
    asm volatile("s_waitcnt vmcnt(0) lgkmcnt(0)" ::: "memory");
    __syncthreads();
    const bf16* GVT = (const bf16*)(ws + WS_GVT) + ((size_t)(b * 8) * 64) * SEQ + c * 128;
    const bf16* WSB = (const bf16*)(ws + WS_WSB);
    bf16* Y = (bf16*)(ws + WS_Y) + (size_t)r0 * DM;
#define GM_DMA(h) do { const int h_ = (h); LAS unsigned char* B_ = L + (h_ & 1) * 65536; \
        _Pragma("unroll") for (int q_ = 0; q_ < 2; ++q_) { const int d_ = 4 * (2 * w + q_) + (lane >> 4), cs_ = (lane & 15) ^ (d_ & 15); \
            __builtin_amdgcn_global_load_lds((const unsigned*)(GVT + ((size_t)h_ * 64 + d_) * SEQ + 8 * cs_), (LAS unsigned*)(B_ + (2 * w + q_) * 1024), 16, 0, 0); } \
        _Pragma("unroll") for (int q_ = 0; q_ < 4; ++q_) { const int t_ = 4 * (4 * w + q_) + (lane >> 4), cs_ = (lane & 15) ^ (t_ & 15); \
            __builtin_amdgcn_global_load_lds((const unsigned*)(WSB + ((size_t)h_ * 128 + t_) * 128 + 8 * cs_), (LAS unsigned*)(B_ + 16384 + (4 * w + q_) * 1024), 16, 0, 0); } \
        _Pragma("unroll") for (int q_ = 0; q_ < 2; ++q_) { const int t_ = 8 * (2 * w + q_) + (lane >> 3), cs_ = (lane & 7) ^ (t_ & 7); \
            __builtin_amdgcn_global_load_lds((const unsigned*)(Y + (size_t)t_ * DM + h_ * 64 + 8 * cs_), (LAS unsigned*)(B_ + 49152 + (2 * w + q_) * 1024), 16, 0, 0); } } while (0)
    GM_DMA(0);
#pragma unroll 1
    for (int h = 0; h < 8; ++h) {
        if (h + 1 < 8) { GM_DMA(h + 1); asm volatile("s_waitcnt vmcnt(8)" ::: "memory"); } else asm volatile("s_waitcnt vmcnt(0)" ::: "memory");
        __builtin_amdgcn_s_barrier(); asm volatile("" ::: "memory");
        const LAS unsigned char* B = L + (h & 1) * 65536;
        f32x16 acc;
#pragma unroll
        for (int i = 0; i < 16; ++i) acc[i] = 0.f;
        const int d = 32 * dt + r, t = 32 * tt + r;
#pragma unroll
        for (int ks = 0; ks < 8; ++ks) {
            if (ks <= 2 * tt + 1) {
                const int s0 = 16 * ks + 8 * hh;
                const v4u raw = *(const LAS v4u*)(B + d * 256 + (((2 * ks + hh) ^ (d & 15)) * 16));
                const f32x4 ra = *(const LAS f32x4*)(rv + s0), rb = *(const LAS f32x4*)(rv + s0 + 4);
                v4u o; o.x = pk2(__builtin_bit_cast(float, raw.x << 16) * ra[0], __builtin_bit_cast(float, raw.x & 0xffff0000u) * ra[1]);
                o.y = pk2(__builtin_bit_cast(float, raw.y << 16) * ra[2], __builtin_bit_cast(float, raw.y & 0xffff0000u) * ra[3]);
                o.z = pk2(__builtin_bit_cast(float, raw.z << 16) * rb[0], __builtin_bit_cast(float, raw.z & 0xffff0000u) * rb[1]);
                o.w = pk2(__builtin_bit_cast(float, raw.w << 16) * rb[2], __builtin_bit_cast(float, raw.w & 0xffff0000u) * rb[3]);
                const bf16x8 wf = *(const LAS bf16x8*)(B + 16384 + t * 256 + (((2 * ks + hh) ^ (t & 15)) * 16));
                acc = __builtin_amdgcn_mfma_f32_32x32x16_bf16(__builtin_bit_cast(bf16x8, o), wf, acc, 0, 0, 0);
            }
        }
        {
            const float bt = bsl[h * 128 + t];
            LAS unsigned char* U = L + (h & 1) * 65536 + 49152 + t * 128;
#pragma unroll
            for (int q = 0; q < 4; ++q) { const int dd = 32 * dt + 8 * q + 4 * hh; LAS v2u* up = (LAS v2u*)(U + (((4 * dt + q) ^ (t & 7)) * 16) + 8 * hh);
                const f32x4 gg = *(const LAS f32x4*)(gvl + h * 64 + dd); const v2u uu = *up;
                const float o0 = __builtin_bit_cast(float, uu.x << 16) * (acc[4 * q] * gg[0] + bt), o1 = __builtin_bit_cast(float, uu.x & 0xffff0000u) * (acc[4 * q + 1] * gg[1] + bt);
                const float o2 = __builtin_bit_cast(float, uu.y << 16) * (acc[4 * q + 2] * gg[2] + bt), o3 = __builtin_bit_cast(float, uu.y & 0xffff0000u) * (acc[4 * q + 3] * gg[3] + bt);
                *up = (v2u){pk2(o0, o1), pk2(o2, o3)}; }
        }
        asm volatile("s_waitcnt lgkmcnt(0)" ::: "memory"); __builtin_amdgcn_s_barrier(); asm volatile("" ::: "memory");
#pragma unroll
        for (int i = 0; i < 2; ++i) { const int e = tid + 512 * i, tr = e >> 3, pp = e & 7, cs = pp ^ (tr & 7);
            const v4u val = *(const LAS v4u*)(L + (h & 1) * 65536 + 49152 + tr * 128 + pp * 16);
            *(v4u*)(Y + (size_t)tr * DM + h * 64 + 8 * cs) = val; }
        asm volatile("s_waitcnt lgkmcnt(0)" ::: "memory"); __builtin_amdgcn_s_barrier(); asm volatile("" ::: "memory");
    }
#undef GM_DMA
    asm volatile("s_waitcnt vmcnt(0)" ::: "memory");
    __syncthreads();
}
__device__ __forceinline__ void cmp_unit(Frame& F, const Args& A, int unit) {
    typedef short bf16x8 __attribute__((ext_vector_type(8)));
    typedef float f32x16 __attribute__((ext_vector_type(16)));
    unsigned char* ws = A.ws;
    const int tid = F.tid, lane = F.lane, w = F.wave, r = lane & 31, hh = lane >> 5;
    const int row0 = unit * 32, kv = row0 >> 12;
    LAS unsigned char* L = F.lds + RING_OFF;
    const bf16* X = (const bf16*)(ws + WS_KCR) + (size_t)row0 * 1024;
#pragma unroll
    for (int i = 0; i < 9; ++i) { const int pos = 512 * i + tid; if (i < 8 || w < 2) { const int Fc = pos ^ ((pos >> 7) & 7);
        __builtin_amdgcn_global_load_lds((const unsigned*)(X + (size_t)Fc * 8), (LAS unsigned*)(L + (512 * i + 64 * w) * 16), 16, 0, 0); } }
    const bf16* W1 = (const bf16*)(ws + WS_CW1) + ((size_t)kv * 256 + 32 * w) * 2048;
    LAS unsigned char* WB = L + 67584 + w * 8192;
#define CM_DMA(kc) do { const int kc_ = (kc); _Pragma("unroll") for (int q_ = 0; q_ < 4; ++q_) { const int rr_ = 8 * q_ + (lane >> 3), cs_ = (lane & 7) ^ (rr_ & 7); \
        __builtin_amdgcn_global_load_lds((const unsigned*)(W1 + (size_t)rr_ * 2048 + 64 * kc_ + 8 * cs_), (LAS unsigned*)(WB + (kc_ & 1) * 4096 + q_ * 1024), 16, 0, 0); } } while (0)
    CM_DMA(0);
    asm volatile("s_waitcnt vmcnt(4)" ::: "memory");
    __builtin_amdgcn_s_barrier(); asm volatile("" ::: "memory");
    f32x16 acc;
#pragma unroll
    for (int i = 0; i < 16; ++i) acc[i] = 0.f;
#pragma unroll 1
    for (int kc = 0; kc < 32; ++kc) {
        if (kc + 1 < 32) { CM_DMA(kc + 1); asm volatile("s_waitcnt vmcnt(4)" ::: "memory"); } else asm volatile("s_waitcnt vmcnt(0)" ::: "memory");
        const LAS unsigned char* wb = WB + (kc & 1) * 4096 + r * 128;
#pragma unroll
        for (int ks = 0; ks < 4; ++ks) {
            const bf16x8 wf = *(const LAS bf16x8*)(wb + (((2 * ks + hh) ^ (r & 7)) * 16));
            const int Fc = 128 * r + 8 * kc + 2 * ks + hh;
            const bf16x8 xf = *(const LAS bf16x8*)(L + ((Fc ^ ((Fc >> 7) & 7)) * 16));
            acc = __builtin_amdgcn_mfma_f32_32x32x16_bf16(wf, xf, acc, 0, 0, 0);
        }
        asm volatile("s_waitcnt lgkmcnt(0)" ::: "memory");
    }
#undef CM_DMA
    const float* cb1p = (const float*)(ws + WS_CB1P) + kv * 256 + 32 * w;
    float bias[4][4];
#pragma unroll
    for (int q = 0; q < 4; ++q)
#pragma unroll
        for (int i = 0; i < 4; ++i) { const int col = 8 * q + 4 * hh + i; float bsum = 0.f;
#pragma unroll
            for (int pz = 0; pz < 8; ++pz) bsum += cb1p[pz * 512 + col];
            bias[q][i] = bsum; }
    __syncthreads();
    LAS unsigned char* HL = L;
#pragma unroll
    for (int q = 0; q < 4; ++q) { float o[4];
#pragma unroll
        for (int i = 0; i < 4; ++i) o[i] = gelu_tanh(acc[4 * q + i] + bias[q][i]);
        *(LAS v2u*)(HL + r * 528 + (32 * w + 8 * q + 4 * hh) * 2) = (v2u){pk2(o[0], o[1]), pk2(o[2], o[3])}; }
    __syncthreads();
    if (w == 0) {
        const bf16* W2 = (const bf16*)(ws + WS_CW2) + (size_t)kv * 64 * 256;
        f32x16 a2[2];
#pragma unroll
        for (int i = 0; i < 16; ++i) { a2[0][i] = 0.f; a2[1][i] = 0.f; }
#pragma unroll
        for (int ks = 0; ks < 16; ++ks) {
            const bf16x8 hf = *(const LAS bf16x8*)(HL + r * 528 + (16 * ks + 8 * hh) * 2);
#pragma unroll
            for (int dt = 0; dt < 2; ++dt) { const bf16x8 wf = *(const bf16x8*)(W2 + (size_t)(32 * dt + r) * 256 + 16 * ks + 8 * hh);
                a2[dt] = __builtin_amdgcn_mfma_f32_32x32x16_bf16(wf, hf, a2[dt], 0, 0, 0); }
        }
        const float* b2 = A.in[16] + kv * 64; const float* kg0 = A.in[11];
        float sq = 0.f;
#pragma unroll
        for (int dt = 0; dt < 2; ++dt)
#pragma unroll
            for (int i = 0; i < 16; ++i) { const int d = 32 * dt + (i & 3) + 8 * (i >> 2) + 4 * hh; a2[dt][i] += b2[d]; sq += a2[dt][i] * a2[dt][i]; }
        const int row = row0 + r, n = row & 255, bg = (row & 4095) >> 8;
        if (kv == 0) {
            sq += __shfl_xor(sq, 32); const float rn = rsq_acc(sq, 1.f / 64.f);
            bf16* dst = (bf16*)(ws + WS_KCMP) + ((size_t)bg * 256 + n) * 64;
#pragma unroll
            for (int dt = 0; dt < 2; ++dt)
#pragma unroll
                for (int q = 0; q < 4; ++q) { const int d = 32 * dt + 8 * q + 4 * hh; const f32x4 gg = *(const f32x4*)(kg0 + d);
                    v2u wv; wv.x = pk2(a2[dt][4 * q] * rn * gg[0], a2[dt][4 * q + 1] * rn * gg[1]); wv.y = pk2(a2[dt][4 * q + 2] * rn * gg[2], a2[dt][4 * q + 3] * rn * gg[3]);
                    *(v2u*)(dst + d) = wv; }
        } else {
            const int np = (n & ~12) | ((n & 4) << 1) | ((n & 8) >> 1);
            bf16* dst = (bf16*)(ws + WS_VCMPT) + (size_t)bg * 64 * 256 + np;
#pragma unroll
            for (int dt = 0; dt < 2; ++dt)
#pragma unroll
                for (int i = 0; i < 16; ++i) { const int d = 32 * dt + (i & 3) + 8 * (i >> 2) + 4 * hh; dst[(size_t)d * 256] = (bf16)f2bf(a2[dt][i]); }
        }
    }
    __syncthreads();
}

#define TSTAMP() __builtin_amdgcn_s_memrealtime()
namespace att {
typedef short bf16x8 __attribute__((ext_vector_type(8)));
typedef short s16x4 __attribute__((ext_vector_type(4)));
typedef float f32x16 __attribute__((ext_vector_type(16)));
typedef float f32x2_t __attribute__((ext_vector_type(2))); typedef __bf16 bf16x2_t __attribute__((ext_vector_type(2)));
constexpr int TILEB = 8192, NSLOT = 6;
constexpr int OFF_KV = 0, OFF_IMP = NSLOT * 2 * TILEB, OFF_MSK = OFF_IMP + 8 * 2048, ATT_LDS = OFF_MSK + 512;
constexpr float NEGBIG = -30000.f;
__device__ __forceinline__ unsigned cvtpk(float lo, float hi) { f32x2_t v = {lo, hi}; bf16x2_t b = __builtin_convertvector(v, bf16x2_t); return __builtin_bit_cast(unsigned, b); }
__device__ __forceinline__ int crow(int r, int hi) { return (r & 3) + 8 * (r >> 2) + 4 * hi; }
__device__ __forceinline__ float xhalf(float x) { return __shfl_xor(x, 32); }
constexpr int TR_D0 = 575, TR_N = 640, OFF_TR = 115712;
enum { FAR = 0, NEARS = 1, NEARW = 2, NEARC = 3 };
#define SBAR() __builtin_amdgcn_sched_barrier(0)
template <int MODE, bool CMP, bool MASKED>
__device__ __forceinline__ void tile(const LAS unsigned char* Kb, const LAS unsigned char* Vb, const bf16x8 (&qf)[4], bool rowsel, const LAS float* trh, int kidx0,
                                     f32x16 (&O)[2], float& l, float (&u)[2][4], float& carry, int r, int hh) {
    constexpr int ES = CMP ? 16 : 1;
    const LAS float* trb = trh + kidx0;
    f32x16 S[2];
    bf16x8 pf[2][2], kf[2][4], vf[4];
    float ls = 0.f;
    const unsigned pmask = rowsel ? 0xffffffffu : 0u;
#define ATT_B(a, i) do { float s_ = S[a][i]; const int e_ = ES * (32 * (a) + ((i) & 3) + 8 * ((i) >> 2)); \
        if (MODE == NEARS || MODE == NEARW) s_ += trb[e_]; \
        if (MODE == NEARC) { int k_ = kidx0 + e_; k_ = k_ < 0 ? 0 : (k_ < TR_N - 1 ? k_ : TR_N - 1); s_ += trh[k_]; } \
        float p_ = __builtin_amdgcn_exp2f(s_); \
        if (MODE == NEARW) p_ = (kidx0 + e_ >= TR_D0 - 511) ? p_ : 0.f; \
        S[a][i] = p_; ls += p_; } while (0)
#define ATT_B4(a, i0) do { ATT_B(a, (i0)); ATT_B(a, (i0) + 1); ATT_B(a, (i0) + 2); ATT_B(a, (i0) + 3); } while (0)
#define ATT_PACK(a) do { _Pragma("unroll") for (int s2 = 0; s2 < 2; ++s2) { v4u w_ = {cvtpk(S[a][8 * s2 + 0], S[a][8 * s2 + 1]), cvtpk(S[a][8 * s2 + 2], S[a][8 * s2 + 3]), cvtpk(S[a][8 * s2 + 4], S[a][8 * s2 + 5]), cvtpk(S[a][8 * s2 + 6], S[a][8 * s2 + 7])}; \
        if (MASKED) { w_.x &= pmask; w_.y &= pmask; w_.z &= pmask; w_.w &= pmask; } \
        pf[a][s2] = __builtin_bit_cast(bf16x8, w_); } } while (0)
#define ATT_U(a) do { if (CMP) { float rq_[4]; _Pragma("unroll") for (int q = 0; q < 4; ++q) rq_[q] = xhalf(S[a][4 * q + 3]); \
        _Pragma("unroll") for (int q = 0; q < 4; ++q) { const float own_ = (S[a][4 * q] + S[a][4 * q + 1]) + (S[a][4 * q + 2] + S[a][4 * q + 3]); \
            const float prev_ = hh ? rq_[q] : (q > 0 ? rq_[q - 1] : carry); u[a][q] = own_ + prev_; } carry = rq_[3]; } } while (0)
#define ATT_VRD(m, a) vf[m] = *(const LAS bf16x8*)(Vb + (32 * ((m) & 1) + r) * 128 + (((4 * (a) + 2 * ((m) >> 1) + hh) ^ (r & 7)) * 16))
    const f32x16 zero = {0.f, 0.f, 0.f, 0.f, 0.f, 0.f, 0.f, 0.f, 0.f, 0.f, 0.f, 0.f, 0.f, 0.f, 0.f, 0.f};
#pragma unroll
    for (int kk = 0; kk < 4; ++kk) kf[0][kk] = *(const LAS bf16x8*)(Kb + r * 128 + (((2 * kk + hh) ^ (r & 7)) * 16));
    SBAR();
#define ATT_KRD(kk) kf[1][kk] = *(const LAS bf16x8*)(Kb + (32 + r) * 128 + (((2 * (kk) + hh) ^ (r & 7)) * 16))
    S[0] = __builtin_amdgcn_mfma_f32_32x32x16_bf16(kf[0][0], qf[0], zero, 0, 0, 0); ATT_KRD(0); SBAR();
    S[0] = __builtin_amdgcn_mfma_f32_32x32x16_bf16(kf[0][1], qf[1], S[0], 0, 0, 0); ATT_KRD(1); SBAR();
    S[0] = __builtin_amdgcn_mfma_f32_32x32x16_bf16(kf[0][2], qf[2], S[0], 0, 0, 0); ATT_KRD(2); SBAR();
    S[0] = __builtin_amdgcn_mfma_f32_32x32x16_bf16(kf[0][3], qf[3], S[0], 0, 0, 0); ATT_KRD(3); SBAR();
#undef ATT_KRD
    S[1] = __builtin_amdgcn_mfma_f32_32x32x16_bf16(kf[1][0], qf[0], zero, 0, 0, 0); ATT_VRD(0, 0); ATT_B4(0, 0); SBAR();
    S[1] = __builtin_amdgcn_mfma_f32_32x32x16_bf16(kf[1][1], qf[1], S[1], 0, 0, 0); ATT_VRD(1, 0); ATT_B4(0, 4); SBAR();
    S[1] = __builtin_amdgcn_mfma_f32_32x32x16_bf16(kf[1][2], qf[2], S[1], 0, 0, 0); ATT_VRD(2, 0); ATT_B4(0, 8); SBAR();
    S[1] = __builtin_amdgcn_mfma_f32_32x32x16_bf16(kf[1][3], qf[3], S[1], 0, 0, 0); ATT_VRD(3, 0); ATT_B4(0, 12); SBAR();
    ATT_U(0); ATT_PACK(0); SBAR();
    O[0] = __builtin_amdgcn_mfma_f32_32x32x16_bf16(vf[0], pf[0][0], O[0], 0, 0, 0); ATT_VRD(0, 1); ATT_B4(1, 0); SBAR();
    O[1] = __builtin_amdgcn_mfma_f32_32x32x16_bf16(vf[1], pf[0][0], O[1], 0, 0, 0); ATT_VRD(1, 1); ATT_B4(1, 4); SBAR();
    O[0] = __builtin_amdgcn_mfma_f32_32x32x16_bf16(vf[2], pf[0][1], O[0], 0, 0, 0); ATT_VRD(2, 1); ATT_B4(1, 8); SBAR();
    O[1] = __builtin_amdgcn_mfma_f32_32x32x16_bf16(vf[3], pf[0][1], O[1], 0, 0, 0); ATT_VRD(3, 1); ATT_B4(1, 12); SBAR();
    ATT_U(1); ATT_PACK(1); SBAR();
    O[0] = __builtin_amdgcn_mfma_f32_32x32x16_bf16(vf[0], pf[1][0], O[0], 0, 0, 0);
    O[1] = __builtin_amdgcn_mfma_f32_32x32x16_bf16(vf[1], pf[1][0], O[1], 0, 0, 0);
    O[0] = __builtin_amdgcn_mfma_f32_32x32x16_bf16(vf[2], pf[1][1], O[0], 0, 0, 0);
    O[1] = __builtin_amdgcn_mfma_f32_32x32x16_bf16(vf[3], pf[1][1], O[1], 0, 0, 0);
    l += (MASKED && !rowsel) ? 0.f : ls;
#undef ATT_B
#undef ATT_B4
#undef ATT_PACK
#undef ATT_U
#undef ATT_VRD
}
#undef SBAR
}

__device__ __forceinline__ void attn_unit(Frame& F, const Args& A, int bg, int c, size_t ydst_off, unsigned long long& tacc) {
    using namespace att;
    unsigned char* ws = A.ws;
    int tid = F.tid; asm volatile("" : "+v"(tid));
    const int lane = tid & 63, w = F.wave, r = lane & 31, hh = lane >> 5, hg = r >> 3, qi = r & 7;
    const int b = bg >> 1, g = bg & 1, h = g * 4 + hg;
    const int t = 64 * c + 8 * w + qi; const size_t tok = (size_t)b * SEQ + t;
    LAS unsigned char* L = F.lds + RING_OFF;
    const LAS float* tblh = (const LAS float*)(F.lds + TBL_OFF) + h * 132;
    const LAS float* trh = (const LAS float*)(L + OFF_TR) + h * TR_N;
    bf16* Y = (bf16*)(ws + WS_Y);
    bf16* yrow = Y + tok * DM + 512 + h * 64;
    if (DBG_T == 60) tacc -= TSTAMP();
    bf16x8 qf[4];
#pragma unroll
    for (int kk = 0; kk < 4; ++kk) qf[kk] = *(const bf16x8*)(yrow + 16 * kk + 8 * hh);
    const int nc = (c >> 4) + 1, ns = c + 1, w0 = c > 8 ? c - 8 : 0, nw = c - w0 + 1, ntile = nc + ns + nw;
    const int srow = tid >> 3, sch = (tid & 7) ^ (srow & 7);
    const unsigned ldsw = (unsigned)w * 1024u;
#define ATT_DMA(i) do { const int i_ = (i); const bf16* kp_; const bf16* vp_; size_t ldv_; \
        if (i_ < nc) { kp_ = (const bf16*)(ws + WS_KCMP) + ((size_t)bg * 256 + 64 * i_) * 64; vp_ = (const bf16*)(ws + WS_VCMPT) + (size_t)bg * 64 * 256 + 64 * i_; ldv_ = 256; } \
        else if (i_ < nc + ns) { const int j_ = i_ - nc; kp_ = (const bf16*)(ws + WS_KS) + ((size_t)bg * SEQ + 64 * j_) * 64; vp_ = (const bf16*)(ws + WS_VST) + (size_t)bg * 64 * SEQ + 64 * j_; ldv_ = SEQ; } \
        else { const int j_ = w0 + i_ - nc - ns; kp_ = (const bf16*)(ws + WS_KW) + ((size_t)bg * SEQ + 64 * j_) * 64; vp_ = (const bf16*)(ws + WS_VWT) + (size_t)bg * 64 * SEQ + 64 * j_; ldv_ = SEQ; } \
        const int sl_ = ((i_ >> 1) % 3) * 2 + (i_ & 1); \
        __builtin_amdgcn_global_load_lds((const unsigned*)(kp_ + srow * 64 + sch * 8), (LAS unsigned*)(L + OFF_KV + sl_ * 2 * TILEB + ldsw), 16, 0, 0); \
        __builtin_amdgcn_global_load_lds((const unsigned*)(vp_ + (size_t)srow * ldv_ + sch * 8), (LAS unsigned*)(L + OFF_KV + sl_ * 2 * TILEB + TILEB + ldsw), 16, 0, 0); } while (0)
#define ATT_WAITN(n) do { const int n_ = (n); if (n_ >= 2) asm volatile("s_waitcnt vmcnt(4) lgkmcnt(0)" ::: "memory"); else if (n_ == 1) asm volatile("s_waitcnt vmcnt(2) lgkmcnt(0)" ::: "memory"); \
        else asm volatile("s_waitcnt vmcnt(0) lgkmcnt(0)" ::: "memory"); } while (0)
#define ATT_NEXT(i) do { if (((i) & 1) == 0) { if ((i) + 4 < ntile) ATT_DMA((i) + 4); if ((i) + 5 < ntile) ATT_DMA((i) + 5); } if (DBG_T == 1) tacc -= TSTAMP(); } while (0)
#define ATT_FLIP(i) do { if (DBG_T == 1) tacc += TSTAMP(); if ((((i) & 1) == 1) || (i) + 1 == ntile) { if (DBG_T == 2) tacc -= TSTAMP(); \
        const int s2_ = ((i) | 1) + 3; ATT_WAITN(s2_ + 1 < ntile ? 2 : (s2_ < ntile ? 1 : 0)); \
        __builtin_amdgcn_s_barrier(); asm volatile("" ::: "memory"); if (DBG_T == 2) tacc += TSTAMP(); } } while (0)
    ATT_DMA(0); if (ntile > 1) ATT_DMA(1); if (ntile > 2) ATT_DMA(2); if (ntile > 3) ATT_DMA(3);
    ATT_WAITN(ntile > 3 ? 2 : (ntile > 2 ? 1 : 0));
    __builtin_amdgcn_s_barrier(); asm volatile("" ::: "memory");
    asm volatile("" : "+v"(qf[0]), "+v"(qf[1]), "+v"(qf[2]), "+v"(qf[3]));
    if (DBG_T == 60) tacc += TSTAMP();
    f32x16 out[2], O[2];
#pragma unroll
    for (int i = 0; i < 16; ++i) { out[0][i] = 0.f; out[1][i] = 0.f; O[0][i] = 0.f; O[1][i] = 0.f; }
    float l = 0.f, carry = 0.f, dummy_u[2][4];
    int it = 0;
    float u[4][2][4];
#pragma unroll
    for (int i = 0; i < 4; ++i)
#pragma unroll
        for (int a = 0; a < 2; ++a)
#pragma unroll
            for (int q = 0; q < 4; ++q) u[i][a][q] = 0.f;
#pragma unroll
    for (int i = 0; i < 4; ++i) {
        if (i < nc) {
            ATT_NEXT(it);
            const LAS unsigned char* Kb = L + OFF_KV + (((it >> 1) % 3) * 2 + (it & 1)) * 2 * TILEB; const LAS unsigned char* Vb = Kb + TILEB;
            const bool far = 64 * c >= 1024 * i + 1167;
            if (far) tile<FAR, true, false>(Kb, Vb, qf, true, trh, 0, O, l, u[i], carry, r, hh);
            else tile<NEARC, true, false>(Kb, Vb, qf, true, trh, TR_D0 - t + 31 + 16 * (64 * i + 4 * hh), O, l, u[i], carry, r, hh);
            ATT_FLIP(it); ++it;
        }
    }
    unsigned long long mask;
    if (DBG_T == 61) tacc -= TSTAMP();
    {
        const float g0 = ((const float*)(ws + WS_GATES))[tok * 24 + h]; const float lt = l + xhalf(l); const float linv = lt > 0.f ? 1.f / lt : 0.f; const float sc = g0 * linv;
#pragma unroll
        for (int i = 0; i < 16; ++i) { out[0][i] += sc * O[0][i]; out[1][i] += sc * O[1][i]; O[0][i] = 0.f; O[1][i] = 0.f; }
        LAS float* impw = (LAS float*)(L + OFF_IMP + w * 2048);
#pragma unroll
        for (int i = 0; i < 4; ++i)
#pragma unroll
            for (int a = 0; a < 2; ++a)
#pragma unroll
                for (int q = 0; q < 4; ++q) {
                    float x = u[i][a][q] * linv;
                    x += __builtin_bit_cast(float, __builtin_amdgcn_update_dpp(0, __builtin_bit_cast(int, x), 0x128, 0xf, 0xf, false));
                    { const unsigned xb = __builtin_bit_cast(unsigned, x); auto pr = __builtin_amdgcn_permlane16_swap(xb, xb, false, false);
                      const unsigned p0 = pr[0], p1 = pr[1];
                      x = __builtin_bit_cast(float, p0) + __builtin_bit_cast(float, p1); }
                    const int j = 8 * (2 * i + a) + 2 * q + hh;
                    const bool forced = (j == 0) || (j == c) || (j == c - 1);
                    x = (j <= c) ? (forced ? 1e6f : x) : -1.f;
                    const unsigned bits = (__builtin_bit_cast(unsigned, x) & ~63u) | (unsigned)(63 - j);
                    impw[qi * 64 + j] = __builtin_bit_cast(float, bits);
                }
        LDS_WAIT(); asm volatile("" ::: "memory");
        const int q2 = lane >> 3, part = lane & 7;
        const LAS float* iq = impw + q2 * 64;
        float mine[8]; int cnt[8];
        { const f32x4 m0 = *(const LAS f32x4*)(iq + 8 * part), m1 = *(const LAS f32x4*)(iq + 8 * part + 4);
#pragma unroll
          for (int i = 0; i < 4; ++i) { mine[i] = m0[i]; mine[4 + i] = m1[i]; cnt[i] = 0; cnt[4 + i] = 0; } }
        unsigned byte = 0xffu;
        if (c >= 16) {
#pragma unroll 1
            for (int k = 0; 4 * k <= c; ++k) { const f32x4 v = *(const LAS f32x4*)(iq + 4 * k);
#pragma unroll
                for (int e = 0; e < 4; ++e)
#pragma unroll
                    for (int i = 0; i < 8; ++i) cnt[i] += (v[e] > mine[i]) ? 1 : 0; }
            byte = 0;
#pragma unroll
            for (int i = 0; i < 8; ++i) byte |= (cnt[i] < 16) ? (1u << i) : 0u;
        }
        LAS unsigned char* mw = (LAS unsigned char*)(L + OFF_MSK + w * 64);
        mw[q2 * 8 + part] = (unsigned char)byte;
        LDS_WAIT(); asm volatile("" ::: "memory");
        mask = *(const LAS unsigned long long*)(mw + qi * 8);
        l = 0.f;
    }
    if (DBG_T == 61) tacc += TSTAMP();
    unsigned long long uni = 0;
#pragma unroll
    for (int q = 0; q < 8; ++q) { uni |= (unsigned long long)(unsigned)__builtin_amdgcn_readlane((int)(unsigned)mask, q) | ((unsigned long long)(unsigned)__builtin_amdgcn_readlane((int)(unsigned)(mask >> 32), q) << 32); }
#pragma unroll 1
    for (int j = 0; j <= c; ++j) {
        ATT_NEXT(it);
        if ((uni >> j) & 1ull) {
            const LAS unsigned char* Kb = L + OFF_KV + (((it >> 1) % 3) * 2 + (it & 1)) * 2 * TILEB; const LAS unsigned char* Vb = Kb + TILEB;
            const bool rs = (mask >> j) & 1ull;
            if (j <= c - 3) tile<FAR, false, true>(Kb, Vb, qf, rs, trh, 0, O, l, dummy_u, carry, r, hh);
            else tile<NEARS, false, true>(Kb, Vb, qf, rs, trh, TR_D0 - t + 64 * j + 4 * hh, O, l, dummy_u, carry, r, hh);
        }
        ATT_FLIP(it); ++it;
    }
    {
        const float g1 = ((const float*)(ws + WS_GATES))[tok * 24 + 8 + h]; const float lt = l + xhalf(l); const float sc = lt > 0.f ? g1 / lt : 0.f;
#pragma unroll
        for (int i = 0; i < 16; ++i) { out[0][i] += sc * O[0][i]; out[1][i] += sc * O[1][i]; O[0][i] = 0.f; O[1][i] = 0.f; }
        l = 0.f;
    }
#pragma unroll 1
    for (int j = w0; j <= c; ++j) {
        ATT_NEXT(it);
        const LAS unsigned char* Kb = L + OFF_KV + (((it >> 1) % 3) * 2 + (it & 1)) * 2 * TILEB; const LAS unsigned char* Vb = Kb + TILEB;
        if (j <= c - 3 && j != c - 8) tile<FAR, false, false>(Kb, Vb, qf, true, trh, 0, O, l, dummy_u, carry, r, hh);
        else if (j == c - 8) tile<NEARW, false, false>(Kb, Vb, qf, true, trh, TR_D0 - t + 64 * j + 4 * hh, O, l, dummy_u, carry, r, hh);
        else tile<NEARS, false, false>(Kb, Vb, qf, true, trh, TR_D0 - t + 64 * j + 4 * hh, O, l, dummy_u, carry, r, hh);
        ATT_FLIP(it); ++it;
    }
    if (DBG_T == 50 || DBG_T == 51) {
        f32x16 Ox[2] = {O[0], O[1]}; float lx = 0.f;
        if (DBG_T == 50 || w < 4) {
            tacc -= TSTAMP();
#pragma unroll 1
            for (int rep = 0; rep < 128; ++rep) tile<FAR, false, true>(L + OFF_KV, L + OFF_KV + TILEB, qf, (mask >> (rep & 63)) & 1ull, trh, 0, Ox, lx, dummy_u, carry, r, hh);
            tacc += TSTAMP();
        }
        asm volatile("" :: "v"(Ox[0]), "v"(Ox[1]), "v"(lx));
    }
    {
        const float g2 = ((const float*)(ws + WS_GATES))[tok * 24 + 16 + h]; const float lt = l + xhalf(l); const float sc = lt > 0.f ? g2 / lt : 0.f;
#pragma unroll
        for (int i = 0; i < 16; ++i) { out[0][i] += sc * O[0][i]; out[1][i] += sc * O[1][i]; }
    }
    if (DBG_T == 62) tacc -= TSTAMP();
    bf16* yout = (bf16*)(ws + WS_Y) + tok * DM + 512 + h * 64;
#pragma unroll
    for (int dt = 0; dt < 2; ++dt)
#pragma unroll
        for (int q = 0; q < 4; ++q) { v2u wv; wv.x = cvtpk(out[dt][4 * q], out[dt][4 * q + 1]); wv.y = cvtpk(out[dt][4 * q + 2], out[dt][4 * q + 3]);
            *(v2u*)((bf16*)((unsigned char*)yout + ydst_off) + 32 * dt + 8 * q + 4 * hh) = wv; }
    __syncthreads();
    if (DBG_T == 62) tacc += TSTAMP();
#undef ATT_DMA
#undef ATT_WAITN
#undef ATT_NEXT
#undef ATT_FLIP
}

__global__ void __launch_bounds__(NWAVES * 64, 2) mk_fwd(Args args) {
    extern __shared__ __attribute__((aligned(16))) unsigned char lds[];
    Frame F;
    F.lds = (LAS unsigned char*)lds;
    F.MISC = (volatile LAS unsigned*)(F.lds + MISC_OFF);
    F.tid = threadIdx.x; F.lane = F.tid & 63; F.wave = __builtin_amdgcn_readfirstlane(F.tid >> 6);
    F.G = gridDim.x; { const int bx = blockIdx.x; F.vcu = (F.G % 8 == 0) ? (bx % 8) * (F.G / 8) + bx / 8 : bx; }
    unsigned char* ws = args.ws;
    F.ctl = (gu32*)(ws + WS_CTL);
    for (int u = F.tid; u < (LDS_BYTES - LDSCTL_OFF) / 4; u += NWAVES * 64) ((LAS unsigned*)(F.lds + LDSCTL_OFF))[u] = 0u;
    __syncthreads();
    if (F.tid < 128) { const int n = F.tid; int bkt = n;
        if (n >= 16) { const float nf = (float)n; int large = 16 + (int)(logf(nf / 16.f) / logf(8.f) * 16.f); bkt = large < 31 ? large : 31; }
        ((LAS unsigned char*)(F.lds + TB_OFF))[n] = (unsigned char)bkt; }
    __syncthreads();
    for (int e = F.tid; e < 8 * 129; e += NWAVES * 64) { const int hh_ = e / 129, x = e % 129; const int bk = x < 128 ? ((LAS unsigned char*)(F.lds + TB_OFF))[x] : 31;
        ((LAS float*)(F.lds + TBL_OFF))[hh_ * 132 + x] = args.in[17][hh_ * 32 + bk] * 1.4426950408889634f; }
    __syncthreads();
    XcdBarrier bar; bar.bar = (unsigned*)(F.ctl + CW_BAR) + args.li * XCD_BAR_WORDS; bar.x = 0; bar.st = nullptr;
    if (N_LAUNCHES != PER_PHASE) bar = xcd_barrier_post((unsigned*)(F.ctl + CW_BAR) + args.li * XCD_BAR_WORDS, F.MISC + 8);
#define GRID_BAR() do { if (N_LAUNCHES != PER_PHASE) xcd_barrier(bar); } while (0)
    const int lo = args.ph_lo, hi = args.ph_hi;
#define IN(k) (lo <= (k) && (k) < hi)
#define BOTH(k) (IN(k) && IN((k) + 1))
    bf16* XB = (bf16*)(ws + WS_XB); bf16* ACT = (bf16*)(ws + WS_ACT); bf16* Y = (bf16*)(ws + WS_Y);
    float* SS0 = (float*)(ws + WS_SS0); float* SS1 = (float*)(ws + WS_SS1); float* SS2 = (float*)(ws + WS_SS2); float* SS3 = (float*)(ws + WS_SS3);

    unsigned long long tacc = 0;
#define PT0(k) do { if (DBG_T == 10 + (k)) tacc -= TSTAMP(); if (DBG_T == 30 + (k)) tacc += TSTAMP(); } while (0)
#define PT1(k) do { if (DBG_T == 10 + (k)) tacc += TSTAMP(); if (DBG_T == 31 + (k)) tacc -= TSTAMP(); } while (0)
    if (IN(0)) { PT0(0); NREP(0) p0_prologue(F, args); PT1(0); if (BOTH(0)) GRID_BAR(); }
    if (IN(1)) {
        PT0(1);
        pg8::Gemm g{XB, (const bf16*)(ws + WS_WGU1), MTOK, NGU, DM, DM, DM}; pg8::StaticOrder S; S.init(MTOK, NGU, F.G, (int)blockIdx.x);
        EpiSwiGLU E{SS0, ACT};
        NREP(1) pg8::gemm_phase<EpiSwiGLU, pg8::StaticOrder, true, true>(F.lds + RING_OFF, g, S, E);
        PT1(1);
        if (BOTH(1)) GRID_BAR();
    }
    if (IN(2)) {
        PT0(2);
        pg8::Gemm g{ACT, (const bf16*)(ws + WS_WD1), MTOK, DM, DFF, DFF, DFF}; pg8::StaticOrder S; S.init(MTOK, DM, F.G, (int)blockIdx.x);
        EpiResid E{args.in[0], args.out, XB, SS1, 0.5f};
        NREP(2) pg8::gemm_phase<EpiResid, pg8::StaticOrder, true, true>(F.lds + RING_OFF, g, S, E);
        PT1(2);
        if (BOTH(2)) GRID_BAR();
    }
    if (IN(3)) {
        PT0(3);
        pg8::Gemm g{XB, (const bf16*)(ws + WS_WIN), MTOK, NIN, DM, DM, DM}; pg8::StaticOrder S; S.init(MTOK, NIN, F.G, (int)blockIdx.x);
        EpiMix E{SS1, ws, args.in[10], args.in[11]};
        NREP(3) pg8::gemm_phase<EpiMix, pg8::StaticOrder, true, true>(F.lds + RING_OFF, g, S, E);
        PT1(3);
        if (BOTH(3)) GRID_BAR();
    }
    if (IN(4)) {
        PT0(4);
        for (int u = F.vcu; u < 256; u += F.G) cmp_unit(F, args, u);
        for (int u = F.vcu; u < 256; u += F.G) gmlp_unit(F, args, u);
        PT1(4);
        if (BOTH(4)) GRID_BAR();
    }
    if (IN(5)) {
        PT0(5);
        if (DBG_T == 3) tacc -= TSTAMP();
        if (DBG_T == 63) tacc -= TSTAMP();
        {
            LAS float* TR = (LAS float*)(F.lds + RING_OFF + att::OFF_TR); const LAS float* tbl = (const LAS float*)(F.lds + TBL_OFF);
            for (int e = F.tid; e < 8 * att::TR_N; e += NWAVES * 64) { const int hh_ = e / att::TR_N, k = e % att::TR_N, dist = att::TR_D0 - k;
                TR[e] = dist < 0 ? att::NEGBIG : tbl[hh_ * 132 + (dist < 128 ? dist : 128)] - tbl[hh_ * 132 + 128]; }
            __syncthreads();
        }
        if (DBG_T == 63) tacc += TSTAMP();
#if DBG_REP == 5
#pragma unroll 1
        for (int n = F.vcu; n < NBG * 64; n += F.G) { const int v = n & 255, i = n >> 8, x = v >> 5, lv = v & 31; attn_unit(F, args, 2 * x + (i & 1), i < 2 ? 63 - lv : lv, (size_t)(300 - 120) * MiB, tacc); }
#endif
        if (F.G % 8 == 0) {
            const int x = (int)blockIdx.x & 7; gu32* head = F.ctl + CW_Q + 64 * x;
#pragma unroll 1
            for (;;) {
                if (F.tid == 0) F.MISC[0] = __hip_atomic_fetch_add(head, 1u, RLX_AGENT);
                __syncthreads(); const int u = (int)F.MISC[0]; __syncthreads();
                if (u >= 128) break;
                attn_unit(F, args, 2 * x + (u & 1), 63 - (u >> 1), (size_t)0, tacc);
            }
        } else {
#pragma unroll 1
            for (int n = (int)blockIdx.x; n < NBG * 64; n += F.G) attn_unit(F, args, n & 15, 63 - (n >> 4), (size_t)0, tacc);
        }
        if (DBG_T == 3) tacc += TSTAMP();
        PT1(5);
        if (BOTH(5)) GRID_BAR();
    }
    if (IN(6)) {
        PT0(6);
        pg8::Gemm g{Y, (const bf16*)(ws + WS_WOUT), MTOK, DM, DM, DM, DM}; pg8::StaticOrder S; S.init(MTOK, DM, F.G, (int)blockIdx.x);
        EpiResid E{args.out, args.out, XB, SS2, 1.0f};
        pg8::gemm_phase<EpiResid, pg8::StaticOrder, true, true>(F.lds + RING_OFF, g, S, E);
        PT1(6);
        if (BOTH(6)) GRID_BAR();
    }
    if (IN(7)) {
        PT0(7);
        pg8::Gemm g{XB, (const bf16*)(ws + WS_WGU2), MTOK, NGU, DM, DM, DM}; pg8::StaticOrder S; S.init(MTOK, NGU, F.G, (int)blockIdx.x);
        EpiSwiGLU E{SS2, ACT};
        pg8::gemm_phase<EpiSwiGLU, pg8::StaticOrder, true, true>(F.lds + RING_OFF, g, S, E);
        PT1(7);
        if (BOTH(7)) GRID_BAR();
    }
    if (IN(8)) {
        PT0(8);
        pg8::Gemm g{ACT, (const bf16*)(ws + WS_WD2), MTOK, DM, DFF, DFF, DFF}; pg8::StaticOrder S; S.init(MTOK, DM, F.G, (int)blockIdx.x);
        EpiResid E{args.out, args.out, nullptr, SS3, 0.5f};
        pg8::gemm_phase<EpiResid, pg8::StaticOrder, true, true>(F.lds + RING_OFF, g, S, E);
        PT1(8);
        if (BOTH(8)) GRID_BAR();
    }
    if (IN(9)) {
        PT0(9);
        int tid9 = threadIdx.x; asm volatile("" : "+v"(tid9)); const int lane9 = tid9 & 63;
        const int gw = F.vcu * NWAVES + F.wave, NGW = F.G * NWAVES; const float* gf = args.in[23];
        for (int m = gw; m < MTOK; m += NGW) {
            float s = (lane9 < 16) ? SS3[(size_t)m * 16 + lane9] : 0.f; s = wave_sum(s);
            const float ri = rsq_acc(s, 1.f / DM);
            GAS f32x4* xr = (GAS f32x4*)(args.out + (size_t)m * DM) + lane9;
#pragma unroll
            for (int j = 0; j < 4; ++j) { f32x4 v = xr[64 * j]; const f32x4 gg = *((const f32x4*)gf + lane9 + 64 * j); v = v * ri * gg; xr[64 * j] = v; }
        }
        PT1(9);
    }
    if (DBG_T != 0) { __syncthreads(); if (F.lane == 0) { F.MISC[16 + 2 * F.wave] = (unsigned)tacc; F.MISC[17 + 2 * F.wave] = (unsigned)(tacc >> 32); } __syncthreads();
        if (blockIdx.x == 0 && F.tid == 0) { const unsigned long long tw = (unsigned long long)F.MISC[16 + 2 * (DBG_TW)] | ((unsigned long long)F.MISC[17 + 2 * (DBG_TW)] << 32);
            const unsigned long long t0 = TSTAMP(); while (TSTAMP() - t0 < 16ull * tw) __builtin_amdgcn_s_sleep(8); } }
#undef IN
#undef BOTH
#undef GRID_BAR
}

extern "C" void kernel_launch(void* const* d_in, const int* in_sizes, int n_in, void* d_out, int out_size, void* d_ws, size_t ws_size, hipStream_t stream) {
    static int grid = 0;
    if (grid == 0) {
        if (n_in != 24 || in_sizes[0] != MTOK * DM || out_size != MTOK * DM || ws_size < WS_END) { fprintf(stderr, "kernel_launch: unexpected shapes (n_in %d, in0 %d, out %d, ws %zu)\n", n_in, n_in > 0 ? in_sizes[0] : -1, out_size, ws_size); grid = -1; return; }
        int dev = 0, cus = 0, per_cu = 0;
        if (hipGetDevice(&dev) != hipSuccess || hipDeviceGetAttribute(&cus, hipDeviceAttributeMultiprocessorCount, dev) != hipSuccess) { grid = -1; return; }
        if (hipFuncSetAttribute((const void*)mk_fwd, hipFuncAttributeMaxDynamicSharedMemorySize, LDS_BYTES) != hipSuccess) { fprintf(stderr, "kernel_launch: hipFuncSetAttribute failed\n"); grid = -1; return; }
        if (hipOccupancyMaxActiveBlocksPerMultiprocessor(&per_cu, (const void*)mk_fwd, NWAVES * 64, LDS_BYTES) != hipSuccess || per_cu < 1) { fprintf(stderr, "kernel_launch: occupancy query says %d blocks per CU\n", per_cu); (void)hipGetLastError(); grid = -1; return; }
        grid = cus;
    }
    if (grid < 0) return;
    (void)hipMemsetAsync((char*)d_ws + WS_CTL, 0, CTL_ZERO_BYTES, stream);
    Args a{};
    for (int i = 0; i < 24; ++i) a.in[i] = (const float*)d_in[i];
    a.out = (float*)d_out; a.ws = (unsigned char*)d_ws;
    if (N_LAUNCHES == 1) {
        a.ph_lo = 0; a.ph_hi = PER_PHASE; a.li = 0;
        void* kargs[] = {&a};
        hipError_t e = hipLaunchCooperativeKernel((const void*)mk_fwd, dim3(grid), dim3(NWAVES * 64), kargs, LDS_BYTES, stream);
        if (e != hipSuccess) fprintf(stderr, "kernel_launch: cooperative launch failed: %s (grid %d)\n", hipGetErrorString(e), grid);
    } else {
        for (int li = 0; li < PER_PHASE; ++li) { a.ph_lo = li; a.ph_hi = li + 1; a.li = 0;
            hipLaunchKernelGGL(mk_fwd, dim3(grid), dim3(NWAVES * 64), LDS_BYTES, stream, a); }
    }
}
```

```cpp
#include <hip/hip_runtime.h>
#include <cstdio>
#include <cstdint>

#ifndef DBG_REP
#define DBG_REP -1
#endif
#ifndef DBG_TW
#define DBG_TW 0
#endif
#ifndef DBG_FIX
#define DBG_FIX 0
#endif
#ifndef DBG_T
#define DBG_T 0
#endif
#define NREP(k) for (int rep_ = 0; rep_ < ((DBG_REP) == (k) ? 2 : 1); ++rep_)
#ifndef MK_N_LAUNCHES
#define MK_N_LAUNCHES 1
#endif

namespace pg8 {
#define PG8_LAS __attribute__((address_space(3)))
typedef unsigned short bf16_t;
typedef short bf16x8 __attribute__((ext_vector_type(8)));
typedef float f32x4 __attribute__((ext_vector_type(4)));
typedef unsigned u32x4 __attribute__((ext_vector_type(4)));
typedef unsigned u32x2 __attribute__((ext_vector_type(2)));
constexpr int BM = 256, BK = 64, HALF = 128, HTB = HALF * BK * 2, STAGE_BYTES = 8 * HTB, NXCD = 8, WGM = 8;

__host__ __device__ __forceinline__ int lds_byte(int r, int c) { const int st = (r >> 4) * 2 + (c >> 5), rr = r & 15, cc = c & 31, ob = rr * 64 + cc * 2; return st * 1024 + (ob ^ (((ob >> 9) & 1) << 5)); }
__host__ __device__ __forceinline__ void stage_rc(int b, int& R, int& C) { const int st = b / 1024, sb = b % 1024, swz = sb ^ (((sb >> 9) & 1) << 5); R = (st >> 1) * 16 + swz / 64; C = (st & 1) * 32 + (swz % 64) / 2; }
__host__ __device__ __forceinline__ int perm32(int rho) { const int n = rho >> 4, i = rho & 15; return 8 * (i >> 2) + 4 * n + (i & 3); }

struct Unit { int pm, pn, am, bn; };
struct Gemm { const bf16_t* A; const bf16_t* Bt; int M, N, K, lda, ldb; };

struct StaticOrder {
    int nM, nN, nwg, G, c, fixed;
    __host__ __device__ void init(int M, int N, int G_, int c_) { nM = M / BM; nN = N / BM; nwg = nM * nN; G = G_; c = c_; fixed = 0; }
    __host__ __device__ bool next(int i, Unit& u) const {
        const long L = (long)i * G + c; if (L >= nwg) return false;
        int wgid = (int)L; { const int q = nwg / NXCD, r = nwg % NXCD, xcd = wgid % NXCD, off = wgid / NXCD; wgid = (xcd < r ? xcd * (q + 1) : r * (q + 1) + (xcd - r) * q) + off; }
        const int nig = WGM * nN, gid = wgid / nig, fm = gid * WGM, gsz = (nM - fm) < WGM ? (nM - fm) : WGM;
        u.pm = fm + ((wgid % nig) % gsz); u.pn = (wgid % nig) / gsz; u.am = fixed ? 0 : u.pm; u.bn = fixed ? 0 : u.pn; return true;
    }
};
struct CmpOrder {
    int c;
    __device__ bool next(int i, Unit& u) const { if (i != 0 || c >= 32) return false; u.pm = c; u.pn = c >> 4; u.am = u.pm; u.bn = u.pn; return true; }
};

__device__ __forceinline__ unsigned cvt_pk_bf16(float lo, float hi) { unsigned r; asm volatile("v_cvt_pk_bf16_f32 %0, %1, %2" : "=v"(r) : "v"(lo), "v"(hi)); return r; }

template <class Epi, class Sched, bool ALIGN_EPI = false, bool SP2 = false>
__device__ __forceinline__ void gemm_phase(PG8_LAS unsigned char* lds, const Gemm g, const Sched& S, const Epi& E) {
    const int tid = threadIdx.x, wid = __builtin_amdgcn_readfirstlane(tid >> 6), lane = tid & 63, wr = wid >> 2, wc = wid & 3, fr = lane & 15, fq = lane >> 4;
    const int K = g.K, nt = K / BK;
    unsigned voffA[2], voffB[2];
#pragma unroll
    for (int i = 0; i < 2; ++i) { int R, C; stage_rc(tid * 16 + i * 8192, R, C); const int Rb = Epi::PERM ? ((R & ~31) + perm32(R & 31)) : R;
        voffA[i] = (unsigned)(R * g.lda + C) * 2u; voffB[i] = (unsigned)(Rb * g.ldb + C) * 2u; }
    const size_t kstep = (size_t)(BK * 2);
    const size_t hstepA = (size_t)HALF * g.lda * 2, hstepB = (size_t)HALF * g.ldb * 2;
    const size_t tstepA = 2 * hstepA, tstepB = 2 * hstepB;
    const unsigned ldsw = (unsigned)wid * 1024u;
    const int aoff = lds_byte(wr * 64 + fr, fq * 8), boff = lds_byte(wc * 32 + fr, fq * 8);
#define PG8_SA(b, h) (((b) * 2 + (h)) * HTB)
#define PG8_SB(b, h) ((4 + (b) * 2 + (h)) * HTB)
#define PG8_STAGE(bufoff, gbase, voff) do { _Pragma("unroll") for (int _i = 0; _i < 2; ++_i) \
        __builtin_amdgcn_global_load_lds((const unsigned*)((const char*)(gbase) + (voff)[_i]), (PG8_LAS unsigned*)(lds + (bufoff) + ldsw + _i * 8192), 16, 0, 0); } while (0)
#define PG8_LDA(dst, b, h) do { _Pragma("unroll") for (int m = 0; m < 4; ++m) _Pragma("unroll") for (int k = 0; k < 2; ++k) dst[m][k] = *(const PG8_LAS bf16x8*)(lds + PG8_SA(b, h) + aoff + m * 2048 + k * 1024); } while (0)
#define PG8_LDB(dst, b, h) do { _Pragma("unroll") for (int n = 0; n < 2; ++n) _Pragma("unroll") for (int k = 0; k < 2; ++k) dst[n][k] = *(const PG8_LAS bf16x8*)(lds + PG8_SB(b, h) + boff + n * 2048 + k * 1024); } while (0)
#define PG8_MMA(ai, bj, At, Bt) do { __builtin_amdgcn_s_setprio(1); _Pragma("unroll") for (int m = 0; m < 4; ++m) _Pragma("unroll") for (int n = 0; n < 2; ++n) _Pragma("unroll") for (int k = 0; k < 2; ++k) \
        acc[ai][bj][m][n] = __builtin_amdgcn_mfma_f32_16x16x32_bf16(Bt[n][k], At[m][k], acc[ai][bj][m][n], 0, 0, 0); __builtin_amdgcn_s_setprio(0); } while (0)
#define PG8_WAIT_V(n) asm volatile("s_waitcnt vmcnt(" #n ")" ::: "memory")
#define PG8_WAIT_L(n) asm volatile("s_waitcnt lgkmcnt(" #n ")" ::: "memory")
#define PG8_BAR __builtin_amdgcn_s_barrier()
#define PG8_SCHED __builtin_amdgcn_sched_barrier(0)
    Unit cur, nxt; int ui = 0;
    if (!S.next(0, cur)) return;
    f32x4 acc[2][2][4][2];
#pragma unroll
    for (int a = 0; a < 2; ++a)
#pragma unroll
        for (int b = 0; b < 2; ++b)
#pragma unroll
            for (int m = 0; m < 4; ++m)
#pragma unroll
                for (int n = 0; n < 2; ++n) acc[a][b][m][n] = (f32x4){0.f, 0.f, 0.f, 0.f};
    bf16x8 At[4][2], B0[2][2], B1[2][2];
    const char* cA = (const char*)g.A + (size_t)cur.am * tstepA; const char* cB = (const char*)g.Bt + (size_t)cur.bn * tstepB;
    if constexpr (SP2) {
        PG8_STAGE(PG8_SB(0, 0), cB, voffB); PG8_STAGE(PG8_SB(0, 1), cB + hstepB, voffB); PG8_STAGE(PG8_SA(0, 0), cA, voffA); PG8_STAGE(PG8_SA(0, 1), cA + hstepA, voffA);
        if (wr == 1) PG8_BAR;
        PG8_WAIT_V(2); PG8_BAR;
        PG8_STAGE(PG8_SB(1, 0), cB + kstep, voffB); PG8_STAGE(PG8_SA(1, 0), cA + kstep, voffA); PG8_STAGE(PG8_SB(1, 1), cB + hstepB + kstep, voffB);
        PG8_WAIT_V(6); PG8_BAR;
    } else {
        PG8_STAGE(PG8_SB(0, 0), cB, voffB); PG8_STAGE(PG8_SA(0, 0), cA, voffA); PG8_STAGE(PG8_SB(0, 1), cB + hstepB, voffB); PG8_STAGE(PG8_SA(0, 1), cA + hstepA, voffA);
        if (wr == 1) PG8_BAR;
        PG8_WAIT_V(4); PG8_BAR;
        PG8_STAGE(PG8_SB(1, 0), cB + kstep, voffB); PG8_STAGE(PG8_SA(1, 0), cA + kstep, voffA); PG8_STAGE(PG8_SB(1, 1), cB + hstepB + kstep, voffB);
        PG8_WAIT_V(6); PG8_BAR;
    }
    for (;;) {
        const bool has_next = S.next(ui + 1, nxt);
        const char* nA = has_next ? (const char*)g.A + (size_t)nxt.am * tstepA : cA; const char* nB = has_next ? (const char*)g.Bt + (size_t)nxt.bn * tstepB : cB;
        for (int t = 0; t < nt; t += 2) {
            const bool last = (t == nt - 2);
            const char* a1 = cA + (size_t)(t + 1) * kstep;
            const char* a2 = last ? nA : cA + (size_t)(t + 2) * kstep; const char* b2 = last ? nB : cB + (size_t)(t + 2) * kstep;
            const char* a3 = a2 + kstep; const char* b3 = b2 + kstep;
            if constexpr (SP2) {
            PG8_LDB(B0, 0, 0); PG8_LDB(B1, 0, 1); PG8_SCHED; PG8_LDA(At, 0, 0); PG8_STAGE(PG8_SA(1, 1), a1 + hstepA, voffA);
            PG8_WAIT_V(8); PG8_WAIT_L(0); PG8_BAR; PG8_MMA(0, 0, At, B0); PG8_MMA(0, 1, At, B1); PG8_BAR; PG8_SCHED;
            PG8_LDA(At, 0, 1); PG8_STAGE(PG8_SB(0, 0), b2, voffB); PG8_STAGE(PG8_SB(0, 1), b2 + hstepB, voffB); PG8_STAGE(PG8_SA(0, 0), a2, voffA);
            PG8_WAIT_V(8); PG8_WAIT_L(0); PG8_BAR; PG8_MMA(1, 0, At, B0); PG8_MMA(1, 1, At, B1); PG8_BAR; PG8_SCHED;
            PG8_LDB(B0, 1, 0); PG8_LDB(B1, 1, 1); PG8_SCHED; PG8_LDA(At, 1, 0); PG8_STAGE(PG8_SA(0, 1), a2 + hstepA, voffA);
            PG8_WAIT_V(8); PG8_WAIT_L(0); PG8_BAR; PG8_MMA(0, 0, At, B0); PG8_MMA(0, 1, At, B1); PG8_BAR; PG8_SCHED;
            PG8_LDA(At, 1, 1); PG8_STAGE(PG8_SB(1, 0), b3, voffB); PG8_STAGE(PG8_SB(1, 1), b3 + hstepB, voffB); PG8_STAGE(PG8_SA(1, 0), a3, voffA);
            PG8_WAIT_V(8); PG8_WAIT_L(0); PG8_BAR; PG8_MMA(1, 0, At, B0); PG8_MMA(1, 1, At, B1); PG8_BAR; PG8_SCHED;
            } else {
            PG8_LDB(B0, 0, 0); PG8_SCHED; PG8_LDA(At, 0, 0); PG8_STAGE(PG8_SA(1, 1), a1 + hstepA, voffA);
            PG8_WAIT_L(8); PG8_BAR; PG8_WAIT_L(0); PG8_MMA(0, 0, At, B0); PG8_BAR; PG8_SCHED;
            PG8_LDB(B1, 0, 1); PG8_STAGE(PG8_SB(0, 0), b2, voffB);
            PG8_BAR; PG8_WAIT_L(0); PG8_MMA(0, 1, At, B1); PG8_BAR;
            PG8_LDA(At, 0, 1); PG8_STAGE(PG8_SA(0, 0), a2, voffA);
            PG8_BAR; PG8_WAIT_L(0); PG8_MMA(1, 0, At, B0); PG8_BAR; PG8_SCHED;
            PG8_STAGE(PG8_SB(0, 1), b2 + hstepB, voffB);
            PG8_WAIT_V(6); PG8_BAR; PG8_MMA(1, 1, At, B1); PG8_BAR;
            PG8_LDB(B0, 1, 0); PG8_SCHED; PG8_LDA(At, 1, 0); PG8_STAGE(PG8_SA(0, 1), a2 + hstepA, voffA);
            PG8_WAIT_L(8); PG8_BAR; PG8_WAIT_L(0); PG8_MMA(0, 0, At, B0); PG8_BAR; PG8_SCHED;
            PG8_LDB(B1, 1, 1); PG8_STAGE(PG8_SB(1, 0), b3, voffB);
            PG8_BAR; PG8_WAIT_L(0); PG8_MMA(0, 1, At, B1); PG8_BAR;
            PG8_LDA(At, 1, 1); PG8_STAGE(PG8_SA(1, 0), a3, voffA);
            PG8_BAR; PG8_WAIT_L(0); PG8_MMA(1, 0, At, B0); PG8_BAR; PG8_SCHED;
            PG8_STAGE(PG8_SB(1, 1), b3 + hstepB, voffB);
            PG8_WAIT_V(6); PG8_BAR; PG8_MMA(1, 1, At, B1); PG8_BAR;
            }
        }
        if constexpr (ALIGN_EPI) { if (wr == 0) PG8_BAR; }
        E(acc, cur, wr, wc, fr, fq);
        if (!has_next) break;
#pragma unroll
        for (int a = 0; a < 2; ++a)
#pragma unroll
            for (int b = 0; b < 2; ++b)
#pragma unroll
                for (int m = 0; m < 4; ++m)
#pragma unroll
                    for (int n = 0; n < 2; ++n) acc[a][b][m][n] = (f32x4){0.f, 0.f, 0.f, 0.f};
        cur = nxt; cA = nA; cB = nB; ++ui;
        if constexpr (ALIGN_EPI) { if (wr == 1) PG8_BAR; }
    }
    PG8_WAIT_V(0);
    if constexpr (!ALIGN_EPI) { if (wr == 0) PG8_BAR; }
    PG8_BAR;
#undef PG8_SA
#undef PG8_SB
#undef PG8_STAGE
#undef PG8_LDA
#undef PG8_LDB
#undef PG8_MMA
#undef PG8_WAIT_V
#undef PG8_WAIT_L
#undef PG8_BAR
#undef PG8_SCHED
}
}

constexpr int NWAVES = 8;
constexpr int BATCH = 8, SEQ = 4096, DM = 1024, MTOK = BATCH * SEQ;
constexpr int DFF = 2816, NGU = 2 * DFF, INC = 2328, NIN = 2560;
constexpr int HD = 64, NBG = 16, NCMP = 255;
constexpr float EPS = 1e-6f;
constexpr int PER_PHASE = 10;
constexpr int N_LAUNCHES = MK_N_LAUNCHES;

constexpr size_t MiB = 1u << 20;
constexpr size_t WS_CTL = 0, CTL_ZERO_BYTES = 1 * MiB;
constexpr size_t WS_WGU1 = 2 * MiB, WS_WD1 = 13 * MiB, WS_WGU2 = 19 * MiB, WS_WD2 = 30 * MiB, WS_WIN = 36 * MiB, WS_WOUT = 41 * MiB, WS_CW1 = 43 * MiB;
constexpr size_t WS_WSB = 45 * MiB, WS_CB1P = 45 * MiB + 512 * 1024, WS_CW2 = 45 * MiB + 768 * 1024;
constexpr size_t WS_SS0 = 46 * MiB, WS_SS1 = 48 * MiB, WS_SS2 = 50 * MiB, WS_SS3 = 52 * MiB, WS_SSV = 54 * MiB;
constexpr size_t WS_XB = 56 * MiB;
constexpr size_t WS_ACT = 120 * MiB;
constexpr size_t WS_Y = 120 * MiB, WS_GVT = 184 * MiB, WS_KCR = 216 * MiB, WS_VCR = 224 * MiB, WS_KS = 232 * MiB, WS_VST = 240 * MiB, WS_KW = 248 * MiB, WS_VWT = 256 * MiB;
constexpr size_t WS_GATES = 264 * MiB, WS_H1 = 268 * MiB, WS_KCMP = 272 * MiB, WS_VCMPT = 272 * MiB + 512 * 1024;
constexpr size_t WS_END = 296 * MiB;
constexpr int CW_BAR = 4096;
constexpr int CW_Q = 8192;

constexpr int RING_OFF = 0, RING_BYTES = 147456;
constexpr int LDSCTL_OFF = RING_BYTES, MISC_OFF = LDSCTL_OFF + 320;
constexpr int TB_OFF = LDSCTL_OFF + 1024;
constexpr int TBL_OFF = LDSCTL_OFF + 2048;
constexpr int LDS_BYTES = 163840;

#define GAS __attribute__((address_space(1)))
#define LAS __attribute__((address_space(3)))
typedef unsigned short bf16;
typedef unsigned v4u __attribute__((ext_vector_type(4)));
typedef unsigned v2u __attribute__((ext_vector_type(2)));
typedef float f32x4 __attribute__((ext_vector_type(4)));
typedef GAS unsigned gu32;
#define RLX_AGENT __ATOMIC_RELAXED, __HIP_MEMORY_SCOPE_AGENT
#define LDS_WAIT() asm volatile("s_waitcnt lgkmcnt(0)" ::: "memory")
#define VM_WAIT() asm volatile("s_waitcnt vmcnt(0)" ::: "memory")
__device__ __forceinline__ unsigned f2bf(float f) { unsigned u = __builtin_bit_cast(unsigned, f); return (u + 0x7fffu + ((u >> 16) & 1u)) >> 16; }
__device__ __forceinline__ unsigned pk2(float lo, float hi) { return f2bf(lo) | (f2bf(hi) << 16); }
__device__ __forceinline__ float bf2f(unsigned short b) { return __builtin_bit_cast(float, (unsigned)b << 16); }
__device__ __forceinline__ float wave_sum(float v) {
#pragma unroll
    for (int o = 1; o < 64; o <<= 1) v += __shfl_xor(v, o);
    return v;
}
__device__ __forceinline__ float wave_max(float v) {
#pragma unroll
    for (int o = 1; o < 64; o <<= 1) v = fmaxf(v, __shfl_xor(v, o));
    return v;
}
__device__ __forceinline__ float gelu_tanh(float x) { const float u2 = 1.5957691216057308f * (x + 0.044715f * x * x * x); return x / (1.f + __expf(-u2)); }
__device__ __forceinline__ float sigmoidf_(float x) { return 1.f / (1.f + __expf(-x)); }

#define XB_TMO      128
#define XB_XCNT(j)  (256  + 64 * (j))
#define XB_XSUB(j)  (1280 + 64 * (j))
#define XB_XGEN(j)  (2304 + 64 * (j))
#define XB_TOP      3328
#define XB_TOPGEN   3392
#define XCD_BAR_WORDS 3456
#define XB_SPIN_CAP (1u << 22)
__device__ __forceinline__ unsigned xb_ld(unsigned* p)              { return __hip_atomic_load(p, __ATOMIC_RELAXED, __HIP_MEMORY_SCOPE_AGENT); }
__device__ __forceinline__ unsigned xb_add(unsigned* p, unsigned v) { return __hip_atomic_fetch_add(p, v, __ATOMIC_RELAXED, __HIP_MEMORY_SCOPE_AGENT); }
__device__ __forceinline__ unsigned xb_xcc_id() { return (unsigned)__builtin_amdgcn_s_getreg((3 << 11) | 20) & 0xFu; }
#define XB_SPIN(cond, bar) do { unsigned _sp = 0; while (cond) { __builtin_amdgcn_s_sleep(1); \
    if ((++_sp & 255u) == 0u) { if (xb_ld(&(bar)[XB_TMO])) break; if (_sp > XB_SPIN_CAP) { atomicAdd(&(bar)[XB_TMO], 1u); break; } } } } while (0)
struct XcdBarrier { unsigned* bar; unsigned x; volatile LAS unsigned* st; };
__device__ __forceinline__ XcdBarrier xcd_barrier_post(unsigned* bar, volatile LAS unsigned* st) {
    XcdBarrier b; b.bar = bar; b.x = xb_xcc_id(); b.st = st;
    if (threadIdx.x == 0) (void)xb_add(&bar[XB_XCNT(b.x)], 1u);
    return b;
}
__device__ __forceinline__ void xcd_barrier_complete(unsigned* bar, unsigned x, unsigned& nloc, unsigned& nx) {
    const unsigned G = gridDim.x * gridDim.y * gridDim.z;
    unsigned sum, cnt, mine, sp = 0u;
    for (;;) {
        sum = 0u; cnt = 0u; mine = 0u;
#pragma unroll
        for (unsigned j = 0; j < 16; ++j) { const unsigned c = xb_ld(&bar[XB_XCNT(j)]); sum += c; cnt += (c > 0u) ? 1u : 0u; mine = (j == x) ? c : mine; }
        if (sum == G) break;
        __builtin_amdgcn_s_sleep(1);
        if ((++sp & 255u) == 0u) { if (xb_ld(&bar[XB_TMO])) break; if (sp > XB_SPIN_CAP) { atomicAdd(&bar[XB_TMO], 1u); break; } }
    }
    nloc = mine > 0u ? mine : 1u; nx = cnt > 0u ? cnt : 1u;
}
__device__ __forceinline__ void xcd_barrier(const XcdBarrier& b) {
    asm volatile("s_waitcnt vmcnt(0)" ::: "memory");
    __syncthreads();
    if (threadIdx.x == 0) {
        unsigned* bar = b.bar;
        __builtin_amdgcn_s_waitcnt(0);
        unsigned nloc = b.st[0], nx = b.st[1];
        if (nloc == 0u) { xcd_barrier_complete(bar, b.x, nloc, nx); b.st[0] = nloc; b.st[1] = nx; }
        const unsigned old = xb_add(&bar[XB_XSUB(b.x)], 1u);
        const unsigned gen = old / nloc;
        if (old + 1u == (gen + 1u) * nloc) {
            __builtin_amdgcn_fence(__ATOMIC_RELEASE, "agent");
            asm volatile("s_waitcnt vmcnt(0)" ::: "memory");
            const unsigned og = xb_add(&bar[XB_TOP], 1u);
            const unsigned tg = og / nx;
            if (og + 1u == (tg + 1u) * nx) xb_add(&bar[XB_TOPGEN], 1u);
            else XB_SPIN(xb_ld(&bar[XB_TOPGEN]) == tg, bar);
            __builtin_amdgcn_fence(__ATOMIC_ACQUIRE, "agent");
            xb_add(&bar[XB_XGEN(b.x)], 1u);
            asm volatile("s_waitcnt vmcnt(0)" ::: "memory");
        } else {
            XB_SPIN(xb_ld(&bar[XB_XGEN(b.x)]) == gen, bar);
            __builtin_amdgcn_fence(__ATOMIC_ACQUIRE, "agent");
            asm volatile("s_waitcnt vmcnt(0)" ::: "memory");
        }
    }
    __syncthreads();
}

__device__ __forceinline__ float row_rinv(const float* ss, int row, int fq) {
    const f32x4 p = *(const f32x4*)(ss + (size_t)row * 16 + 4 * fq);
    float s = (p[0] + p[1]) + (p[2] + p[3]);
    s += __shfl_xor(s, 16); s += __shfl_xor(s, 32);
    return __builtin_amdgcn_rsqf(s * (1.f / DM) + EPS);
}
__device__ __forceinline__ float rsq_acc(float s, float invn) { return 1.0f / sqrtf(s * invn + EPS); }

struct EpiSwiGLU {
    static constexpr bool PERM = true;
    const float* ss; bf16* act;
    __device__ __forceinline__ void operator()(const f32x4 (&acc)[2][2][4][2], const pg8::Unit& u, int wr, int wc, int fr, int fq) const {
#pragma unroll
        for (int ai = 0; ai < 2; ++ai)
#pragma unroll
            for (int m = 0; m < 4; ++m) {
                const int row = u.pm * 256 + ai * 128 + wr * 64 + m * 16 + fr;
                const float ri = row_rinv(ss, row, fq);
                float o[8];
#pragma unroll
                for (int n = 0; n < 2; ++n)
#pragma unroll
                    for (int i = 0; i < 4; ++i) { const float g = acc[ai][0][m][n][i] * ri, up = acc[ai][1][m][n][i] * ri; o[n * 4 + i] = g * sigmoidf_(g) * up; }
                v4u w; w.x = pk2(o[0], o[1]); w.y = pk2(o[2], o[3]); w.z = pk2(o[4], o[5]); w.w = pk2(o[6], o[7]);
                *(v4u*)(act + (size_t)row * DFF + u.pn * 128 + wc * 32 + fq * 8) = w;
            }
    }
};
struct EpiResid {
    static constexpr bool PERM = false;
    const float* basef; const bf16* baseb; float* outf; bf16* outb; float* ssp; float scale;
    __device__ __forceinline__ void operator()(const f32x4 (&acc)[2][2][4][2], const pg8::Unit& u, int wr, int wc, int fr, int fq) const {
#pragma unroll
        for (int ai = 0; ai < 2; ++ai)
#pragma unroll
            for (int m = 0; m < 4; ++m) {
                const int row = u.pm * 256 + ai * 128 + wr * 64 + m * 16 + fr;
                float sq = 0.f;
#pragma unroll
                for (int bj = 0; bj < 2; ++bj)
#pragma unroll
                    for (int n = 0; n < 2; ++n) {
                        const size_t off = (size_t)row * DM + u.pn * 256 + bj * 128 + wc * 32 + n * 16 + fq * 4;
                        f32x4 b;
                        if (basef) b = *(const f32x4*)(basef + off);
                        else { const v2u rb = *(const v2u*)(baseb + off); b = (f32x4){__builtin_bit_cast(float, rb.x << 16), __builtin_bit_cast(float, rb.x & 0xffff0000u), __builtin_bit_cast(float, rb.y << 16), __builtin_bit_cast(float, rb.y & 0xffff0000u)}; }
                        const f32x4 o = b + acc[ai][bj][m][n] * scale;
                        if (outf) *(f32x4*)(outf + off) = o;
                        if (outb) { v2u w; w.x = pk2(o[0], o[1]); w.y = pk2(o[2], o[3]); *(v2u*)(outb + off) = w; }
                        sq += (o[0] * o[0] + o[1] * o[1]) + (o[2] * o[2] + o[3] * o[3]);
                    }
                sq += __shfl_xor(sq, 16); sq += __shfl_xor(sq, 32);
                if (fq == 0) ssp[(size_t)row * 16 + u.pn * 4 + wc] = sq;
            }
    }
};
struct EpiMix {
    static constexpr bool PERM = true;
    const float* ss; unsigned char* ws; const float* qg; const float* kg;
    __device__ __forceinline__ void operator()(const f32x4 (&acc)[2][2][4][2], const pg8::Unit& u, int wr, int wc, int fr, int fq) const {
        const int pn = u.pn;
        bf16* const Y = (bf16*)(ws + WS_Y); bf16* const GVT = (bf16*)(ws + WS_GVT); float* const SSV = (float*)(ws + WS_SSV); bf16* const KCR = (bf16*)(ws + WS_KCR); bf16* const VCR = (bf16*)(ws + WS_VCR);
        bf16* const KS = (bf16*)(ws + WS_KS); bf16* const VST = (bf16*)(ws + WS_VST); bf16* const KW = (bf16*)(ws + WS_KW); bf16* const VWT = (bf16*)(ws + WS_VWT); float* const GATES = (float*)(ws + WS_GATES);
        float gn[2][2][4];
        const float* gsrc = nullptr;
        if (pn == 4 || pn == 5) gsrc = qg; else if (pn == 7 && wc < 2) gsrc = kg + 64; else if (pn == 8 && wc < 2) gsrc = kg + 128;
#pragma unroll
        for (int bj = 0; bj < 2; ++bj)
#pragma unroll
            for (int n = 0; n < 2; ++n)
#pragma unroll
                for (int i = 0; i < 4; ++i) gn[bj][n][i] = gsrc ? gsrc[32 * bj + 8 * fq + 4 * n + i] : 1.f;
#pragma unroll
        for (int ai = 0; ai < 2; ++ai)
#pragma unroll
            for (int m = 0; m < 4; ++m) {
                const int row = u.pm * 256 + ai * 128 + wr * 64 + m * 16 + fr;
                const int b = row >> 12, t = row & 4095;
                const float ri = row_rinv(ss, row, fq);
                float v[2][2][4];
#pragma unroll
                for (int bj = 0; bj < 2; ++bj)
#pragma unroll
                    for (int n = 0; n < 2; ++n)
#pragma unroll
                        for (int i = 0; i < 4; ++i) v[bj][n][i] = acc[ai][bj][m][n][i] * ri;
                if (pn < 4) {
                    float sq = 0.f;
#pragma unroll
                    for (int bj = 0; bj < 2; ++bj)
#pragma unroll
                        for (int n = 0; n < 2; ++n)
#pragma unroll
                            for (int i = 0; i < 4; ++i) { const float x = gelu_tanh(v[bj][n][i]); v[bj][n][i] = x; sq += x * x; }
                    if (pn < 2) {
#pragma unroll
                        for (int bj = 0; bj < 2; ++bj) { v4u w; w.x = pk2(v[bj][0][0], v[bj][0][1]); w.y = pk2(v[bj][0][2], v[bj][0][3]); w.z = pk2(v[bj][1][0], v[bj][1][1]); w.w = pk2(v[bj][1][2], v[bj][1][3]);
                            *(v4u*)(Y + (size_t)row * DM + pn * 256 + wc * 64 + bj * 32 + fq * 8) = w; }
                    } else {
                        const int h = (pn - 2) * 4 + wc;
                        bf16* dst = GVT + ((size_t)(b * 8 + h) * 64) * SEQ + t;
#pragma unroll
                        for (int bj = 0; bj < 2; ++bj)
#pragma unroll
                            for (int n = 0; n < 2; ++n)
#pragma unroll
                                for (int i = 0; i < 4; ++i) dst[(size_t)(32 * bj + 8 * fq + 4 * n + i) * SEQ] = (bf16)f2bf(v[bj][n][i]);
                        sq += __shfl_xor(sq, 16); sq += __shfl_xor(sq, 32);
                        if (fq == 0) SSV[(size_t)row * 8 + (pn - 2) * 4 + wc] = sq;
                    }
                } else if (pn < 9) {
                    const bool is_q = (pn == 4 || pn == 5);
                    const bool is_k = (wc < 2);
                    const bool normed = is_q || ((pn == 7 || pn == 8) && is_k);
                    if (normed) {
                        float sq = 0.f;
#pragma unroll
                        for (int bj = 0; bj < 2; ++bj)
#pragma unroll
                            for (int n = 0; n < 2; ++n)
#pragma unroll
                                for (int i = 0; i < 4; ++i) sq += v[bj][n][i] * v[bj][n][i];
                        sq += __shfl_xor(sq, 16); sq += __shfl_xor(sq, 32);
                        const float rh = rsq_acc(sq, 1.f / 64.f) * (is_q ? 0.125f * 1.4426950408889634f : 1.f);
#pragma unroll
                        for (int bj = 0; bj < 2; ++bj)
#pragma unroll
                            for (int n = 0; n < 2; ++n)
#pragma unroll
                                for (int i = 0; i < 4; ++i) v[bj][n][i] *= rh * gn[bj][n][i];
                    }
                    if (is_q || is_k) {
                        bf16* dst;
                        if (is_q) dst = Y + (size_t)row * DM + 512 + (pn - 4) * 256 + wc * 64;
                        else { bf16* kb = (pn == 6) ? KCR : (pn == 7) ? KS : KW; dst = kb + ((size_t)(b * 2 + wc) * SEQ + t) * 64; }
#pragma unroll
                        for (int bj = 0; bj < 2; ++bj) { v4u w; w.x = pk2(v[bj][0][0], v[bj][0][1]); w.y = pk2(v[bj][0][2], v[bj][0][3]); w.z = pk2(v[bj][1][0], v[bj][1][1]); w.w = pk2(v[bj][1][2], v[bj][1][3]);
                            *(v4u*)(dst + bj * 32 + fq * 8) = w; }
                    } else if (pn == 6) {
                        bf16* dst = VCR + ((size_t)(b * 2 + (wc - 2)) * SEQ + t) * 64;
#pragma unroll
                        for (int bj = 0; bj < 2; ++bj) { v4u w; w.x = pk2(v[bj][0][0], v[bj][0][1]); w.y = pk2(v[bj][0][2], v[bj][0][3]); w.z = pk2(v[bj][1][0], v[bj][1][1]); w.w = pk2(v[bj][1][2], v[bj][1][3]);
                            *(v4u*)(dst + bj * 32 + fq * 8) = w; }
                    } else {
                        bf16* vb = (pn == 7) ? VST : VWT;
                        const int tp = (t & ~12) | ((t & 4) << 1) | ((t & 8) >> 1);
                        bf16* dst = vb + ((size_t)(b * 2 + (wc - 2)) * 64) * SEQ + tp;
#pragma unroll
                        for (int bj = 0; bj < 2; ++bj)
#pragma unroll
                            for (int n = 0; n < 2; ++n)
#pragma unroll
                                for (int i = 0; i < 4; ++i) dst[(size_t)(32 * bj + 8 * fq + 4 * n + i) * SEQ] = (bf16)f2bf(v[bj][n][i]);
                    }
                } else {
                    if (wc == 0 && fq < 3) {
                        f32x4 g0, g1;
#pragma unroll
                        for (int i = 0; i < 4; ++i) { g0[i] = sigmoidf_(v[0][0][i]); g1[i] = sigmoidf_(v[0][1][i]); }
                        *(f32x4*)(GATES + (size_t)row * 24 + fq * 8) = g0; *(f32x4*)(GATES + (size_t)row * 24 + fq * 8 + 4) = g1;
                    }
                }
            }
    }
};
struct EpiNone { static constexpr bool PERM = false;
    __device__ __forceinline__ void operator()(const f32x4 (&acc)[2][2][4][2], const pg8::Unit&, int, int, int, int) const {
#pragma unroll
        for (int a = 0; a < 2; ++a)
#pragma unroll
            for (int b = 0; b < 2; ++b)
#pragma unroll
                for (int m = 0; m < 4; ++m) asm volatile("" :: "v"(acc[a][b][m][0]), "v"(acc[a][b][m][1])); } };
struct EpiCmp {
    static constexpr bool PERM = true;
    const float* cb1p; bf16* H1;
    __device__ __forceinline__ void operator()(const f32x4 (&acc)[2][2][4][2], const pg8::Unit& u, int wr, int wc, int fr, int fq) const {
        float bias[2][2][4];
#pragma unroll
        for (int bj = 0; bj < 2; ++bj)
#pragma unroll
            for (int n = 0; n < 2; ++n)
#pragma unroll
                for (int i = 0; i < 4; ++i) { const int col = u.pn * 256 + bj * 128 + wc * 32 + fq * 8 + n * 4 + i; float s = 0.f;
#pragma unroll
                    for (int p = 0; p < 8; ++p) s += cb1p[p * 512 + col];
                    bias[bj][n][i] = s; }
#pragma unroll
        for (int ai = 0; ai < 2; ++ai)
#pragma unroll
            for (int m = 0; m < 4; ++m) {
                const int row = u.pm * 256 + ai * 128 + wr * 64 + m * 16 + fr;
#pragma unroll
                for (int bj = 0; bj < 2; ++bj) { float o[8];
#pragma unroll
                    for (int n = 0; n < 2; ++n)
#pragma unroll
                        for (int i = 0; i < 4; ++i) o[n * 4 + i] = gelu_tanh(acc[ai][bj][m][n][i] + bias[bj][n][i]);
                    v4u w; w.x = pk2(o[0], o[1]); w.y = pk2(o[2], o[3]); w.z = pk2(o[4], o[5]); w.w = pk2(o[6], o[7]);
                    *(v4u*)(H1 + (size_t)row * 256 + bj * 128 + wc * 32 + fq * 8) = w; }
            }
    }
};

struct Frame {
    LAS unsigned char* lds; volatile LAS unsigned* MISC; gu32* ctl;
    int tid, lane, wave, vcu, G;
};
struct Args { const float* in[24]; float* out; unsigned char* ws; int ph_lo, ph_hi, li, pad; };

__device__ __forceinline__ void p0_tr_item(const float* W, int ldw, int K, const float* gain, bf16* WT, int n0d, int sc0, int nv0, int sc1, int nv1, int kb, LAS float* scr, int lane) {
    const int k0 = 64 * kb, c16 = lane & 15, half = c16 >> 3, cc = (c16 & 7) * 4;
    const int sc = half ? sc1 : sc0, nv = half ? nv1 : nv0;
#pragma unroll 8
    for (int i = 0; i < 16; ++i) { const int kk = 4 * i + (lane >> 4);
        f32x4 x = {0.f, 0.f, 0.f, 0.f};
        if (cc < nv) { x = *(const f32x4*)(W + (size_t)(k0 + kk) * ldw + sc + cc); if (gain) x = x * gain[k0 + kk]; }
        *(LAS f32x4*)(scr + kk * 68 + c16 * 4) = x; }
    LDS_WAIT(); asm volatile("" ::: "memory");
#pragma unroll
    for (int kc = 0; kc < 8; ++kc) { const LAS float* sp = scr + (8 * kc) * 68 + lane;
        v4u o; o.x = pk2(sp[0 * 68], sp[1 * 68]); o.y = pk2(sp[2 * 68], sp[3 * 68]); o.z = pk2(sp[4 * 68], sp[5 * 68]); o.w = pk2(sp[6 * 68], sp[7 * 68]);
        *(GAS v4u*)(WT + (size_t)(n0d + lane) * K + k0 + 8 * kc) = o; }
    LDS_WAIT(); asm volatile("" ::: "memory");
}

__device__ __forceinline__ void p0_prologue(Frame& F, const Args& A) {
    unsigned char* ws = A.ws;
    LAS float* scr = (LAS float*)(F.lds + RING_OFF + F.wave * 17408);
    const int gw = F.vcu * NWAVES + F.wave, NGW = F.G * NWAVES, lane = F.lane;
    constexpr int I_GU = (DM / 64) * (NGU / 64), I_D = (DFF / 64) * (DM / 64), I_IN = (DM / 64) * (NIN / 64), I_OUT = (DM / 64) * (DM / 64), I_C1 = 2 * (2048 / 64) * (256 / 64);
    constexpr int I_WS = 8 * 128 * 128 / 64 / 8;
    constexpr int I_CB = 64, I_C2 = 64;
    constexpr int NITEMS = 2 * I_GU + 2 * I_D + I_IN + I_OUT + I_C1 + I_WS + I_CB + I_C2;
    for (int it = gw; it < NITEMS; it += NGW) {
        int r = it;
        if (r < 2 * I_GU) {
            const int f = r / I_GU; r -= f * I_GU; const int nblk = NGU / 64, kb = r / nblk, nb = r % nblk, n0 = 64 * nb, pn = n0 >> 8, bj = (n0 >> 7) & 1, j = n0 & 127;
            const float* W = f ? (bj ? A.in[21] : A.in[20]) : (bj ? A.in[3] : A.in[2]);
            p0_tr_item(W, DFF, DM, f ? A.in[19] : A.in[1], (bf16*)(ws + (f ? WS_WGU2 : WS_WGU1)), n0, 128 * pn + j, 32, 128 * pn + j + 32, 32, kb, scr, lane); continue; }
        r -= 2 * I_GU;
        if (r < 2 * I_D) {
            const int f = r / I_D; r -= f * I_D; const int nblk = DM / 64, kb = r / nblk, nb = r % nblk;
            p0_tr_item(f ? A.in[22] : A.in[4], DM, DFF, nullptr, (bf16*)(ws + (f ? WS_WD2 : WS_WD1)), 64 * nb, 64 * nb, 32, 64 * nb + 32, 32, kb, scr, lane); continue; }
        r -= 2 * I_D;
        if (r < I_IN) {
            const int nblk = NIN / 64, kb = r / nblk, nb = r % nblk, n0 = 64 * nb, pn = n0 >> 8, tc = n0 & 255;
            const int col0 = 256 * pn + 64 * ((tc >> 5) & 3) + 32 * (tc >> 7), col1 = 256 * pn + 64 * (((tc + 32) >> 5) & 3) + 32 * ((tc + 32) >> 7);
            int nv0 = INC - col0; nv0 = nv0 < 0 ? 0 : (nv0 > 32 ? 32 : nv0); int nv1 = INC - col1; nv1 = nv1 < 0 ? 0 : (nv1 > 32 ? 32 : nv1);
            p0_tr_item(A.in[6], INC, DM, A.in[5], (bf16*)(ws + WS_WIN), n0, col0, nv0, col1, nv1, kb, scr, lane); continue; }
        r -= I_IN;
        if (r < I_OUT) { const int nblk = DM / 64, kb = r / nblk, nb = r % nblk;
            p0_tr_item(A.in[18], DM, DM, nullptr, (bf16*)(ws + WS_WOUT), 64 * nb, 64 * nb, 32, 64 * nb + 32, 32, kb, scr, lane); continue; }
        r -= I_OUT;
        if (r < I_C1) { const int kv = r / (I_C1 / 2); r -= kv * (I_C1 / 2); const int nblk = 256 / 64, kb = r / nblk, nb = r % nblk;
            p0_tr_item(A.in[13] + (size_t)kv * 2048 * 256, 256, 2048, nullptr, (bf16*)(ws + WS_CW1) + (size_t)kv * 256 * 2048, 64 * nb, 64 * nb, 32, 64 * nb + 32, 32, kb, scr, lane); continue; }
        r -= I_C1;
        if (r < I_WS) {
            const int e0 = (r * 64 + lane) * 8; const int s0 = e0 & 127, t = (e0 >> 7) & 127;
            const float* src = A.in[8] + e0; unsigned o[4];
#pragma unroll
            for (int i = 0; i < 4; ++i) { const float a = (s0 + 2 * i <= t) ? src[2 * i] : 0.f, b2 = (s0 + 2 * i + 1 <= t) ? src[2 * i + 1] : 0.f; o[i] = pk2(a, b2); }
            *(v4u*)((bf16*)(ws + WS_WSB) + e0) = (v4u){o[0], o[1], o[2], o[3]}; continue; }
        r -= I_WS;
        if (r >= I_CB) {
            r -= I_CB; const int e0 = (r * 64 + lane) * 8, kv = e0 >> 14, d = (e0 >> 8) & 63, j0 = e0 & 255;
            const float* src = A.in[15] + (size_t)kv * 256 * 64 + d; unsigned o[4];
#pragma unroll
            for (int i = 0; i < 4; ++i) o[i] = pk2(src[(size_t)(j0 + 2 * i) * 64], src[(size_t)(j0 + 2 * i + 1) * 64]);
            *(v4u*)((bf16*)(ws + WS_CW2) + e0) = (v4u){o[0], o[1], o[2], o[3]}; continue; }
        {
            const int kp = r & 7, jb = (r >> 3) & 3, kv = r >> 5, j = jb * 64 + lane;
            const float* pe = A.in[12] + (size_t)kv * 2048; const float* w1 = A.in[13] + (size_t)kv * 2048 * 256;
            float s = (kp == 0) ? A.in[14][kv * 256 + j] : 0.f;
            for (int k = kp * 256; k < kp * 256 + 256; ++k) s += pe[k] * w1[(size_t)k * 256 + j];
            ((float*)(ws + WS_CB1P))[kp * 512 + kv * 256 + j] = s;
        }
    }
    const float* x = A.in[0]; bf16* XB = (bf16*)(ws + WS_XB); float* SS0 = (float*)(ws + WS_SS0);
    for (int m0 = 2 * gw; m0 < MTOK; m0 += 2 * NGW) {
        f32x4 v[2][4];
#pragma unroll
        for (int rr = 0; rr < 2; ++rr) { const GAS f32x4* xr = (const GAS f32x4*)(x + (size_t)(m0 + rr) * DM) + lane;
#pragma unroll
            for (int j = 0; j < 4; ++j) v[rr][j] = xr[64 * j]; }
#pragma unroll
        for (int rr = 0; rr < 2; ++rr) { GAS unsigned long long* o8 = (GAS unsigned long long*)(XB + (size_t)(m0 + rr) * DM) + lane; float sq = 0.f;
#pragma unroll
            for (int j = 0; j < 4; ++j) { const f32x4 t = v[rr][j]; sq += (t.x * t.x + t.y * t.y) + (t.z * t.z + t.w * t.w);
                o8[64 * j] = (unsigned long long)pk2(t.x, t.y) | ((unsigned long long)pk2(t.z, t.w) << 32); }
            sq = wave_sum(sq);
            if (lane < 16) SS0[(size_t)(m0 + rr) * 16 + lane] = (lane == 0) ? sq : 0.f; }
    }
}

__device__ __forceinline__ void gmlp_unit(Frame& F, const Args& A, int unit) {
    typedef short bf16x8 __attribute__((ext_vector_type(8)));
    typedef float f32x16 __attribute__((ext_vector_type(16)));
    unsigned char* ws = A.ws;
    const int b = unit >> 5, c = unit & 31, r0 = b * SEQ + c * 128, tid = F.tid, lane = F.lane, w = F.wave, r = lane & 31, hh = lane >> 5, tt = w >> 1, dt = w & 1;
    LAS unsigned char* L = F.lds + RING_OFF;
    LAS float* rv = (LAS float*)(L + 131072); LAS float* gvl = rv + 128; LAS float* bsl = gvl + 512;
    { const float* SSV = (const float*)(ws + WS_SSV);
      if (tid < 128) { const f32x4 p0 = *(const f32x4*)(SSV + (size_t)(r0 + tid) * 8), p1 = *(const f32x4*)(SSV + (size_t)(r0 + tid) * 8 + 4);
          rv[tid] = rsq_acc(((p0[0] + p0[1]) + (p0[2] + p0[3])) + ((p1[0] + p1[1]) + (p1[2] + p1[3])), 1.f / 512.f); }
      gvl[tid] = A.in[7][tid]; bsl[tid] = A.in[9][tid]; bsl[512 + tid] = A.in[9][512 + tid]; }
    asm volatile("s_waitcnt vmcnt(0) lgkmcnt(0)" ::: "memory");
    __syncthreads();
    const bf16* GVT = (const bf16*)(ws + WS_GVT) + ((size_t)(b * 8) * 64) * SEQ + c * 128;
    const bf16* WSB = (const bf16*)(ws + WS_WSB);
    bf16* Y = (bf16*)(ws + WS_Y) + (size_t)r0 * DM;
#define GM_DMA(h) do { const int h_ = (h); LAS unsigned char* B_ = L + (h_ & 1) * 65536; \
        _Pragma("unroll") for (int q_ = 0; q_ < 2; ++q_) { const int d_ = 4 * (2 * w + q_) + (lane >> 4), cs_ = (lane & 15) ^ (d_ & 15); \
            __builtin_amdgcn_global_load_lds((const unsigned*)(GVT + ((size_t)h_ * 64 + d_) * SEQ + 8 * cs_), (LAS unsigned*)(B_ + (2 * w + q_) * 1024), 16, 0, 0); } \
        _Pragma("unroll") for (int q_ = 0; q_ < 4; ++q_) { const int t_ = 4 * (4 * w + q_) + (lane >> 4), cs_ = (lane & 15) ^ (t_ & 15); \
            __builtin_amdgcn_global_load_lds((const unsigned*)(WSB + ((size_t)h_ * 128 + t_) * 128 + 8 * cs_), (LAS unsigned*)(B_ + 16384 + (4 * w + q_) * 1024), 16, 0, 0); } \
        _Pragma("unroll") for (int q_ = 0; q_ < 2; ++q_) { const int t_ = 8 * (2 * w + q_) + (lane >> 3), cs_ = (lane & 7) ^ (t_ & 7); \
            __builtin_amdgcn_global_load_lds((const unsigned*)(Y + (size_t)t_ * DM + h_ * 64 + 8 * cs_), (LAS unsigned*)(B_ + 49152 + (2 * w + q_) * 1024), 16, 0, 0); } } while (0)
    GM_DMA(0);
#pragma unroll 1
    for (int h = 0; h < 8; ++h) {
        if (h + 1 < 8) { GM_DMA(h + 1); asm volatile("s_waitcnt vmcnt(8)" ::: "memory"); } else asm volatile("s_waitcnt vmcnt(0)" ::: "memory");
        __builtin_amdgcn_s_barrier(); asm volatile("" ::: "memory");
        const LAS unsigned char* B = L + (h & 1) * 65536;
        f32x16 acc;
#pragma unroll
        for (int i = 0; i < 16; ++i) acc[i] = 0.f;
        const int d = 32 * dt + r, t = 32 * tt + r;
#pragma unroll
        for (int ks = 0; ks < 8; ++ks) {
            if (ks <= 2 * tt + 1) {
                const int s0 = 16 * ks + 8 * hh;
                const v4u raw = *(const LAS v4u*)(B + d * 256 + (((2 * ks + hh) ^ (d & 15)) * 16));
                const f32x4 ra = *(const LAS f32x4*)(rv + s0), rb = *(const LAS f32x4*)(rv + s0 + 4);
                v4u o; o.x = pk2(__builtin_bit_cast(float, raw.x << 16) * ra[0], __builtin_bit_cast(float, raw.x & 0xffff0000u) * ra[1]);
                o.y = pk2(__builtin_bit_cast(float, raw.y << 16) * ra[2], __builtin_bit_cast(float, raw.y & 0xffff0000u) * ra[3]);
                o.z = pk2(__builtin_bit_cast(float, raw.z << 16) * rb[0], __builtin_bit_cast(float, raw.z & 0xffff0000u) * rb[1]);
                o.w = pk2(__builtin_bit_cast(float, raw.w << 16) * rb[2], __builtin_bit_cast(float, raw.w & 0xffff0000u) * rb[3]);
                const bf16x8 wf = *(const LAS bf16x8*)(B + 16384 + t * 256 + (((2 * ks + hh) ^ (t & 15)) * 16));
                acc = __builtin_amdgcn_mfma_f32_32x32x16_bf16(__builtin_bit_cast(bf16x8, o), wf, acc, 0, 0, 0);
            }
        }
        {
            const float bt = bsl[h * 128 + t];
            LAS unsigned char* U = L + (h & 1) * 65536 + 49152 + t * 128;
#pragma unroll
            for (int q = 0; q < 4; ++q) { const int dd = 32 * dt + 8 * q + 4 * hh; LAS v2u* up = (LAS v2u*)(U + (((4 * dt + q) ^ (t & 7)) * 16) + 8 * hh);
                const f32x4 gg = *(const LAS f32x4*)(gvl + h * 64 + dd); const v2u uu = *up;
                const float o0 = __builtin_bit_cast(float, uu.x << 16) * (acc[4 * q] * gg[0] + bt), o1 = __builtin_bit_cast(float, uu.x & 0xffff0000u) * (acc[4 * q + 1] * gg[1] + bt);
                const float o2 = __builtin_bit_cast(float, uu.y << 16) * (acc[4 * q + 2] * gg[2] + bt), o3 = __builtin_bit_cast(float, uu.y & 0xffff0000u) * (acc[4 * q + 3] * gg[3] + bt);
                *up = (v2u){pk2(o0, o1), pk2(o2, o3)}; }
        }
        asm volatile("s_waitcnt lgkmcnt(0)" ::: "memory"); __builtin_amdgcn_s_barrier(); asm volatile("" ::: "memory");
#pragma unroll
        for (int i = 0; i < 2; ++i) { const int e = tid + 512 * i, tr = e >> 3, pp = e & 7, cs = pp ^ (tr & 7);
            const v4u val = *(const LAS v4u*)(L + (h & 1) * 65536 + 49152 + tr * 128 + pp * 16);
            *(v4u*)(Y + (size_t)tr * DM + h * 64 + 8 * cs) = val; }
        asm volatile("s_waitcnt lgkmcnt(0)" ::: "memory"); __builtin_amdgcn_s_barrier(); asm volatile("" ::: "memory");
    }
#undef GM_DMA
    asm volatile("s_waitcnt vmcnt(0)" ::: "memory");
    __syncthreads();
}
__device__ __forceinline__ void cmp_unit(Frame& F, const Args& A, int unit) {
    typedef short bf16x8 __attribute__((ext_vector_type(8)));
    typedef float f32x16 __attribute__((ext_vector_type(16)));
    unsigned char* ws = A.ws;
    const int tid = F.tid, lane = F.lane, w = F.wave, r = lane & 31, hh = lane >> 5;
    const int row0 = unit * 32, kv = row0 >> 12;
    LAS unsigned char* L = F.lds + RING_OFF;
    const bf16* X = (const bf16*)(ws + WS_KCR) + (size_t)row0 * 1024;
#pragma unroll
    for (int i = 0; i < 9; ++i) { const int pos = 512 * i + tid; if (i < 8 || w < 2) { const int Fc = pos ^ ((pos >> 7) & 7);
        __builtin_amdgcn_global_load_lds((const unsigned*)(X + (size_t)Fc * 8), (LAS unsigned*)(L + (512 * i + 64 * w) * 16), 16, 0, 0); } }
    const bf16* W1 = (const bf16*)(ws + WS_CW1) + ((size_t)kv * 256 + 32 * w) * 2048;
    LAS unsigned char* WB = L + 67584 + w * 8192;
#define CM_DMA(kc) do { const int kc_ = (kc); _Pragma("unroll") for (int q_ = 0; q_ < 4; ++q_) { const int rr_ = 8 * q_ + (lane >> 3), cs_ = (lane & 7) ^ (rr_ & 7); \
        __builtin_amdgcn_global_load_lds((const unsigned*)(W1 + (size_t)rr_ * 2048 + 64 * kc_ + 8 * cs_), (LAS unsigned*)(WB + (kc_ & 1) * 4096 + q_ * 1024), 16, 0, 0); } } while (0)
    CM_DMA(0);
    asm volatile("s_waitcnt vmcnt(4)" ::: "memory");
    __builtin_amdgcn_s_barrier(); asm volatile("" ::: "memory");
    f32x16 acc;
#pragma unroll
    for (int i = 0; i < 16; ++i) acc[i] = 0.f;
#pragma unroll 1
    for (int kc = 0; kc < 32; ++kc) {
        if (kc + 1 < 32) { CM_DMA(kc + 1); asm volatile("s_waitcnt vmcnt(4)" ::: "memory"); } else asm volatile("s_waitcnt vmcnt(0)" ::: "memory");
        const LAS unsigned char* wb = WB + (kc & 1) * 4096 + r * 128;
#pragma unroll
        for (int ks = 0; ks < 4; ++ks) {
            const bf16x8 wf = *(const LAS bf16x8*)(wb + (((2 * ks + hh) ^ (r & 7)) * 16));
            const int Fc = 128 * r + 8 * kc + 2 * ks + hh;
            const bf16x8 xf = *(const LAS bf16x8*)(L + ((Fc ^ ((Fc >> 7) & 7)) * 16));
            acc = __builtin_amdgcn_mfma_f32_32x32x16_bf16(wf, xf, acc, 0, 0, 0);
        }
        asm volatile("s_waitcnt lgkmcnt(0)" ::: "memory");
    }
#undef CM_DMA
    const float* cb1p = (const float*)(ws + WS_CB1P) + kv * 256 + 32 * w;
    float bias[4][4];
#pragma unroll
    for (int q = 0; q < 4; ++q)
#pragma unroll
        for (int i = 0; i < 4; ++i) { const int col = 8 * q + 4 * hh + i; float bsum = 0.f;
#pragma unroll
            for (int pz = 0; pz < 8; ++pz) bsum += cb1p[pz * 512 + col];
            bias[q][i] = bsum; }
    __syncthreads();
    LAS unsigned char* HL = L;
#pragma unroll
    for (int q = 0; q < 4; ++q) { float o[4];
#pragma unroll
        for (int i = 0; i < 4; ++i) o[i] = gelu_tanh(acc[4 * q + i] + bias[q][i]);
        *(LAS v2u*)(HL + r * 528 + (32 * w + 8 * q + 4 * hh) * 2) = (v2u){pk2(o[0], o[1]), pk2(o[2], o[3])}; }
    __syncthreads();
    if (w == 0) {
        const bf16* W2 = (const bf16*)(ws + WS_CW2) + (size_t)kv * 64 * 256;
        f32x16 a2[2];
#pragma unroll
        for (int i = 0; i < 16; ++i) { a2[0][i] = 0.f; a2[1][i] = 0.f; }
#pragma unroll
        for (int ks = 0; ks < 16; ++ks) {
            const bf16x8 hf = *(const LAS bf16x8*)(HL + r * 528 + (16 * ks + 8 * hh) * 2);
#pragma unroll
            for (int dt = 0; dt < 2; ++dt) { const bf16x8 wf = *(const bf16x8*)(W2 + (size_t)(32 * dt + r) * 256 + 16 * ks + 8 * hh);
                a2[dt] = __builtin_amdgcn_mfma_f32_32x32x16_bf16(wf, hf, a2[dt], 0, 0, 0); }
        }
        const float* b2 = A.in[16] + kv * 64; const float* kg0 = A.in[11];
        float sq = 0.f;
#pragma unroll
        for (int dt = 0; dt < 2; ++dt)
#pragma unroll
            for (int i = 0; i < 16; ++i) { const int d = 32 * dt + (i & 3) + 8 * (i >> 2) + 4 * hh; a2[dt][i] += b2[d]; sq += a2[dt][i] * a2[dt][i]; }
        const int row = row0 + r, n = row & 255, bg = (row & 4095) >> 8;
        if (kv == 0) {
            sq += __shfl_xor(sq, 32); const float rn = rsq_acc(sq, 1.f / 64.f);
            bf16* dst = (bf16*)(ws + WS_KCMP) + ((size_t)bg * 256 + n) * 64;
#pragma unroll
            for (int dt = 0; dt < 2; ++dt)
#pragma unroll
                for (int q = 0; q < 4; ++q) { const int d = 32 * dt + 8 * q + 4 * hh; const f32x4 gg = *(const f32x4*)(kg0 + d);
                    v2u wv; wv.x = pk2(a2[dt][4 * q] * rn * gg[0], a2[dt][4 * q + 1] * rn * gg[1]); wv.y = pk2(a2[dt][4 * q + 2] * rn * gg[2], a2[dt][4 * q + 3] * rn * gg[3]);
                    *(v2u*)(dst + d) = wv; }
        } else {
            const int np = (n & ~12) | ((n & 4) << 1) | ((n & 8) >> 1);
            bf16* dst = (bf16*)(ws + WS_VCMPT) + (size_t)bg * 64 * 256 + np;
#pragma unroll
            for (int dt = 0; dt < 2; ++dt)
#pragma unroll
                for (int i = 0; i < 16; ++i) { const int d = 32 * dt + (i & 3) + 8 * (i >> 2) + 4 * hh; dst[(size_t)d * 256] = (bf16)f2bf(a2[dt][i]); }
        }
    }
    __syncthreads();
}

#define TSTAMP() __builtin_amdgcn_s_memrealtime()
namespace att {
typedef short bf16x8 __attribute__((ext_vector_type(8)));
typedef short s16x4 __attribute__((ext_vector_type(4)));
typedef float f32x16 __attribute__((ext_vector_type(16)));
typedef float f32x2_t __attribute__((ext_vector_type(2))); typedef __bf16 bf16x2_t __attribute__((ext_vector_type(2)));
constexpr int TILEB = 8192, NSLOT = 6;
constexpr int OFF_KV = 0, OFF_IMP = NSLOT * 2 * TILEB, OFF_MSK = OFF_IMP + 8 * 2048, ATT_LDS = OFF_MSK + 512;
constexpr float NEGBIG = -30000.f;
__device__ __forceinline__ unsigned cvtpk(float lo, float hi) { f32x2_t v = {lo, hi}; bf16x2_t b = __builtin_convertvector(v, bf16x2_t); return __builtin_bit_cast(unsigned, b); }
__device__ __forceinline__ int crow(int r, int hi) { return (r & 3) + 8 * (r >> 2) + 4 * hi; }
__device__ __forceinline__ float xhalf(float x) { return __shfl_xor(x, 32); }
constexpr int TR_D0 = 575, TR_N = 640, OFF_TR = 115712;
enum { FAR = 0, NEARS = 1, NEARW = 2, NEARC = 3 };
#define SBAR() __builtin_amdgcn_sched_barrier(0)
template <int MODE, bool CMP, bool MASKED>
__device__ __forceinline__ void tile(const LAS unsigned char* Kb, const LAS unsigned char* Vb, const bf16x8 (&qf)[4], bool rowsel, const LAS float* trh, int kidx0,
                                     f32x16 (&O)[2], float& l, float (&u)[2][4], float& carry, int r, int hh) {
    constexpr int ES = CMP ? 16 : 1;
    const LAS float* trb = trh + kidx0;
    f32x16 S[2];
    bf16x8 pf[2][2], kf[2][4], vf[4];
    float ls = 0.f;
    const unsigned pmask = rowsel ? 0xffffffffu : 0u;
#define ATT_B(a, i) do { float s_ = S[a][i]; const int e_ = ES * (32 * (a) + ((i) & 3) + 8 * ((i) >> 2)); \
        if (MODE == NEARS || MODE == NEARW) s_ += trb[e_]; \
        if (MODE == NEARC) { int k_ = kidx0 + e_; k_ = k_ < 0 ? 0 : (k_ < TR_N - 1 ? k_ : TR_N - 1); s_ += trh[k_]; } \
        float p_ = __builtin_amdgcn_exp2f(s_); \
        if (MODE == NEARW) p_ = (kidx0 + e_ >= TR_D0 - 511) ? p_ : 0.f; \
        S[a][i] = p_; ls += p_; } while (0)
#define ATT_B4(a, i0) do { ATT_B(a, (i0)); ATT_B(a, (i0) + 1); ATT_B(a, (i0) + 2); ATT_B(a, (i0) + 3); } while (0)
#define ATT_PACK(a) do { _Pragma("unroll") for (int s2 = 0; s2 < 2; ++s2) { v4u w_ = {cvtpk(S[a][8 * s2 + 0], S[a][8 * s2 + 1]), cvtpk(S[a][8 * s2 + 2], S[a][8 * s2 + 3]), cvtpk(S[a][8 * s2 + 4], S[a][8 * s2 + 5]), cvtpk(S[a][8 * s2 + 6], S[a][8 * s2 + 7])}; \
        if (MASKED) { w_.x &= pmask; w_.y &= pmask; w_.z &= pmask; w_.w &= pmask; } \
        pf[a][s2] = __builtin_bit_cast(bf16x8, w_); } } while (0)
#define ATT_U(a) do { if (CMP) { float rq_[4]; _Pragma("unroll") for (int q = 0; q < 4; ++q) rq_[q] = xhalf(S[a][4 * q + 3]); \
        _Pragma("unroll") for (int q = 0; q < 4; ++q) { const float own_ = (S[a][4 * q] + S[a][4 * q + 1]) + (S[a][4 * q + 2] + S[a][4 * q + 3]); \
            const float prev_ = hh ? rq_[q] : (q > 0 ? rq_[q - 1] : carry); u[a][q] = own_ + prev_; } carry = rq_[3]; } } while (0)
#define ATT_VRD(m, a) vf[m] = *(const LAS bf16x8*)(Vb + (32 * ((m) & 1) + r) * 128 + (((4 * (a) + 2 * ((m) >> 1) + hh) ^ (r & 7)) * 16))
    const f32x16 zero = {0.f, 0.f, 0.f, 0.f, 0.f, 0.f, 0.f, 0.f, 0.f, 0.f, 0.f, 0.f, 0.f, 0.f, 0.f, 0.f};
#pragma unroll
    for (int kk = 0; kk < 4; ++kk) kf[0][kk] = *(const LAS bf16x8*)(Kb + r * 128 + (((2 * kk + hh) ^ (r & 7)) * 16));
    SBAR();
#define ATT_KRD(kk) kf[1][kk] = *(const LAS bf16x8*)(Kb + (32 + r) * 128 + (((2 * (kk) + hh) ^ (r & 7)) * 16))
    S[0] = __builtin_amdgcn_mfma_f32_32x32x16_bf16(kf[0][0], qf[0], zero, 0, 0, 0); ATT_KRD(0); SBAR();
    S[0] = __builtin_amdgcn_mfma_f32_32x32x16_bf16(kf[0][1], qf[1], S[0], 0, 0, 0); ATT_KRD(1); SBAR();
    S[0] = __builtin_amdgcn_mfma_f32_32x32x16_bf16(kf[0][2], qf[2], S[0], 0, 0, 0); ATT_KRD(2); SBAR();
    S[0] = __builtin_amdgcn_mfma_f32_32x32x16_bf16(kf[0][3], qf[3], S[0], 0, 0, 0); ATT_KRD(3); SBAR();
#undef ATT_KRD
    S[1] = __builtin_amdgcn_mfma_f32_32x32x16_bf16(kf[1][0], qf[0], zero, 0, 0, 0); ATT_VRD(0, 0); ATT_B4(0, 0); SBAR();
    S[1] = __builtin_amdgcn_mfma_f32_32x32x16_bf16(kf[1][1], qf[1], S[1], 0, 0, 0); ATT_VRD(1, 0); ATT_B4(0, 4); SBAR();
    S[1] = __builtin_amdgcn_mfma_f32_32x32x16_bf16(kf[1][2], qf[2], S[1], 0, 0, 0); ATT_VRD(2, 0); ATT_B4(0, 8); SBAR();
    S[1] = __builtin_amdgcn_mfma_f32_32x32x16_bf16(kf[1][3], qf[3], S[1], 0, 0, 0); ATT_VRD(3, 0); ATT_B4(0, 12); SBAR();
    ATT_U(0); ATT_PACK(0); SBAR();
    O[0] = __builtin_amdgcn_mfma_f32_32x32x16_bf16(vf[0], pf[0][0], O[0], 0, 0, 0); ATT_VRD(0, 1); ATT_B4(1, 0); SBAR();
    O[1] = __builtin_amdgcn_mfma_f32_32x32x16_bf16(vf[1], pf[0][0], O[1], 0, 0, 0); ATT_VRD(1, 1); ATT_B4(1, 4); SBAR();
    O[0] = __builtin_amdgcn_mfma_f32_32x32x16_bf16(vf[2], pf[0][1], O[0], 0, 0, 0); ATT_VRD(2, 1); ATT_B4(1, 8); SBAR();
    O[1] = __builtin_amdgcn_mfma_f32_32x32x16_bf16(vf[3], pf[0][1], O[1], 0, 0, 0); ATT_VRD(3, 1); ATT_B4(1, 12); SBAR();
    ATT_U(1); ATT_PACK(1); SBAR();
    O[0] = __builtin_amdgcn_mfma_f32_32x32x16_bf16(vf[0], pf[1][0], O[0], 0, 0, 0);
    O[1] = __builtin_amdgcn_mfma_f32_32x32x16_bf16(vf[1], pf[1][0], O[1], 0, 0, 0);
    O[0] = __builtin_amdgcn_mfma_f32_32x32x16_bf16(vf[2], pf[1][1], O[0], 0, 0, 0);
    O[1] = __builtin_amdgcn_mfma_f32_32x32x16_bf16(vf[3], pf[1][1], O[1], 0, 0, 0);
    l += (MASKED && !rowsel) ? 0.f : ls;
#undef ATT_B
#undef ATT_B4
#undef ATT_PACK
#undef ATT_U
#undef ATT_VRD
}
#undef SBAR
}

__device__ __forceinline__ void attn_unit(Frame& F, const Args& A, int bg, int c, size_t ydst_off, unsigned long long& tacc) {
    using namespace att;
    unsigned char* ws = A.ws;
    int tid = F.tid; asm volatile("" : "+v"(tid));
    const int lane = tid & 63, w = F.wave, r = lane & 31, hh = lane >> 5, hg = r >> 3, qi = r & 7;
    const int b = bg >> 1, g = bg & 1, h = g * 4 + hg;
    const int t = 64 * c + 8 * w + qi; const size_t tok = (size_t)b * SEQ + t;
    LAS unsigned char* L = F.lds + RING_OFF;
    const LAS float* tblh = (const LAS float*)(F.lds + TBL_OFF) + h * 132;
    const LAS float* trh = (const LAS float*)(L + OFF_TR) + h * TR_N;
    bf16* Y = (bf16*)(ws + WS_Y);
    bf16* yrow = Y + tok * DM + 512 + h * 64;
    if (DBG_T == 60) tacc -= TSTAMP();
    bf16x8 qf[4];
#pragma unroll
    for (int kk = 0; kk < 4; ++kk) qf[kk] = *(const bf16x8*)(yrow + 16 * kk + 8 * hh);
    const int nc = (c >> 4) + 1, ns = c + 1, w0 = c > 8 ? c - 8 : 0, nw = c - w0 + 1, ntile = nc + ns + nw;
    const int srow = tid >> 3, sch = (tid & 7) ^ (srow & 7);
    const unsigned ldsw = (unsigned)w * 1024u;
#define ATT_DMA(i) do { const int i_ = (i); const bf16* kp_; const bf16* vp_; size_t ldv_; \
        if (i_ < nc) { kp_ = (const bf16*)(ws + WS_KCMP) + ((size_t)bg * 256 + 64 * i_) * 64; vp_ = (const bf16*)(ws + WS_VCMPT) + (size_t)bg * 64 * 256 + 64 * i_; ldv_ = 256; } \
        else if (i_ < nc + ns) { const int j_ = i_ - nc; kp_ = (const bf16*)(ws + WS_KS) + ((size_t)bg * SEQ + 64 * j_) * 64; vp_ = (const bf16*)(ws + WS_VST) + (size_t)bg * 64 * SEQ + 64 * j_; ldv_ = SEQ; } \
        else { const int j_ = w0 + i_ - nc - ns; kp_ = (const bf16*)(ws + WS_KW) + ((size_t)bg * SEQ + 64 * j_) * 64; vp_ = (const bf16*)(ws + WS_VWT) + (size_t)bg * 64 * SEQ + 64 * j_; ldv_ = SEQ; } \
        const int sl_ = ((i_ >> 1) % 3) * 2 + (i_ & 1); \
        __builtin_amdgcn_global_load_lds((const unsigned*)(kp_ + srow * 64 + sch * 8), (LAS unsigned*)(L + OFF_KV + sl_ * 2 * TILEB + ldsw), 16, 0, 0); \
        __builtin_amdgcn_global_load_lds((const unsigned*)(vp_ + (size_t)srow * ldv_ + sch * 8), (LAS unsigned*)(L + OFF_KV + sl_ * 2 * TILEB + TILEB + ldsw), 16, 0, 0); } while (0)
#define ATT_WAITN(n) do { const int n_ = (n); if (n_ >= 2) asm volatile("s_waitcnt vmcnt(4) lgkmcnt(0)" ::: "memory"); else if (n_ == 1) asm volatile("s_waitcnt vmcnt(2) lgkmcnt(0)" ::: "memory"); \
        else asm volatile("s_waitcnt vmcnt(0) lgkmcnt(0)" ::: "memory"); } while (0)
#define ATT_NEXT(i) do { if (((i) & 1) == 0) { if ((i) + 4 < ntile) ATT_DMA((i) + 4); if ((i) + 5 < ntile) ATT_DMA((i) + 5); } if (DBG_T == 1) tacc -= TSTAMP(); } while (0)
#define ATT_FLIP(i) do { if (DBG_T == 1) tacc += TSTAMP(); if ((((i) & 1) == 1) || (i) + 1 == ntile) { if (DBG_T == 2) tacc -= TSTAMP(); \
        const int s2_ = ((i) | 1) + 3; ATT_WAITN(s2_ + 1 < ntile ? 2 : (s2_ < ntile ? 1 : 0)); \
        __builtin_amdgcn_s_barrier(); asm volatile("" ::: "memory"); if (DBG_T == 2) tacc += TSTAMP(); } } while (0)
    ATT_DMA(0); if (ntile > 1) ATT_DMA(1); if (ntile > 2) ATT_DMA(2); if (ntile > 3) ATT_DMA(3);
    ATT_WAITN(ntile > 3 ? 2 : (ntile > 2 ? 1 : 0));
    __builtin_amdgcn_s_barrier(); asm volatile("" ::: "memory");
    asm volatile("" : "+v"(qf[0]), "+v"(qf[1]), "+v"(qf[2]), "+v"(qf[3]));
    if (DBG_T == 60) tacc += TSTAMP();
    f32x16 out[2], O[2];
#pragma unroll
    for (int i = 0; i < 16; ++i) { out[0][i] = 0.f; out[1][i] = 0.f; O[0][i] = 0.f; O[1][i] = 0.f; }
    float l = 0.f, carry = 0.f, dummy_u[2][4];
    int it = 0;
    float u[4][2][4];
#pragma unroll
    for (int i = 0; i < 4; ++i)
#pragma unroll
        for (int a = 0; a < 2; ++a)
#pragma unroll
            for (int q = 0; q < 4; ++q) u[i][a][q] = 0.f;
#pragma unroll
    for (int i = 0; i < 4; ++i) {
        if (i < nc) {
            ATT_NEXT(it);
            const LAS unsigned char* Kb = L + OFF_KV + (((it >> 1) % 3) * 2 + (it & 1)) * 2 * TILEB; const LAS unsigned char* Vb = Kb + TILEB;
            const bool far = 64 * c >= 1024 * i + 1167;
            if (far) tile<FAR, true, false>(Kb, Vb, qf, true, trh, 0, O, l, u[i], carry, r, hh);
            else tile<NEARC, true, false>(Kb, Vb, qf, true, trh, TR_D0 - t + 31 + 16 * (64 * i + 4 * hh), O, l, u[i], carry, r, hh);
            ATT_FLIP(it); ++it;
        }
    }
    unsigned long long mask;
    if (DBG_T == 61) tacc -= TSTAMP();
    {
        const float g0 = ((const float*)(ws + WS_GATES))[tok * 24 + h]; const float lt = l + xhalf(l); const float linv = lt > 0.f ? 1.f / lt : 0.f; const float sc = g0 * linv;
#pragma unroll
        for (int i = 0; i < 16; ++i) { out[0][i] += sc * O[0][i]; out[1][i] += sc * O[1][i]; O[0][i] = 0.f; O[1][i] = 0.f; }
        LAS float* impw = (LAS float*)(L + OFF_IMP + w * 2048);
#pragma unroll
        for (int i = 0; i < 4; ++i)
#pragma unroll
            for (int a = 0; a < 2; ++a)
#pragma unroll
                for (int q = 0; q < 4; ++q) {
                    float x = u[i][a][q] * linv;
                    x += __builtin_bit_cast(float, __builtin_amdgcn_update_dpp(0, __builtin_bit_cast(int, x), 0x128, 0xf, 0xf, false));
                    { const unsigned xb = __builtin_bit_cast(unsigned, x); auto pr = __builtin_amdgcn_permlane16_swap(xb, xb, false, false);
                      const unsigned p0 = pr[0], p1 = pr[1];
                      x = __builtin_bit_cast(float, p0) + __builtin_bit_cast(float, p1); }
                    const int j = 8 * (2 * i + a) + 2 * q + hh;
                    const bool forced = (j == 0) || (j == c) || (j == c - 1);
                    x = (j <= c) ? (forced ? 1e6f : x) : -1.f;
                    const unsigned bits = (__builtin_bit_cast(unsigned, x) & ~63u) | (unsigned)(63 - j);
                    impw[qi * 64 + j] = __builtin_bit_cast(float, bits);
                }
        LDS_WAIT(); asm volatile("" ::: "memory");
        const int q2 = lane >> 3, part = lane & 7;
        const LAS float* iq = impw + q2 * 64;
        float mine[8]; int cnt[8];
        { const f32x4 m0 = *(const LAS f32x4*)(iq + 8 * part), m1 = *(const LAS f32x4*)(iq + 8 * part + 4);
#pragma unroll
          for (int i = 0; i < 4; ++i) { mine[i] = m0[i]; mine[4 + i] = m1[i]; cnt[i] = 0; cnt[4 + i] = 0; } }
        unsigned byte = 0xffu;
        if (c >= 16) {
#pragma unroll 1
            for (int k = 0; 4 * k <= c; ++k) { const f32x4 v = *(const LAS f32x4*)(iq + 4 * k);
#pragma unroll
                for (int e = 0; e < 4; ++e)
#pragma unroll
                    for (int i = 0; i < 8; ++i) cnt[i] += (v[e] > mine[i]) ? 1 : 0; }
            byte = 0;
#pragma unroll
            for (int i = 0; i < 8; ++i) byte |= (cnt[i] < 16) ? (1u << i) : 0u;
        }
        LAS unsigned char* mw = (LAS unsigned char*)(L + OFF_MSK + w * 64);
        mw[q2 * 8 + part] = (unsigned char)byte;
        LDS_WAIT(); asm volatile("" ::: "memory");
        mask = *(const LAS unsigned long long*)(mw + qi * 8);
        l = 0.f;
    }
    if (DBG_T == 61) tacc += TSTAMP();
    unsigned long long uni = 0;
#pragma unroll
    for (int q = 0; q < 8; ++q) { uni |= (unsigned long long)(unsigned)__builtin_amdgcn_readlane((int)(unsigned)mask, q) | ((unsigned long long)(unsigned)__builtin_amdgcn_readlane((int)(unsigned)(mask >> 32), q) << 32); }
#pragma unroll 1
    for (int j = 0; j <= c; ++j) {
        ATT_NEXT(it);
        if ((uni >> j) & 1ull) {
            const LAS unsigned char* Kb = L + OFF_KV + (((it >> 1) % 3) * 2 + (it & 1)) * 2 * TILEB; const LAS unsigned char* Vb = Kb + TILEB;
            const bool rs = (mask >> j) & 1ull;
            if (j <= c - 3) tile<FAR, false, true>(Kb, Vb, qf, rs, trh, 0, O, l, dummy_u, carry, r, hh);
            else tile<NEARS, false, true>(Kb, Vb, qf, rs, trh, TR_D0 - t + 64 * j + 4 * hh, O, l, dummy_u, carry, r, hh);
        }
        ATT_FLIP(it); ++it;
    }
    {
        const float g1 = ((const float*)(ws + WS_GATES))[tok * 24 + 8 + h]; const float lt = l + xhalf(l); const float sc = lt > 0.f ? g1 / lt : 0.f;
#pragma unroll
        for (int i = 0; i < 16; ++i) { out[0][i] += sc * O[0][i]; out[1][i] += sc * O[1][i]; O[0][i] = 0.f; O[1][i] = 0.f; }
        l = 0.f;
    }
#pragma unroll 1
    for (int j = w0; j <= c; ++j) {
        ATT_NEXT(it);
        const LAS unsigned char* Kb = L + OFF_KV + (((it >> 1) % 3) * 2 + (it & 1)) * 2 * TILEB; const LAS unsigned char* Vb = Kb + TILEB;
        if (j <= c - 3 && j != c - 8) tile<FAR, false, false>(Kb, Vb, qf, true, trh, 0, O, l, dummy_u, carry, r, hh);
        else if (j == c - 8) tile<NEARW, false, false>(Kb, Vb, qf, true, trh, TR_D0 - t + 64 * j + 4 * hh, O, l, dummy_u, carry, r, hh);
        else tile<NEARS, false, false>(Kb, Vb, qf, true, trh, TR_D0 - t + 64 * j + 4 * hh, O, l, dummy_u, carry, r, hh);
        ATT_FLIP(it); ++it;
    }
    if (DBG_T == 50 || DBG_T == 51) {
        f32x16 Ox[2] = {O[0], O[1]}; float lx = 0.f;
        if (DBG_T == 50 || w < 4) {
            tacc -= TSTAMP();
#pragma unroll 1
            for (int rep = 0; rep < 128; ++rep) tile<FAR, false, true>(L + OFF_KV, L + OFF_KV + TILEB, qf, (mask >> (rep & 63)) & 1ull, trh, 0, Ox, lx, dummy_u, carry, r, hh);
            tacc += TSTAMP();
        }
        asm volatile("" :: "v"(Ox[0]), "v"(Ox[1]), "v"(lx));
    }
    {
        const float g2 = ((const float*)(ws + WS_GATES))[tok * 24 + 16 + h]; const float lt = l + xhalf(l); const float sc = lt > 0.f ? g2 / lt : 0.f;
#pragma unroll
        for (int i = 0; i < 16; ++i) { out[0][i] += sc * O[0][i]; out[1][i] += sc * O[1][i]; }
    }
    if (DBG_T == 62) tacc -= TSTAMP();
    bf16* yout = (bf16*)(ws + WS_Y) + tok * DM + 512 + h * 64;
#pragma unroll
    for (int dt = 0; dt < 2; ++dt)
#pragma unroll
        for (int q = 0; q < 4; ++q) { v2u wv; wv.x = cvtpk(out[dt][4 * q], out[dt][4 * q + 1]); wv.y = cvtpk(out[dt][4 * q + 2], out[dt][4 * q + 3]);
            *(v2u*)((bf16*)((unsigned char*)yout + ydst_off) + 32 * dt + 8 * q + 4 * hh) = wv; }
    __syncthreads();
    if (DBG_T == 62) tacc += TSTAMP();
#undef ATT_DMA
#undef ATT_WAITN
#undef ATT_NEXT
#undef ATT_FLIP
}

__global__ void __launch_bounds__(NWAVES * 64, 2) mk_fwd(Args args) {
    extern __shared__ __attribute__((aligned(16))) unsigned char lds[];
    Frame F;
    F.lds = (LAS unsigned char*)lds;
    F.MISC = (volatile LAS unsigned*)(F.lds + MISC_OFF);
    F.tid = threadIdx.x; F.lane = F.tid & 63; F.wave = __builtin_amdgcn_readfirstlane(F.tid >> 6);
    F.G = gridDim.x; { const int bx = blockIdx.x; F.vcu = (F.G % 8 == 0) ? (bx % 8) * (F.G / 8) + bx / 8 : bx; }
    unsigned char* ws = args.ws;
    F.ctl = (gu32*)(ws + WS_CTL);
    for (int u = F.tid; u < (LDS_BYTES - LDSCTL_OFF) / 4; u += NWAVES * 64) ((LAS unsigned*)(F.lds + LDSCTL_OFF))[u] = 0u;
    __syncthreads();
    if (F.tid < 128) { const int n = F.tid; int bkt = n;
        if (n >= 16) { const float nf = (float)n; int large = 16 + (int)(logf(nf / 16.f) / logf(8.f) * 16.f); bkt = large < 31 ? large : 31; }
        ((LAS unsigned char*)(F.lds + TB_OFF))[n] = (unsigned char)bkt; }
    __syncthreads();
    for (int e = F.tid; e < 8 * 129; e += NWAVES * 64) { const int hh_ = e / 129, x = e % 129; const int bk = x < 128 ? ((LAS unsigned char*)(F.lds + TB_OFF))[x] : 31;
        ((LAS float*)(F.lds + TBL_OFF))[hh_ * 132 + x] = args.in[17][hh_ * 32 + bk] * 1.4426950408889634f; }
    __syncthreads();
    XcdBarrier bar; bar.bar = (unsigned*)(F.ctl + CW_BAR) + args.li * XCD_BAR_WORDS; bar.x = 0; bar.st = nullptr;
    if (N_LAUNCHES != PER_PHASE) bar = xcd_barrier_post((unsigned*)(F.ctl + CW_BAR) + args.li * XCD_BAR_WORDS, F.MISC + 8);
#define GRID_BAR() do { if (N_LAUNCHES != PER_PHASE) xcd_barrier(bar); } while (0)
    const int lo = args.ph_lo, hi = args.ph_hi;
#define IN(k) (lo <= (k) && (k) < hi)
#define BOTH(k) (IN(k) && IN((k) + 1))
    bf16* XB = (bf16*)(ws + WS_XB); bf16* ACT = (bf16*)(ws + WS_ACT); bf16* Y = (bf16*)(ws + WS_Y);
    float* SS0 = (float*)(ws + WS_SS0); float* SS1 = (float*)(ws + WS_SS1); float* SS2 = (float*)(ws + WS_SS2); float* SS3 = (float*)(ws + WS_SS3);

    unsigned long long tacc = 0;
#define PT0(k) do { if (DBG_T == 10 + (k)) tacc -= TSTAMP(); if (DBG_T == 30 + (k)) tacc += TSTAMP(); } while (0)
#define PT1(k) do { if (DBG_T == 10 + (k)) tacc += TSTAMP(); if (DBG_T == 31 + (k)) tacc -= TSTAMP(); } while (0)
    if (IN(0)) { PT0(0); NREP(0) p0_prologue(F, args); PT1(0); if (BOTH(0)) GRID_BAR(); }
    if (IN(1)) {
        PT0(1);
        unsigned long long cyc0 = 0; if (DBG_T == 80 || DBG_T == 81) cyc0 = (DBG_T == 80) ? __builtin_amdgcn_s_memtime() : TSTAMP();
        pg8::Gemm g{XB, (const bf16*)(ws + WS_WGU1), MTOK, NGU, DM, DM, DM}; pg8::StaticOrder S; S.init(MTOK, NGU, F.G, (int)blockIdx.x);
        EpiSwiGLU E{SS0, ACT};
        NREP(1) pg8::gemm_phase<EpiSwiGLU, pg8::StaticOrder, true, true>(F.lds + RING_OFF, g, S, E);
        PT1(1);
        if (DBG_T == 80) tacc = (__builtin_amdgcn_s_memtime() - cyc0) / 100;
        if (DBG_T == 81) tacc = (TSTAMP() - cyc0);
        if (BOTH(1)) GRID_BAR();
    }
    if (IN(2)) {
        PT0(2);
        pg8::Gemm g{ACT, (const bf16*)(ws + WS_WD1), MTOK, DM, DFF, DFF, DFF}; pg8::StaticOrder S; S.init(MTOK, DM, F.G, (int)blockIdx.x);
        EpiResid E{args.in[0], nullptr, nullptr, XB, SS1, 0.5f};
        NREP(2) { S.fixed = (DBG_FIX && rep_ == 0) ? 1 : 0; pg8::gemm_phase<EpiResid, pg8::StaticOrder, true, true>(F.lds + RING_OFF, g, S, E); }
        PT1(2);
        if (BOTH(2)) GRID_BAR();
    }
    if (IN(3)) {
        PT0(3);
        pg8::Gemm g{XB, (const bf16*)(ws + WS_WIN), MTOK, NIN, DM, DM, DM}; pg8::StaticOrder S; S.init(MTOK, NIN, F.G, (int)blockIdx.x);
        EpiMix E{SS1, ws, args.in[10], args.in[11]};
        NREP(3) pg8::gemm_phase<EpiMix, pg8::StaticOrder, true, true>(F.lds + RING_OFF, g, S, E);
        PT1(3);
        if (BOTH(3)) GRID_BAR();
    }
    if (IN(4)) {
        PT0(4);
        for (int u = F.vcu; u < 256; u += F.G) cmp_unit(F, args, u);
        for (int u = F.vcu; u < 256; u += F.G) gmlp_unit(F, args, u);
        PT1(4);
        if (BOTH(4)) GRID_BAR();
    }
    if (IN(5)) {
        PT0(5);
        if (DBG_T == 3) tacc -= TSTAMP();
        if (DBG_T == 63) tacc -= TSTAMP();
        {
            LAS float* TR = (LAS float*)(F.lds + RING_OFF + att::OFF_TR); const LAS float* tbl = (const LAS float*)(F.lds + TBL_OFF);
            for (int e = F.tid; e < 8 * att::TR_N; e += NWAVES * 64) { const int hh_ = e / att::TR_N, k = e % att::TR_N, dist = att::TR_D0 - k;
                TR[e] = dist < 0 ? att::NEGBIG : tbl[hh_ * 132 + (dist < 128 ? dist : 128)] - tbl[hh_ * 132 + 128]; }
            __syncthreads();
        }
        if (DBG_T == 63) tacc += TSTAMP();
#if DBG_REP == 5
#pragma unroll 1
        for (int n = F.vcu; n < NBG * 64; n += F.G) { const int v = n & 255, i = n >> 8, x = v >> 5, lv = v & 31; attn_unit(F, args, 2 * x + (i & 1), i < 2 ? 63 - lv : lv, (size_t)(300 - 120) * MiB, tacc); }
#endif
        if (F.G % 8 == 0) {
            const int x = (int)blockIdx.x & 7; gu32* head = F.ctl + CW_Q + 64 * x;
#pragma unroll 1
            for (;;) {
                if (F.tid == 0) F.MISC[0] = __hip_atomic_fetch_add(head, 1u, RLX_AGENT);
                __syncthreads(); const int u = (int)F.MISC[0]; __syncthreads();
                if (u >= 128) break;
                attn_unit(F, args, 2 * x + (u & 1), 63 - (u >> 1), (size_t)0, tacc);
            }
        } else {
#pragma unroll 1
            for (int n = (int)blockIdx.x; n < NBG * 64; n += F.G) attn_unit(F, args, n & 15, 63 - (n >> 4), (size_t)0, tacc);
        }
        if (DBG_T == 3) tacc += TSTAMP();
        PT1(5);
        if (BOTH(5)) GRID_BAR();
    }
    if (IN(6)) {
        PT0(6);
        pg8::Gemm g{Y, (const bf16*)(ws + WS_WOUT), MTOK, DM, DM, DM, DM}; pg8::StaticOrder S; S.init(MTOK, DM, F.G, (int)blockIdx.x);
        EpiResid E{nullptr, XB, nullptr, XB, SS2, 1.0f};
        pg8::gemm_phase<EpiResid, pg8::StaticOrder, true, true>(F.lds + RING_OFF, g, S, E);
        PT1(6);
        if (BOTH(6)) GRID_BAR();
    }
    if (IN(7)) {
        PT0(7);
        pg8::Gemm g{XB, (const bf16*)(ws + WS_WGU2), MTOK, NGU, DM, DM, DM}; pg8::StaticOrder S; S.init(MTOK, NGU, F.G, (int)blockIdx.x);
        EpiSwiGLU E{SS2, ACT};
        pg8::gemm_phase<EpiSwiGLU, pg8::StaticOrder, true, true>(F.lds + RING_OFF, g, S, E);
        PT1(7);
        if (BOTH(7)) GRID_BAR();
    }
    if (IN(8)) {
        PT0(8);
        pg8::Gemm g{ACT, (const bf16*)(ws + WS_WD2), MTOK, DM, DFF, DFF, DFF}; pg8::StaticOrder S; S.init(MTOK, DM, F.G, (int)blockIdx.x);
        EpiResid E{nullptr, XB, args.out, nullptr, SS3, 0.5f};
        pg8::gemm_phase<EpiResid, pg8::StaticOrder, true, true>(F.lds + RING_OFF, g, S, E);
        PT1(8);
        if (BOTH(8)) GRID_BAR();
    }
    if (IN(9)) {
        PT0(9);
        int tid9 = threadIdx.x; asm volatile("" : "+v"(tid9)); const int lane9 = tid9 & 63;
        const int gw = F.vcu * NWAVES + F.wave, NGW = F.G * NWAVES; const float* gf = args.in[23];
        for (int m = gw; m < MTOK; m += NGW) {
            float s = (lane9 < 16) ? SS3[(size_t)m * 16 + lane9] : 0.f; s = wave_sum(s);
            const float ri = rsq_acc(s, 1.f / DM);
            GAS f32x4* xr = (GAS f32x4*)(args.out + (size_t)m * DM) + lane9;
#pragma unroll
            for (int j = 0; j < 4; ++j) { f32x4 v = xr[64 * j]; const f32x4 gg = *((const f32x4*)gf + lane9 + 64 * j); v = v * ri * gg; xr[64 * j] = v; }
        }
        PT1(9);
    }
    if (DBG_T != 0) { __syncthreads(); if (F.lane == 0) { F.MISC[16 + 2 * F.wave] = (unsigned)tacc; F.MISC[17 + 2 * F.wave] = (unsigned)(tacc >> 32); } __syncthreads();
        if (blockIdx.x == 0 && F.tid == 0) { const unsigned long long tw = (unsigned long long)F.MISC[16 + 2 * (DBG_TW)] | ((unsigned long long)F.MISC[17 + 2 * (DBG_TW)] << 32);
            const unsigned long long t0 = TSTAMP(); while (TSTAMP() - t0 < 16ull * tw) __builtin_amdgcn_s_sleep(8); } }
#undef IN
#undef BOTH
#undef GRID_BAR
}

extern "C" void kernel_launch(void* const* d_in, const int* in_sizes, int n_in, void* d_out, int out_size, void* d_ws, size_t ws_size, hipStream_t stream) {
    static int grid = 0;
    if (grid == 0) {
        if (n_in != 24 || in_sizes[0] != MTOK * DM || out_size != MTOK * DM || ws_size < WS_END) { fprintf(stderr, "kernel_launch: unexpected shapes (n_in %d, in0 %d, out %d, ws %zu)\n", n_in, n_in > 0 ? in_sizes[0] : -1, out_size, ws_size); grid = -1; return; }
        int dev = 0, cus = 0, per_cu = 0;
        if (hipGetDevice(&dev) != hipSuccess || hipDeviceGetAttribute(&cus, hipDeviceAttributeMultiprocessorCount, dev) != hipSuccess) { grid = -1; return; }
        if (hipFuncSetAttribute((const void*)mk_fwd, hipFuncAttributeMaxDynamicSharedMemorySize, LDS_BYTES) != hipSuccess) { fprintf(stderr, "kernel_launch: hipFuncSetAttribute failed\n"); grid = -1; return; }
        if (hipOccupancyMaxActiveBlocksPerMultiprocessor(&per_cu, (const void*)mk_fwd, NWAVES * 64, LDS_BYTES) != hipSuccess || per_cu < 1) { fprintf(stderr, "kernel_launch: occupancy query says %d blocks per CU\n", per_cu); (void)hipGetLastError(); grid = -1; return; }
        grid = cus;
    }
    if (grid < 0) return;
    (void)hipMemsetAsync((char*)d_ws + WS_CTL, 0, CTL_ZERO_BYTES, stream);
    Args a{};
    for (int i = 0; i < 24; ++i) a.in[i] = (const float*)d_in[i];
    a.out = (float*)d_out; a.ws = (unsigned char*)d_ws;
    if (N_LAUNCHES == 1) {
        a.ph_lo = 0; a.ph_hi = PER_PHASE; a.li = 0;
        void* kargs[] = {&a};
        hipError_t e = hipLaunchCooperativeKernel((const void*)mk_fwd, dim3(grid), dim3(NWAVES * 64), kargs, LDS_BYTES, stream);
        if (e != hipSuccess) fprintf(stderr, "kernel_launch: cooperative launch failed: %s (grid %d)\n", hipGetErrorString(e), grid);
    } else {
        for (int li = 0; li < PER_PHASE; ++li) { a.ph_lo = li; a.ph_hi = li + 1; a.li = 0;
            hipLaunchKernelGGL(mk_fwd, dim3(grid), dim3(NWAVES * 64), LDS_BYTES, stream, a); }
    }
}
```

```cpp
#include <hip/hip_runtime.h>
#include <cstdio>
#include <cstdint>

#ifndef DBG_REP
#define DBG_REP -1
#endif
#ifndef DBG_TW
#define DBG_TW 0
#endif
#ifndef DBG_FIX
#define DBG_FIX 0
#endif
#ifndef DBG_T
#define DBG_T 0
#endif
#define NREP(k) for (int rep_ = 0; rep_ < ((DBG_REP) == (k) ? 2 : 1); ++rep_)
#ifndef MK_N_LAUNCHES
#define MK_N_LAUNCHES 1
#endif

namespace pg8 {
#define PG8_LAS __attribute__((address_space(3)))
typedef unsigned short bf16_t;
typedef short bf16x8 __attribute__((ext_vector_type(8)));
typedef float f32x4 __attribute__((ext_vector_type(4)));
typedef unsigned u32x4 __attribute__((ext_vector_type(4)));
typedef unsigned u32x2 __attribute__((ext_vector_type(2)));
constexpr int BM = 256, BK = 64, HALF = 128, HTB = HALF * BK * 2, STAGE_BYTES = 8 * HTB, NXCD = 8, WGM = 8;

__host__ __device__ __forceinline__ int lds_byte(int r, int c) { const int st = (r >> 4) * 2 + (c >> 5), rr = r & 15, cc = c & 31, ob = rr * 64 + cc * 2; return st * 1024 + (ob ^ (((ob >> 9) & 1) << 5)); }
__host__ __device__ __forceinline__ void stage_rc(int b, int& R, int& C) { const int st = b / 1024, sb = b % 1024, swz = sb ^ (((sb >> 9) & 1) << 5); R = (st >> 1) * 16 + swz / 64; C = (st & 1) * 32 + (swz % 64) / 2; }
__host__ __device__ __forceinline__ int perm32(int rho) { const int n = rho >> 4, i = rho & 15; return 8 * (i >> 2) + 4 * n + (i & 3); }

struct Unit { int pm, pn, am, bn; };
struct Gemm { const bf16_t* A; const bf16_t* Bt; int M, N, K, lda, ldb; };

struct StaticOrder {
    int nM, nN, nwg, G, c, fixed;
    __host__ __device__ void init(int M, int N, int G_, int c_) { nM = M / BM; nN = N / BM; nwg = nM * nN; G = G_; c = c_; fixed = 0; }
    __host__ __device__ bool next(int i, Unit& u) const {
        const long L = (long)i * G + c; if (L >= nwg) return false;
        int wgid = (int)L; { const int q = nwg / NXCD, r = nwg % NXCD, xcd = wgid % NXCD, off = wgid / NXCD; wgid = (xcd < r ? xcd * (q + 1) : r * (q + 1) + (xcd - r) * q) + off; }
        const int nig = WGM * nN, gid = wgid / nig, fm = gid * WGM, gsz = (nM - fm) < WGM ? (nM - fm) : WGM;
        u.pm = fm + ((wgid % nig) % gsz); u.pn = (wgid % nig) / gsz; u.am = fixed ? 0 : u.pm; u.bn = fixed ? 0 : u.pn; return true;
    }
};
struct CmpOrder {
    int c;
    __device__ bool next(int i, Unit& u) const { if (i != 0 || c >= 32) return false; u.pm = c; u.pn = c >> 4; u.am = u.pm; u.bn = u.pn; return true; }
};

__device__ __forceinline__ unsigned cvt_pk_bf16(float lo, float hi) { unsigned r; asm volatile("v_cvt_pk_bf16_f32 %0, %1, %2" : "=v"(r) : "v"(lo), "v"(hi)); return r; }

template <class Epi, class Sched, bool ALIGN_EPI = false, bool SP2 = false>
__device__ __forceinline__ void gemm_phase(PG8_LAS unsigned char* lds, const Gemm g, const Sched& S, const Epi& E) {
    const int tid = threadIdx.x, wid = __builtin_amdgcn_readfirstlane(tid >> 6), lane = tid & 63, wr = wid >> 2, wc = wid & 3, fr = lane & 15, fq = lane >> 4;
    const int K = g.K, nt = K / BK;
    unsigned voffA[2], voffB[2];
#pragma unroll
    for (int i = 0; i < 2; ++i) { int R, C; stage_rc(tid * 16 + i * 8192, R, C); const int Rb = Epi::PERM ? ((R & ~31) + perm32(R & 31)) : R;
        voffA[i] = (unsigned)(R * g.lda + C) * 2u; voffB[i] = (unsigned)(Rb * g.ldb + C) * 2u; }
    const size_t kstep = (size_t)(BK * 2);
    const size_t hstepA = (size_t)HALF * g.lda * 2, hstepB = (size_t)HALF * g.ldb * 2;
    const size_t tstepA = 2 * hstepA, tstepB = 2 * hstepB;
    const unsigned ldsw = (unsigned)wid * 1024u;
    const int aoff = lds_byte(wr * 64 + fr, fq * 8), boff = lds_byte(wc * 32 + fr, fq * 8);
#define PG8_SA(b, h) (((b) * 2 + (h)) * HTB)
#define PG8_SB(b, h) ((4 + (b) * 2 + (h)) * HTB)
#define PG8_STAGE(bufoff, gbase, voff) do { _Pragma("unroll") for (int _i = 0; _i < 2; ++_i) \
        __builtin_amdgcn_global_load_lds((const unsigned*)((const char*)(gbase) + (voff)[_i]), (PG8_LAS unsigned*)(lds + (bufoff) + ldsw + _i * 8192), 16, 0, 0); } while (0)
#define PG8_LDA(dst, b, h) do { _Pragma("unroll") for (int m = 0; m < 4; ++m) _Pragma("unroll") for (int k = 0; k < 2; ++k) dst[m][k] = *(const PG8_LAS bf16x8*)(lds + PG8_SA(b, h) + aoff + m * 2048 + k * 1024); } while (0)
#define PG8_LDB(dst, b, h) do { _Pragma("unroll") for (int n = 0; n < 2; ++n) _Pragma("unroll") for (int k = 0; k < 2; ++k) dst[n][k] = *(const PG8_LAS bf16x8*)(lds + PG8_SB(b, h) + boff + n * 2048 + k * 1024); } while (0)
#define PG8_MMA(ai, bj, At, Bt) do { __builtin_amdgcn_s_setprio(1); _Pragma("unroll") for (int m = 0; m < 4; ++m) _Pragma("unroll") for (int n = 0; n < 2; ++n) _Pragma("unroll") for (int k = 0; k < 2; ++k) \
        acc[ai][bj][m][n] = __builtin_amdgcn_mfma_f32_16x16x32_bf16(Bt[n][k], At[m][k], acc[ai][bj][m][n], 0, 0, 0); __builtin_amdgcn_s_setprio(0); } while (0)
#define PG8_WAIT_V(n) asm volatile("s_waitcnt vmcnt(" #n ")" ::: "memory")
#define PG8_WAIT_L(n) asm volatile("s_waitcnt lgkmcnt(" #n ")" ::: "memory")
#define PG8_BAR __builtin_amdgcn_s_barrier()
#define PG8_SCHED __builtin_amdgcn_sched_barrier(0)
    Unit cur, nxt; int ui = 0;
    if (!S.next(0, cur)) return;
    f32x4 acc[2][2][4][2];
#pragma unroll
    for (int a = 0; a < 2; ++a)
#pragma unroll
        for (int b = 0; b < 2; ++b)
#pragma unroll
            for (int m = 0; m < 4; ++m)
#pragma unroll
                for (int n = 0; n < 2; ++n) acc[a][b][m][n] = (f32x4){0.f, 0.f, 0.f, 0.f};
    bf16x8 At[4][2], B0[2][2], B1[2][2];
    const char* cA = (const char*)g.A + (size_t)cur.am * tstepA; const char* cB = (const char*)g.Bt + (size_t)cur.bn * tstepB;
    if constexpr (SP2) {
        PG8_STAGE(PG8_SB(0, 0), cB, voffB); PG8_STAGE(PG8_SB(0, 1), cB + hstepB, voffB); PG8_STAGE(PG8_SA(0, 0), cA, voffA); PG8_STAGE(PG8_SA(0, 1), cA + hstepA, voffA);
        if (wr == 1) PG8_BAR;
        PG8_WAIT_V(2); PG8_BAR;
        PG8_STAGE(PG8_SB(1, 0), cB + kstep, voffB); PG8_STAGE(PG8_SA(1, 0), cA + kstep, voffA); PG8_STAGE(PG8_SB(1, 1), cB + hstepB + kstep, voffB);
        PG8_WAIT_V(6); PG8_BAR;
    } else {
        PG8_STAGE(PG8_SB(0, 0), cB, voffB); PG8_STAGE(PG8_SA(0, 0), cA, voffA); PG8_STAGE(PG8_SB(0, 1), cB + hstepB, voffB); PG8_STAGE(PG8_SA(0, 1), cA + hstepA, voffA);
        if (wr == 1) PG8_BAR;
        PG8_WAIT_V(4); PG8_BAR;
        PG8_STAGE(PG8_SB(1, 0), cB + kstep, voffB); PG8_STAGE(PG8_SA(1, 0), cA + kstep, voffA); PG8_STAGE(PG8_SB(1, 1), cB + hstepB + kstep, voffB);
        PG8_WAIT_V(6); PG8_BAR;
    }
    for (;;) {
        const bool has_next = S.next(ui + 1, nxt);
        const char* nA = has_next ? (const char*)g.A + (size_t)nxt.am * tstepA : cA; const char* nB = has_next ? (const char*)g.Bt + (size_t)nxt.bn * tstepB : cB;
        for (int t = 0; t < nt; t += 2) {
            const bool last = (t == nt - 2);
            const char* a1 = cA + (size_t)(t + 1) * kstep;
            const char* a2 = last ? nA : cA + (size_t)(t + 2) * kstep; const char* b2 = last ? nB : cB + (size_t)(t + 2) * kstep;
            const char* a3 = a2 + kstep; const char* b3 = b2 + kstep;
            if constexpr (SP2) {
            PG8_LDB(B0, 0, 0); PG8_LDB(B1, 0, 1); PG8_SCHED; PG8_LDA(At, 0, 0); PG8_STAGE(PG8_SA(1, 1), a1 + hstepA, voffA);
            PG8_WAIT_V(8); PG8_WAIT_L(0); PG8_BAR; PG8_MMA(0, 0, At, B0); PG8_MMA(0, 1, At, B1); PG8_BAR; PG8_SCHED;
            PG8_LDA(At, 0, 1); PG8_STAGE(PG8_SB(0, 0), b2, voffB); PG8_STAGE(PG8_SB(0, 1), b2 + hstepB, voffB); PG8_STAGE(PG8_SA(0, 0), a2, voffA);
            PG8_WAIT_V(8); PG8_WAIT_L(0); PG8_BAR; PG8_MMA(1, 0, At, B0); PG8_MMA(1, 1, At, B1); PG8_BAR; PG8_SCHED;
            PG8_LDB(B0, 1, 0); PG8_LDB(B1, 1, 1); PG8_SCHED; PG8_LDA(At, 1, 0); PG8_STAGE(PG8_SA(0, 1), a2 + hstepA, voffA);
            PG8_WAIT_V(8); PG8_WAIT_L(0); PG8_BAR; PG8_MMA(0, 0, At, B0); PG8_MMA(0, 1, At, B1); PG8_BAR; PG8_SCHED;
            PG8_LDA(At, 1, 1); PG8_STAGE(PG8_SB(1, 0), b3, voffB); PG8_STAGE(PG8_SB(1, 1), b3 + hstepB, voffB); PG8_STAGE(PG8_SA(1, 0), a3, voffA);
            PG8_WAIT_V(8); PG8_WAIT_L(0); PG8_BAR; PG8_MMA(1, 0, At, B0); PG8_MMA(1, 1, At, B1); PG8_BAR; PG8_SCHED;
            } else {
            PG8_LDB(B0, 0, 0); PG8_SCHED; PG8_LDA(At, 0, 0); PG8_STAGE(PG8_SA(1, 1), a1 + hstepA, voffA);
            PG8_WAIT_L(8); PG8_BAR; PG8_WAIT_L(0); PG8_MMA(0, 0, At, B0); PG8_BAR; PG8_SCHED;
            PG8_LDB(B1, 0, 1); PG8_STAGE(PG8_SB(0, 0), b2, voffB);
            PG8_BAR; PG8_WAIT_L(0); PG8_MMA(0, 1, At, B1); PG8_BAR;
            PG8_LDA(At, 0, 1); PG8_STAGE(PG8_SA(0, 0), a2, voffA);
            PG8_BAR; PG8_WAIT_L(0); PG8_MMA(1, 0, At, B0); PG8_BAR; PG8_SCHED;
            PG8_STAGE(PG8_SB(0, 1), b2 + hstepB, voffB);
            PG8_WAIT_V(6); PG8_BAR; PG8_MMA(1, 1, At, B1); PG8_BAR;
            PG8_LDB(B0, 1, 0); PG8_SCHED; PG8_LDA(At, 1, 0); PG8_STAGE(PG8_SA(0, 1), a2 + hstepA, voffA);
            PG8_WAIT_L(8); PG8_BAR; PG8_WAIT_L(0); PG8_MMA(0, 0, At, B0); PG8_BAR; PG8_SCHED;
            PG8_LDB(B1, 1, 1); PG8_STAGE(PG8_SB(1, 0), b3, voffB);
            PG8_BAR; PG8_WAIT_L(0); PG8_MMA(0, 1, At, B1); PG8_BAR;
            PG8_LDA(At, 1, 1); PG8_STAGE(PG8_SA(1, 0), a3, voffA);
            PG8_BAR; PG8_WAIT_L(0); PG8_MMA(1, 0, At, B0); PG8_BAR; PG8_SCHED;
            PG8_STAGE(PG8_SB(1, 1), b3 + hstepB, voffB);
            PG8_WAIT_V(6); PG8_BAR; PG8_MMA(1, 1, At, B1); PG8_BAR;
            }
        }
        if constexpr (ALIGN_EPI) { if (wr == 0) PG8_BAR; }
        E(acc, cur, wr, wc, fr, fq);
        if (!has_next) break;
#pragma unroll
        for (int a = 0; a < 2; ++a)
#pragma unroll
            for (int b = 0; b < 2; ++b)
#pragma unroll
                for (int m = 0; m < 4; ++m)
#pragma unroll
                    for (int n = 0; n < 2; ++n) acc[a][b][m][n] = (f32x4){0.f, 0.f, 0.f, 0.f};
        cur = nxt; cA = nA; cB = nB; ++ui;
        if constexpr (ALIGN_EPI) { if (wr == 1) PG8_BAR; }
    }
    PG8_WAIT_V(0);
    if constexpr (!ALIGN_EPI) { if (wr == 0) PG8_BAR; }
    PG8_BAR;
#undef PG8_SA
#undef PG8_SB
#undef PG8_STAGE
#undef PG8_LDA
#undef PG8_LDB
#undef PG8_MMA
#undef PG8_WAIT_V
#undef PG8_WAIT_L
#undef PG8_BAR
#undef PG8_SCHED
}
}

constexpr int NWAVES = 8;
constexpr int BATCH = 8, SEQ = 4096, DM = 1024, MTOK = BATCH * SEQ;
constexpr int DFF = 2816, NGU = 2 * DFF, INC = 2328, NIN = 2560;
constexpr int HD = 64, NBG = 16, NCMP = 255;
constexpr float EPS = 1e-6f;
constexpr int PER_PHASE = 10;
constexpr int N_LAUNCHES = MK_N_LAUNCHES;

constexpr size_t MiB = 1u << 20;
constexpr size_t WS_CTL = 0, CTL_ZERO_BYTES = 1 * MiB;
constexpr size_t WS_WGU1 = 2 * MiB, WS_WD1 = 13 * MiB, WS_WGU2 = 19 * MiB, WS_WD2 = 30 * MiB, WS_WIN = 36 * MiB, WS_WOUT = 41 * MiB, WS_CW1 = 43 * MiB;
constexpr size_t WS_WSB = 45 * MiB, WS_CB1P = 45 * MiB + 512 * 1024, WS_CW2 = 45 * MiB + 768 * 1024;
constexpr size_t WS_SS0 = 46 * MiB, WS_SS1 = 48 * MiB, WS_SS2 = 50 * MiB, WS_SS3 = 52 * MiB, WS_SSV = 54 * MiB;
constexpr size_t WS_XB = 56 * MiB;
constexpr size_t WS_ACT = 120 * MiB;
constexpr size_t WS_Y = 120 * MiB, WS_GVT = 184 * MiB, WS_KCR = 216 * MiB, WS_VCR = 224 * MiB, WS_KS = 232 * MiB, WS_VST = 240 * MiB, WS_KW = 248 * MiB, WS_VWT = 256 * MiB;
constexpr size_t WS_GATES = 264 * MiB, WS_H1 = 268 * MiB, WS_KCMP = 272 * MiB, WS_VCMPT = 272 * MiB + 512 * 1024;
constexpr size_t WS_END = 296 * MiB;
constexpr int CW_BAR = 4096;
constexpr int CW_Q = 8192;

constexpr int RING_OFF = 0, RING_BYTES = 147456;
constexpr int LDSCTL_OFF = RING_BYTES, MISC_OFF = LDSCTL_OFF + 320;
constexpr int TB_OFF = LDSCTL_OFF + 1024;
constexpr int TBL_OFF = LDSCTL_OFF + 2048;
constexpr int LDS_BYTES = 163840;

#define GAS __attribute__((address_space(1)))
#define LAS __attribute__((address_space(3)))
typedef unsigned short bf16;
typedef unsigned v4u __attribute__((ext_vector_type(4)));
typedef unsigned v2u __attribute__((ext_vector_type(2)));
typedef float f32x4 __attribute__((ext_vector_type(4)));
typedef GAS unsigned gu32;
#define RLX_AGENT __ATOMIC_RELAXED, __HIP_MEMORY_SCOPE_AGENT
#define LDS_WAIT() asm volatile("s_waitcnt lgkmcnt(0)" ::: "memory")
#define VM_WAIT() asm volatile("s_waitcnt vmcnt(0)" ::: "memory")
typedef float f32x2_c __attribute__((ext_vector_type(2))); typedef __bf16 bf16x2_c __attribute__((ext_vector_type(2)));
__device__ __forceinline__ unsigned pk2(float lo, float hi) { f32x2_c v = {lo, hi}; bf16x2_c b = __builtin_convertvector(v, bf16x2_c); return __builtin_bit_cast(unsigned, b); }
__device__ __forceinline__ unsigned f2bf(float f) { return pk2(f, f) & 0xffffu; }
__device__ __forceinline__ float bf2f(unsigned short b) { return __builtin_bit_cast(float, (unsigned)b << 16); }
__device__ __forceinline__ float wave_sum(float v) {
#pragma unroll
    for (int o = 1; o < 64; o <<= 1) v += __shfl_xor(v, o);
    return v;
}
__device__ __forceinline__ float wave_max(float v) {
#pragma unroll
    for (int o = 1; o < 64; o <<= 1) v = fmaxf(v, __shfl_xor(v, o));
    return v;
}
__device__ __forceinline__ float gelu_tanh(float x) { const float u2 = -2.302208198f * (x + 0.044715f * x * x * x); return x * __builtin_amdgcn_rcpf(1.f + __builtin_amdgcn_exp2f(u2)); }
__device__ __forceinline__ float sigmoidf_(float x) { return __builtin_amdgcn_rcpf(1.f + __builtin_amdgcn_exp2f(-1.4426950408889634f * x)); }

#define XB_TMO      128
#define XB_XCNT(j)  (256  + 64 * (j))
#define XB_XSUB(j)  (1280 + 64 * (j))
#define XB_XGEN(j)  (2304 + 64 * (j))
#define XB_TOP      3328
#define XB_TOPGEN   3392
#define XCD_BAR_WORDS 3456
#define XB_SPIN_CAP (1u << 22)
__device__ __forceinline__ unsigned xb_ld(unsigned* p)              { return __hip_atomic_load(p, __ATOMIC_RELAXED, __HIP_MEMORY_SCOPE_AGENT); }
__device__ __forceinline__ unsigned xb_add(unsigned* p, unsigned v) { return __hip_atomic_fetch_add(p, v, __ATOMIC_RELAXED, __HIP_MEMORY_SCOPE_AGENT); }
__device__ __forceinline__ unsigned xb_xcc_id() { return (unsigned)__builtin_amdgcn_s_getreg((3 << 11) | 20) & 0xFu; }
#define XB_SPIN(cond, bar) do { unsigned _sp = 0; while (cond) { __builtin_amdgcn_s_sleep(1); \
    if ((++_sp & 255u) == 0u) { if (xb_ld(&(bar)[XB_TMO])) break; if (_sp > XB_SPIN_CAP) { atomicAdd(&(bar)[XB_TMO], 1u); break; } } } } while (0)
struct XcdBarrier { unsigned* bar; unsigned x; volatile LAS unsigned* st; };
__device__ __forceinline__ XcdBarrier xcd_barrier_post(unsigned* bar, volatile LAS unsigned* st) {
    XcdBarrier b; b.bar = bar; b.x = xb_xcc_id(); b.st = st;
    if (threadIdx.x == 0) (void)xb_add(&bar[XB_XCNT(b.x)], 1u);
    return b;
}
__device__ __forceinline__ void xcd_barrier_complete(unsigned* bar, unsigned x, unsigned& nloc, unsigned& nx) {
    const unsigned G = gridDim.x * gridDim.y * gridDim.z;
    unsigned sum, cnt, mine, sp = 0u;
    for (;;) {
        sum = 0u; cnt = 0u; mine = 0u;
#pragma unroll
        for (unsigned j = 0; j < 16; ++j) { const unsigned c = xb_ld(&bar[XB_XCNT(j)]); sum += c; cnt += (c > 0u) ? 1u : 0u; mine = (j == x) ? c : mine; }
        if (sum == G) break;
        __builtin_amdgcn_s_sleep(1);
        if ((++sp & 255u) == 0u) { if (xb_ld(&bar[XB_TMO])) break; if (sp > XB_SPIN_CAP) { atomicAdd(&bar[XB_TMO], 1u); break; } }
    }
    nloc = mine > 0u ? mine : 1u; nx = cnt > 0u ? cnt : 1u;
}
__device__ __forceinline__ void xcd_barrier(const XcdBarrier& b) {
    asm volatile("s_waitcnt vmcnt(0)" ::: "memory");
    __syncthreads();
    if (threadIdx.x == 0) {
        unsigned* bar = b.bar;
        __builtin_amdgcn_s_waitcnt(0);
        unsigned nloc = b.st[0], nx = b.st[1];
        if (nloc == 0u) { xcd_barrier_complete(bar, b.x, nloc, nx); b.st[0] = nloc; b.st[1] = nx; }
        const unsigned old = xb_add(&bar[XB_XSUB(b.x)], 1u);
        const unsigned gen = old / nloc;
        if (old + 1u == (gen + 1u) * nloc) {
            __builtin_amdgcn_fence(__ATOMIC_RELEASE, "agent");
            asm volatile("s_waitcnt vmcnt(0)" ::: "memory");
            const unsigned og = xb_add(&bar[XB_TOP], 1u);
            const unsigned tg = og / nx;
            if (og + 1u == (tg + 1u) * nx) xb_add(&bar[XB_TOPGEN], 1u);
            else XB_SPIN(xb_ld(&bar[XB_TOPGEN]) == tg, bar);
            __builtin_amdgcn_fence(__ATOMIC_ACQUIRE, "agent");
            xb_add(&bar[XB_XGEN(b.x)], 1u);
            asm volatile("s_waitcnt vmcnt(0)" ::: "memory");
        } else {
            XB_SPIN(xb_ld(&bar[XB_XGEN(b.x)]) == gen, bar);
            __builtin_amdgcn_fence(__ATOMIC_ACQUIRE, "agent");
            asm volatile("s_waitcnt vmcnt(0)" ::: "memory");
        }
    }
    __syncthreads();
}

__device__ __forceinline__ float row_rinv(const float* ss, int row, int fq) {
    const f32x4 p = *(const f32x4*)(ss + (size_t)row * 16 + 4 * fq);
    float s = (p[0] + p[1]) + (p[2] + p[3]);
    s += __shfl_xor(s, 16); s += __shfl_xor(s, 32);
    return __builtin_amdgcn_rsqf(s * (1.f / DM) + EPS);
}
__device__ __forceinline__ float rsq_acc(float s, float invn) { return __builtin_amdgcn_rsqf(s * invn + EPS); }

struct EpiSwiGLU {
    static constexpr bool PERM = true;
    const float* ss; bf16* act;
    __device__ __forceinline__ void operator()(const f32x4 (&acc)[2][2][4][2], const pg8::Unit& u, int wr, int wc, int fr, int fq) const {
#pragma unroll
        for (int ai = 0; ai < 2; ++ai)
#pragma unroll
            for (int m = 0; m < 4; ++m) {
                const int row = u.pm * 256 + ai * 128 + wr * 64 + m * 16 + fr;
                const float ri = row_rinv(ss, row, fq);
                float o[8];
#pragma unroll
                for (int n = 0; n < 2; ++n)
#pragma unroll
                    for (int i = 0; i < 4; ++i) { const float g = acc[ai][0][m][n][i] * ri, up = acc[ai][1][m][n][i] * ri; o[n * 4 + i] = g * sigmoidf_(g) * up; }
                v4u w; w.x = pk2(o[0], o[1]); w.y = pk2(o[2], o[3]); w.z = pk2(o[4], o[5]); w.w = pk2(o[6], o[7]);
                *(v4u*)(act + (size_t)row * DFF + u.pn * 128 + wc * 32 + fq * 8) = w;
            }
    }
};
struct EpiResid {
    static constexpr bool PERM = false;
    const float* basef; const bf16* baseb; float* outf; bf16* outb; float* ssp; float scale;
    __device__ __forceinline__ void operator()(const f32x4 (&acc)[2][2][4][2], const pg8::Unit& u, int wr, int wc, int fr, int fq) const {
#pragma unroll
        for (int ai = 0; ai < 2; ++ai)
#pragma unroll
            for (int m = 0; m < 4; ++m) {
                const int row = u.pm * 256 + ai * 128 + wr * 64 + m * 16 + fr;
                float sq = 0.f;
#pragma unroll
                for (int bj = 0; bj < 2; ++bj)
#pragma unroll
                    for (int n = 0; n < 2; ++n) {
                        const size_t off = (size_t)row * DM + u.pn * 256 + bj * 128 + wc * 32 + n * 16 + fq * 4;
                        f32x4 b;
                        if (basef) b = *(const f32x4*)(basef + off);
                        else { const v2u rb = *(const v2u*)(baseb + off); b = (f32x4){__builtin_bit_cast(float, rb.x << 16), __builtin_bit_cast(float, rb.x & 0xffff0000u), __builtin_bit_cast(float, rb.y << 16), __builtin_bit_cast(float, rb.y & 0xffff0000u)}; }
                        const f32x4 o = b + acc[ai][bj][m][n] * scale;
                        if (outf) *(f32x4*)(outf + off) = o;
                        if (outb) { v2u w; w.x = pk2(o[0], o[1]); w.y = pk2(o[2], o[3]); *(v2u*)(outb + off) = w; }
                        sq += (o[0] * o[0] + o[1] * o[1]) + (o[2] * o[2] + o[3] * o[3]);
                    }
                sq += __shfl_xor(sq, 16); sq += __shfl_xor(sq, 32);
                if (fq == 0) ssp[(size_t)row * 16 + u.pn * 4 + wc] = sq;
            }
    }
};
struct EpiMix {
    static constexpr bool PERM = true;
    const float* ss; unsigned char* ws; const float* qg; const float* kg;
    __device__ __forceinline__ void operator()(const f32x4 (&acc)[2][2][4][2], const pg8::Unit& u, int wr, int wc, int fr, int fq) const {
        const int pn = u.pn;
        bf16* const Y = (bf16*)(ws + WS_Y); bf16* const GVT = (bf16*)(ws + WS_GVT); float* const SSV = (float*)(ws + WS_SSV); bf16* const KCR = (bf16*)(ws + WS_KCR); bf16* const VCR = (bf16*)(ws + WS_VCR);
        bf16* const KS = (bf16*)(ws + WS_KS); bf16* const VST = (bf16*)(ws + WS_VST); bf16* const KW = (bf16*)(ws + WS_KW); bf16* const VWT = (bf16*)(ws + WS_VWT); float* const GATES = (float*)(ws + WS_GATES);
        float gn[2][2][4];
        const float* gsrc = nullptr;
        if (pn == 4 || pn == 5) gsrc = qg; else if (pn == 7 && wc < 2) gsrc = kg + 64; else if (pn == 8 && wc < 2) gsrc = kg + 128;
#pragma unroll
        for (int bj = 0; bj < 2; ++bj)
#pragma unroll
            for (int n = 0; n < 2; ++n)
#pragma unroll
                for (int i = 0; i < 4; ++i) gn[bj][n][i] = gsrc ? gsrc[32 * bj + 8 * fq + 4 * n + i] : 1.f;
#pragma unroll
        for (int ai = 0; ai < 2; ++ai)
#pragma unroll
            for (int m = 0; m < 4; ++m) {
                const int row = u.pm * 256 + ai * 128 + wr * 64 + m * 16 + fr;
                const int b = row >> 12, t = row & 4095;
                const float ri = row_rinv(ss, row, fq);
                float v[2][2][4];
#pragma unroll
                for (int bj = 0; bj < 2; ++bj)
#pragma unroll
                    for (int n = 0; n < 2; ++n)
#pragma unroll
                        for (int i = 0; i < 4; ++i) v[bj][n][i] = acc[ai][bj][m][n][i] * ri;
                if (pn < 4) {
                    float sq = 0.f;
#pragma unroll
                    for (int bj = 0; bj < 2; ++bj)
#pragma unroll
                        for (int n = 0; n < 2; ++n)
#pragma unroll
                            for (int i = 0; i < 4; ++i) { const float x = gelu_tanh(v[bj][n][i]); v[bj][n][i] = x; sq += x * x; }
                    if (pn < 2) {
#pragma unroll
                        for (int bj = 0; bj < 2; ++bj) { v4u w; w.x = pk2(v[bj][0][0], v[bj][0][1]); w.y = pk2(v[bj][0][2], v[bj][0][3]); w.z = pk2(v[bj][1][0], v[bj][1][1]); w.w = pk2(v[bj][1][2], v[bj][1][3]);
                            *(v4u*)(Y + (size_t)row * DM + pn * 256 + wc * 64 + bj * 32 + fq * 8) = w; }
                    } else {
                        const int h = (pn - 2) * 4 + wc;
                        bf16* dst = GVT + ((size_t)(b * 8 + h) * 64) * SEQ + t;
#pragma unroll
                        for (int bj = 0; bj < 2; ++bj)
#pragma unroll
                            for (int n = 0; n < 2; ++n)
#pragma unroll
                                for (int i = 0; i < 4; ++i) dst[(size_t)(32 * bj + 8 * fq + 4 * n + i) * SEQ] = (bf16)f2bf(v[bj][n][i]);
                        sq += __shfl_xor(sq, 16); sq += __shfl_xor(sq, 32);
                        if (fq == 0) SSV[(size_t)row * 8 + (pn - 2) * 4 + wc] = sq;
                    }
                } else if (pn < 9) {
                    const bool is_q = (pn == 4 || pn == 5);
                    const bool is_k = (wc < 2);
                    const bool normed = is_q || ((pn == 7 || pn == 8) && is_k);
                    if (normed) {
                        float sq = 0.f;
#pragma unroll
                        for (int bj = 0; bj < 2; ++bj)
#pragma unroll
                            for (int n = 0; n < 2; ++n)
#pragma unroll
                                for (int i = 0; i < 4; ++i) sq += v[bj][n][i] * v[bj][n][i];
                        sq += __shfl_xor(sq, 16); sq += __shfl_xor(sq, 32);
                        const float rh = rsq_acc(sq, 1.f / 64.f) * (is_q ? 0.125f * 1.4426950408889634f : 1.f);
#pragma unroll
                        for (int bj = 0; bj < 2; ++bj)
#pragma unroll
                            for (int n = 0; n < 2; ++n)
#pragma unroll
                                for (int i = 0; i < 4; ++i) v[bj][n][i] *= rh * gn[bj][n][i];
                    }
                    if (is_q || is_k) {
                        bf16* dst;
                        if (is_q) dst = Y + (size_t)row * DM + 512 + (pn - 4) * 256 + wc * 64;
                        else { bf16* kb = (pn == 6) ? KCR : (pn == 7) ? KS : KW; dst = kb + ((size_t)(b * 2 + wc) * SEQ + t) * 64; }
#pragma unroll
                        for (int bj = 0; bj < 2; ++bj) { v4u w; w.x = pk2(v[bj][0][0], v[bj][0][1]); w.y = pk2(v[bj][0][2], v[bj][0][3]); w.z = pk2(v[bj][1][0], v[bj][1][1]); w.w = pk2(v[bj][1][2], v[bj][1][3]);
                            *(v4u*)(dst + bj * 32 + fq * 8) = w; }
                    } else if (pn == 6) {
                        bf16* dst = VCR + ((size_t)(b * 2 + (wc - 2)) * SEQ + t) * 64;
#pragma unroll
                        for (int bj = 0; bj < 2; ++bj) { v4u w; w.x = pk2(v[bj][0][0], v[bj][0][1]); w.y = pk2(v[bj][0][2], v[bj][0][3]); w.z = pk2(v[bj][1][0], v[bj][1][1]); w.w = pk2(v[bj][1][2], v[bj][1][3]);
                            *(v4u*)(dst + bj * 32 + fq * 8) = w; }
                    } else {
                        bf16* vb = (pn == 7) ? VST : VWT;
                        const int tp = (t & ~12) | ((t & 4) << 1) | ((t & 8) >> 1);
                        bf16* dst = vb + ((size_t)(b * 2 + (wc - 2)) * 64) * SEQ + tp;
#pragma unroll
                        for (int bj = 0; bj < 2; ++bj)
#pragma unroll
                            for (int n = 0; n < 2; ++n)
#pragma unroll
                                for (int i = 0; i < 4; ++i) dst[(size_t)(32 * bj + 8 * fq + 4 * n + i) * SEQ] = (bf16)f2bf(v[bj][n][i]);
                    }
                } else {
                    if (wc == 0 && fq < 3) {
                        f32x4 g0, g1;
#pragma unroll
                        for (int i = 0; i < 4; ++i) { g0[i] = sigmoidf_(v[0][0][i]); g1[i] = sigmoidf_(v[0][1][i]); }
                        *(f32x4*)(GATES + (size_t)row * 24 + fq * 8) = g0; *(f32x4*)(GATES + (size_t)row * 24 + fq * 8 + 4) = g1;
                    }
                }
            }
    }
};
struct EpiNone { static constexpr bool PERM = false;
    __device__ __forceinline__ void operator()(const f32x4 (&acc)[2][2][4][2], const pg8::Unit&, int, int, int, int) const {
#pragma unroll
        for (int a = 0; a < 2; ++a)
#pragma unroll
            for (int b = 0; b < 2; ++b)
#pragma unroll
                for (int m = 0; m < 4; ++m) asm volatile("" :: "v"(acc[a][b][m][0]), "v"(acc[a][b][m][1])); } };
struct EpiCmp {
    static constexpr bool PERM = true;
    const float* cb1p; bf16* H1;
    __device__ __forceinline__ void operator()(const f32x4 (&acc)[2][2][4][2], const pg8::Unit& u, int wr, int wc, int fr, int fq) const {
        float bias[2][2][4];
#pragma unroll
        for (int bj = 0; bj < 2; ++bj)
#pragma unroll
            for (int n = 0; n < 2; ++n)
#pragma unroll
                for (int i = 0; i < 4; ++i) { const int col = u.pn * 256 + bj * 128 + wc * 32 + fq * 8 + n * 4 + i; float s = 0.f;
#pragma unroll
                    for (int p = 0; p < 8; ++p) s += cb1p[p * 512 + col];
                    bias[bj][n][i] = s; }
#pragma unroll
        for (int ai = 0; ai < 2; ++ai)
#pragma unroll
            for (int m = 0; m < 4; ++m) {
                const int row = u.pm * 256 + ai * 128 + wr * 64 + m * 16 + fr;
#pragma unroll
                for (int bj = 0; bj < 2; ++bj) { float o[8];
#pragma unroll
                    for (int n = 0; n < 2; ++n)
#pragma unroll
                        for (int i = 0; i < 4; ++i) o[n * 4 + i] = gelu_tanh(acc[ai][bj][m][n][i] + bias[bj][n][i]);
                    v4u w; w.x = pk2(o[0], o[1]); w.y = pk2(o[2], o[3]); w.z = pk2(o[4], o[5]); w.w = pk2(o[6], o[7]);
                    *(v4u*)(H1 + (size_t)row * 256 + bj * 128 + wc * 32 + fq * 8) = w; }
            }
    }
};

struct Frame {
    LAS unsigned char* lds; volatile LAS unsigned* MISC; gu32* ctl;
    int tid, lane, wave, vcu, G;
};
struct Args { const float* in[24]; float* out; unsigned char* ws; int ph_lo, ph_hi, li, pad; };

__device__ __forceinline__ void p0_tr_item(const float* W, int ldw, int K, const float* gain, bf16* WT, int n0d, int sc0, int nv0, int sc1, int nv1, int kb, LAS float* scr, int lane) {
    const int k0 = 64 * kb, c16 = lane & 15, half = c16 >> 3, cc = (c16 & 7) * 4;
    const int sc = half ? sc1 : sc0, nv = half ? nv1 : nv0;
#pragma unroll 8
    for (int i = 0; i < 16; ++i) { const int kk = 4 * i + (lane >> 4);
        f32x4 x = {0.f, 0.f, 0.f, 0.f};
        if (cc < nv) { x = *(const f32x4*)(W + (size_t)(k0 + kk) * ldw + sc + cc); if (gain) x = x * gain[k0 + kk]; }
        *(LAS f32x4*)(scr + kk * 68 + c16 * 4) = x; }
    LDS_WAIT(); asm volatile("" ::: "memory");
#pragma unroll
    for (int kc = 0; kc < 8; ++kc) { const LAS float* sp = scr + (8 * kc) * 68 + lane;
        v4u o; o.x = pk2(sp[0 * 68], sp[1 * 68]); o.y = pk2(sp[2 * 68], sp[3 * 68]); o.z = pk2(sp[4 * 68], sp[5 * 68]); o.w = pk2(sp[6 * 68], sp[7 * 68]);
        *(GAS v4u*)(WT + (size_t)(n0d + lane) * K + k0 + 8 * kc) = o; }
    LDS_WAIT(); asm volatile("" ::: "memory");
}

__device__ __forceinline__ void p0_prologue(Frame& F, const Args& A) {
    unsigned char* ws = A.ws;
    LAS float* scr = (LAS float*)(F.lds + RING_OFF + F.wave * 17408);
    const int gw = F.vcu * NWAVES + F.wave, NGW = F.G * NWAVES, lane = F.lane;
    constexpr int I_GU = (DM / 64) * (NGU / 64), I_D = (DFF / 64) * (DM / 64), I_IN = (DM / 64) * (NIN / 64), I_OUT = (DM / 64) * (DM / 64), I_C1 = 2 * (2048 / 64) * (256 / 64);
    constexpr int I_WS = 8 * 128 * 128 / 64 / 8;
    constexpr int I_CB = 64, I_C2 = 64;
    constexpr int NITEMS = 2 * I_GU + 2 * I_D + I_IN + I_OUT + I_C1 + I_WS + I_CB + I_C2;
    for (int it = gw; it < NITEMS; it += NGW) {
        int r = it;
        if (r < 2 * I_GU) {
            const int f = r / I_GU; r -= f * I_GU; const int nblk = NGU / 64, kb = r / nblk, nb = r % nblk, n0 = 64 * nb, pn = n0 >> 8, bj = (n0 >> 7) & 1, j = n0 & 127;
            const float* W = f ? (bj ? A.in[21] : A.in[20]) : (bj ? A.in[3] : A.in[2]);
            p0_tr_item(W, DFF, DM, f ? A.in[19] : A.in[1], (bf16*)(ws + (f ? WS_WGU2 : WS_WGU1)), n0, 128 * pn + j, 32, 128 * pn + j + 32, 32, kb, scr, lane); continue; }
        r -= 2 * I_GU;
        if (r < 2 * I_D) {
            const int f = r / I_D; r -= f * I_D; const int nblk = DM / 64, kb = r / nblk, nb = r % nblk;
            p0_tr_item(f ? A.in[22] : A.in[4], DM, DFF, nullptr, (bf16*)(ws + (f ? WS_WD2 : WS_WD1)), 64 * nb, 64 * nb, 32, 64 * nb + 32, 32, kb, scr, lane); continue; }
        r -= 2 * I_D;
        if (r < I_IN) {
            const int nblk = NIN / 64, kb = r / nblk, nb = r % nblk, n0 = 64 * nb, pn = n0 >> 8, tc = n0 & 255;
            const int col0 = 256 * pn + 64 * ((tc >> 5) & 3) + 32 * (tc >> 7), col1 = 256 * pn + 64 * (((tc + 32) >> 5) & 3) + 32 * ((tc + 32) >> 7);
            int nv0 = INC - col0; nv0 = nv0 < 0 ? 0 : (nv0 > 32 ? 32 : nv0); int nv1 = INC - col1; nv1 = nv1 < 0 ? 0 : (nv1 > 32 ? 32 : nv1);
            p0_tr_item(A.in[6], INC, DM, A.in[5], (bf16*)(ws + WS_WIN), n0, col0, nv0, col1, nv1, kb, scr, lane); continue; }
        r -= I_IN;
        if (r < I_OUT) { const int nblk = DM / 64, kb = r / nblk, nb = r % nblk;
            p0_tr_item(A.in[18], DM, DM, nullptr, (bf16*)(ws + WS_WOUT), 64 * nb, 64 * nb, 32, 64 * nb + 32, 32, kb, scr, lane); continue; }
        r -= I_OUT;
        if (r < I_C1) { const int kv = r / (I_C1 / 2); r -= kv * (I_C1 / 2); const int nblk = 256 / 64, kb = r / nblk, nb = r % nblk;
            p0_tr_item(A.in[13] + (size_t)kv * 2048 * 256, 256, 2048, nullptr, (bf16*)(ws + WS_CW1) + (size_t)kv * 256 * 2048, 64 * nb, 64 * nb, 32, 64 * nb + 32, 32, kb, scr, lane); continue; }
        r -= I_C1;
        if (r < I_WS) {
            const int e0 = (r * 64 + lane) * 8; const int s0 = e0 & 127, t = (e0 >> 7) & 127;
            const float* src = A.in[8] + e0; unsigned o[4];
#pragma unroll
            for (int i = 0; i < 4; ++i) { const float a = (s0 + 2 * i <= t) ? src[2 * i] : 0.f, b2 = (s0 + 2 * i + 1 <= t) ? src[2 * i + 1] : 0.f; o[i] = pk2(a, b2); }
            *(v4u*)((bf16*)(ws + WS_WSB) + e0) = (v4u){o[0], o[1], o[2], o[3]}; continue; }
        r -= I_WS;
        if (r >= I_CB) {
            r -= I_CB; const int e0 = (r * 64 + lane) * 8, kv = e0 >> 14, d = (e0 >> 8) & 63, j0 = e0 & 255;
            const float* src = A.in[15] + (size_t)kv * 256 * 64 + d; unsigned o[4];
#pragma unroll
            for (int i = 0; i < 4; ++i) o[i] = pk2(src[(size_t)(j0 + 2 * i) * 64], src[(size_t)(j0 + 2 * i + 1) * 64]);
            *(v4u*)((bf16*)(ws + WS_CW2) + e0) = (v4u){o[0], o[1], o[2], o[3]}; continue; }
        {
            const int kp = r & 7, jb = (r >> 3) & 3, kv = r >> 5, j = jb * 64 + lane;
            const float* pe = A.in[12] + (size_t)kv * 2048; const float* w1 = A.in[13] + (size_t)kv * 2048 * 256;
            float s = (kp == 0) ? A.in[14][kv * 256 + j] : 0.f;
            for (int k = kp * 256; k < kp * 256 + 256; ++k) s += pe[k] * w1[(size_t)k * 256 + j];
            ((float*)(ws + WS_CB1P))[kp * 512 + kv * 256 + j] = s;
        }
    }
    const float* x = A.in[0]; bf16* XB = (bf16*)(ws + WS_XB); float* SS0 = (float*)(ws + WS_SS0);
    for (int m0 = 2 * gw; m0 < MTOK; m0 += 2 * NGW) {
        f32x4 v[2][4];
#pragma unroll
        for (int rr = 0; rr < 2; ++rr) { const GAS f32x4* xr = (const GAS f32x4*)(x + (size_t)(m0 + rr) * DM) + lane;
#pragma unroll
            for (int j = 0; j < 4; ++j) v[rr][j] = xr[64 * j]; }
#pragma unroll
        for (int rr = 0; rr < 2; ++rr) { GAS unsigned long long* o8 = (GAS unsigned long long*)(XB + (size_t)(m0 + rr) * DM) + lane; float sq = 0.f;
#pragma unroll
            for (int j = 0; j < 4; ++j) { const f32x4 t = v[rr][j]; sq += (t.x * t.x + t.y * t.y) + (t.z * t.z + t.w * t.w);
                o8[64 * j] = (unsigned long long)pk2(t.x, t.y) | ((unsigned long long)pk2(t.z, t.w) << 32); }
            sq = wave_sum(sq);
            if (lane < 16) SS0[(size_t)(m0 + rr) * 16 + lane] = (lane == 0) ? sq : 0.f; }
    }
}

__device__ __forceinline__ void gmlp_unit(Frame& F, const Args& A, int unit) {
    typedef short bf16x8 __attribute__((ext_vector_type(8)));
    typedef float f32x16 __attribute__((ext_vector_type(16)));
    unsigned char* ws = A.ws;
    const int b = unit >> 5, c = unit & 31, r0 = b * SEQ + c * 128, tid = F.tid, lane = F.lane, w = F.wave, r = lane & 31, hh = lane >> 5, tt = w >> 1, dt = w & 1;
    LAS unsigned char* L = F.lds + RING_OFF;
    LAS float* rv = (LAS float*)(L + 131072); LAS float* gvl = rv + 128; LAS float* bsl = gvl + 512;
    { const float* SSV = (const float*)(ws + WS_SSV);
      if (tid < 128) { const f32x4 p0 = *(const f32x4*)(SSV + (size_t)(r0 + tid) * 8), p1 = *(const f32x4*)(SSV + (size_t)(r0 + tid) * 8 + 4);
          rv[tid] = rsq_acc(((p0[0] + p0[1]) + (p0[2] + p0[3])) + ((p1[0] + p1[1]) + (p1[2] + p1[3])), 1.f / 512.f); }
      gvl[tid] = A.in[7][tid]; bsl[tid] = A.in[9][tid]; bsl[512 + tid] = A.in[9][512 + tid]; }
    asm volatile("s_waitcnt vmcnt(0) lgkmcnt(0)" ::: "memory");
    __syncthreads();
    const bf16* GVT = (const bf16*)(ws + WS_GVT) + ((size_t)(b * 8) * 64) * SEQ + c * 128;
    const bf16* WSB = (const bf16*)(ws + WS_WSB);
    bf16* Y = (bf16*)(ws + WS_Y) + (size_t)r0 * DM;
#define GM_DMA(h) do { const int h_ = (h); LAS unsigned char* B_ = L + (h_ & 1) * 65536; \
        _Pragma("unroll") for (int q_ = 0; q_ < 2; ++q_) { const int d_ = 4 * (2 * w + q_) + (lane >> 4), cs_ = (lane & 15) ^ (d_ & 15); \
            __builtin_amdgcn_global_load_lds((const unsigned*)(GVT + ((size_t)h_ * 64 + d_) * SEQ + 8 * cs_), (LAS unsigned*)(B_ + (2 * w + q_) * 1024), 16, 0, 0); } \
        _Pragma("unroll") for (int q_ = 0; q_ < 4; ++q_) { const int t_ = 4 * (4 * w + q_) + (lane >> 4), cs_ = (lane & 15) ^ (t_ & 15); \
            __builtin_amdgcn_global_load_lds((const unsigned*)(WSB + ((size_t)h_ * 128 + t_) * 128 + 8 * cs_), (LAS unsigned*)(B_ + 16384 + (4 * w + q_) * 1024), 16, 0, 0); } \
        _Pragma("unroll") for (int q_ = 0; q_ < 2; ++q_) { const int t_ = 8 * (2 * w + q_) + (lane >> 3), cs_ = (lane & 7) ^ (t_ & 7); \
            __builtin_amdgcn_global_load_lds((const unsigned*)(Y + (size_t)t_ * DM + h_ * 64 + 8 * cs_), (LAS unsigned*)(B_ + 49152 + (2 * w + q_) * 1024), 16, 0, 0); } } while (0)
    GM_DMA(0);
#pragma unroll 1
    for (int h = 0; h < 8; ++h) {
        if (h + 1 < 8) { GM_DMA(h + 1); asm volatile("s_waitcnt vmcnt(8)" ::: "memory"); } else asm volatile("s_waitcnt vmcnt(0)" ::: "memory");
        __builtin_amdgcn_s_barrier(); asm volatile("" ::: "memory");
        const LAS unsigned char* B = L + (h & 1) * 65536;
        f32x16 acc;
#pragma unroll
        for (int i = 0; i < 16; ++i) acc[i] = 0.f;
        const int d = 32 * dt + r, t = 32 * tt + r;
#pragma unroll
        for (int ks = 0; ks < 8; ++ks) {
            if (ks <= 2 * tt + 1) {
                const int s0 = 16 * ks + 8 * hh;
                const v4u raw = *(const LAS v4u*)(B + d * 256 + (((2 * ks + hh) ^ (d & 15)) * 16));
                const f32x4 ra = *(const LAS f32x4*)(rv + s0), rb = *(const LAS f32x4*)(rv + s0 + 4);
                v4u o; o.x = pk2(__builtin_bit_cast(float, raw.x << 16) * ra[0], __builtin_bit_cast(float, raw.x & 0xffff0000u) * ra[1]);
                o.y = pk2(__builtin_bit_cast(float, raw.y << 16) * ra[2], __builtin_bit_cast(float, raw.y & 0xffff0000u) * ra[3]);
                o.z = pk2(__builtin_bit_cast(float, raw.z << 16) * rb[0], __builtin_bit_cast(float, raw.z & 0xffff0000u) * rb[1]);
                o.w = pk2(__builtin_bit_cast(float, raw.w << 16) * rb[2], __builtin_bit_cast(float, raw.w & 0xffff0000u) * rb[3]);
                const bf16x8 wf = *(const LAS bf16x8*)(B + 16384 + t * 256 + (((2 * ks + hh) ^ (t & 15)) * 16));
                acc = __builtin_amdgcn_mfma_f32_32x32x16_bf16(__builtin_bit_cast(bf16x8, o), wf, acc, 0, 0, 0);
            }
        }
        {
            const float bt = bsl[h * 128 + t];
            LAS unsigned char* U = L + (h & 1) * 65536 + 49152 + t * 128;
#pragma unroll
            for (int q = 0; q < 4; ++q) { const int dd = 32 * dt + 8 * q + 4 * hh; LAS v2u* up = (LAS v2u*)(U + (((4 * dt + q) ^ (t & 7)) * 16) + 8 * hh);
                const f32x4 gg = *(const LAS f32x4*)(gvl + h * 64 + dd); const v2u uu = *up;
                const float o0 = __builtin_bit_cast(float, uu.x << 16) * (acc[4 * q] * gg[0] + bt), o1 = __builtin_bit_cast(float, uu.x & 0xffff0000u) * (acc[4 * q + 1] * gg[1] + bt);
                const float o2 = __builtin_bit_cast(float, uu.y << 16) * (acc[4 * q + 2] * gg[2] + bt), o3 = __builtin_bit_cast(float, uu.y & 0xffff0000u) * (acc[4 * q + 3] * gg[3] + bt);
                *up = (v2u){pk2(o0, o1), pk2(o2, o3)}; }
        }
        asm volatile("s_waitcnt lgkmcnt(0)" ::: "memory"); __builtin_amdgcn_s_barrier(); asm volatile("" ::: "memory");
#pragma unroll
        for (int i = 0; i < 2; ++i) { const int e = tid + 512 * i, tr = e >> 3, pp = e & 7, cs = pp ^ (tr & 7);
            const v4u val = *(const LAS v4u*)(L + (h & 1) * 65536 + 49152 + tr * 128 + pp * 16);
            *(v4u*)(Y + (size_t)tr * DM + h * 64 + 8 * cs) = val; }
        asm volatile("s_waitcnt lgkmcnt(0)" ::: "memory"); __builtin_amdgcn_s_barrier(); asm volatile("" ::: "memory");
    }
#undef GM_DMA
    asm volatile("s_waitcnt vmcnt(0)" ::: "memory");
    __syncthreads();
}
__device__ __forceinline__ void cmp_unit(Frame& F, const Args& A, int unit) {
    typedef short bf16x8 __attribute__((ext_vector_type(8)));
    typedef float f32x16 __attribute__((ext_vector_type(16)));
    unsigned char* ws = A.ws;
    const int tid = F.tid, lane = F.lane, w = F.wave, r = lane & 31, hh = lane >> 5;
    const int row0 = unit * 32, kv = row0 >> 12;
    LAS unsigned char* L = F.lds + RING_OFF;
    const bf16* X = (const bf16*)(ws + WS_KCR) + (size_t)row0 * 1024;
#pragma unroll
    for (int i = 0; i < 9; ++i) { const int pos = 512 * i + tid; if (i < 8 || w < 2) { const int Fc = pos ^ ((pos >> 7) & 7);
        __builtin_amdgcn_global_load_lds((const unsigned*)(X + (size_t)Fc * 8), (LAS unsigned*)(L + (512 * i + 64 * w) * 16), 16, 0, 0); } }
    const bf16* W1 = (const bf16*)(ws + WS_CW1) + ((size_t)kv * 256 + 32 * w) * 2048;
    LAS unsigned char* WB = L + 67584 + w * 8192;
#define CM_DMA(kc) do { const int kc_ = (kc); _Pragma("unroll") for (int q_ = 0; q_ < 4; ++q_) { const int rr_ = 8 * q_ + (lane >> 3), cs_ = (lane & 7) ^ (rr_ & 7); \
        __builtin_amdgcn_global_load_lds((const unsigned*)(W1 + (size_t)rr_ * 2048 + 64 * kc_ + 8 * cs_), (LAS unsigned*)(WB + (kc_ & 1) * 4096 + q_ * 1024), 16, 0, 0); } } while (0)
    CM_DMA(0);
    asm volatile("s_waitcnt vmcnt(4)" ::: "memory");
    __builtin_amdgcn_s_barrier(); asm volatile("" ::: "memory");
    f32x16 acc;
#pragma unroll
    for (int i = 0; i < 16; ++i) acc[i] = 0.f;
#pragma unroll 1
    for (int kc = 0; kc < 32; ++kc) {
        if (kc + 1 < 32) { CM_DMA(kc + 1); asm volatile("s_waitcnt vmcnt(4)" ::: "memory"); } else asm volatile("s_waitcnt vmcnt(0)" ::: "memory");
        const LAS unsigned char* wb = WB + (kc & 1) * 4096 + r * 128;
#pragma unroll
        for (int ks = 0; ks < 4; ++ks) {
            const bf16x8 wf = *(const LAS bf16x8*)(wb + (((2 * ks + hh) ^ (r & 7)) * 16));
            const int Fc = 128 * r + 8 * kc + 2 * ks + hh;
            const bf16x8 xf = *(const LAS bf16x8*)(L + ((Fc ^ ((Fc >> 7) & 7)) * 16));
            acc = __builtin_amdgcn_mfma_f32_32x32x16_bf16(wf, xf, acc, 0, 0, 0);
        }
        asm volatile("s_waitcnt lgkmcnt(0)" ::: "memory");
    }
#undef CM_DMA
    const float* cb1p = (const float*)(ws + WS_CB1P) + kv * 256 + 32 * w;
    float bias[4][4];
#pragma unroll
    for (int q = 0; q < 4; ++q)
#pragma unroll
        for (int i = 0; i < 4; ++i) { const int col = 8 * q + 4 * hh + i; float bsum = 0.f;
#pragma unroll
            for (int pz = 0; pz < 8; ++pz) bsum += cb1p[pz * 512 + col];
            bias[q][i] = bsum; }
    __syncthreads();
    LAS unsigned char* HL = L;
#pragma unroll
    for (int q = 0; q < 4; ++q) { float o[4];
#pragma unroll
        for (int i = 0; i < 4; ++i) o[i] = gelu_tanh(acc[4 * q + i] + bias[q][i]);
        *(LAS v2u*)(HL + r * 528 + (32 * w + 8 * q + 4 * hh) * 2) = (v2u){pk2(o[0], o[1]), pk2(o[2], o[3])}; }
    __syncthreads();
    if (w == 0) {
        const bf16* W2 = (const bf16*)(ws + WS_CW2) + (size_t)kv * 64 * 256;
        f32x16 a2[2];
#pragma unroll
        for (int i = 0; i < 16; ++i) { a2[0][i] = 0.f; a2[1][i] = 0.f; }
#pragma unroll
        for (int ks = 0; ks < 16; ++ks) {
            const bf16x8 hf = *(const LAS bf16x8*)(HL + r * 528 + (16 * ks + 8 * hh) * 2);
#pragma unroll
            for (int dt = 0; dt < 2; ++dt) { const bf16x8 wf = *(const bf16x8*)(W2 + (size_t)(32 * dt + r) * 256 + 16 * ks + 8 * hh);
                a2[dt] = __builtin_amdgcn_mfma_f32_32x32x16_bf16(wf, hf, a2[dt], 0, 0, 0); }
        }
        const float* b2 = A.in[16] + kv * 64; const float* kg0 = A.in[11];
        float sq = 0.f;
#pragma unroll
        for (int dt = 0; dt < 2; ++dt)
#pragma unroll
            for (int i = 0; i < 16; ++i) { const int d = 32 * dt + (i & 3) + 8 * (i >> 2) + 4 * hh; a2[dt][i] += b2[d]; sq += a2[dt][i] * a2[dt][i]; }
        const int row = row0 + r, n = row & 255, bg = (row & 4095) >> 8;
        if (kv == 0) {
            sq += __shfl_xor(sq, 32); const float rn = rsq_acc(sq, 1.f / 64.f);
            bf16* dst = (bf16*)(ws + WS_KCMP) + ((size_t)bg * 256 + n) * 64;
#pragma unroll
            for (int dt = 0; dt < 2; ++dt)
#pragma unroll
                for (int q = 0; q < 4; ++q) { const int d = 32 * dt + 8 * q + 4 * hh; const f32x4 gg = *(const f32x4*)(kg0 + d);
                    v2u wv; wv.x = pk2(a2[dt][4 * q] * rn * gg[0], a2[dt][4 * q + 1] * rn * gg[1]); wv.y = pk2(a2[dt][4 * q + 2] * rn * gg[2], a2[dt][4 * q + 3] * rn * gg[3]);
                    *(v2u*)(dst + d) = wv; }
        } else {
            const int np = (n & ~12) | ((n & 4) << 1) | ((n & 8) >> 1);
            bf16* dst = (bf16*)(ws + WS_VCMPT) + (size_t)bg * 64 * 256 + np;
#pragma unroll
            for (int dt = 0; dt < 2; ++dt)
#pragma unroll
                for (int i = 0; i < 16; ++i) { const int d = 32 * dt + (i & 3) + 8 * (i >> 2) + 4 * hh; dst[(size_t)d * 256] = (bf16)f2bf(a2[dt][i]); }
        }
    }
    __syncthreads();
}

#define TSTAMP() __builtin_amdgcn_s_memrealtime()
namespace att {
typedef short bf16x8 __attribute__((ext_vector_type(8)));
typedef short s16x4 __attribute__((ext_vector_type(4)));
typedef float f32x16 __attribute__((ext_vector_type(16)));
typedef float f32x2_t __attribute__((ext_vector_type(2))); typedef __bf16 bf16x2_t __attribute__((ext_vector_type(2)));
constexpr int TILEB = 8192, NSLOT = 6;
constexpr int OFF_KV = 0, OFF_IMP = NSLOT * 2 * TILEB, OFF_MSK = OFF_IMP + 8 * 2048, ATT_LDS = OFF_MSK + 512;
constexpr float NEGBIG = -30000.f;
__device__ __forceinline__ unsigned cvtpk(float lo, float hi) { f32x2_t v = {lo, hi}; bf16x2_t b = __builtin_convertvector(v, bf16x2_t); return __builtin_bit_cast(unsigned, b); }
__device__ __forceinline__ int crow(int r, int hi) { return (r & 3) + 8 * (r >> 2) + 4 * hi; }
__device__ __forceinline__ float xhalf(float x) { return __shfl_xor(x, 32); }
constexpr int TR_D0 = 575, TR_N = 640, OFF_TR = 115712;
enum { FAR = 0, NEARS = 1, NEARW = 2, NEARC = 3 };
#define SBAR() __builtin_amdgcn_sched_barrier(0)
template <int MODE, bool CMP, bool MASKED>
__device__ __forceinline__ void tile(const LAS unsigned char* Kb, const LAS unsigned char* Vb, const bf16x8 (&qf)[4], bool rowsel, const LAS float* trh, int kidx0,
                                     f32x16 (&O)[2], float& l, float (&u)[2][4], float& carry, int r, int hh) {
    constexpr int ES = CMP ? 16 : 1;
    const LAS float* trb = trh + kidx0;
    f32x16 S[2];
    bf16x8 pf[2][2], kf[2][4], vf[4];
    float ls = 0.f;
    const unsigned pmask = rowsel ? 0xffffffffu : 0u;
#define ATT_B(a, i) do { float s_ = S[a][i]; const int e_ = ES * (32 * (a) + ((i) & 3) + 8 * ((i) >> 2)); \
        if (MODE == NEARS || MODE == NEARW) s_ += trb[e_]; \
        if (MODE == NEARC) { int k_ = kidx0 + e_; k_ = k_ < 0 ? 0 : (k_ < TR_N - 1 ? k_ : TR_N - 1); s_ += trh[k_]; } \
        float p_ = __builtin_amdgcn_exp2f(s_); \
        if (MODE == NEARW) p_ = (kidx0 + e_ >= TR_D0 - 511) ? p_ : 0.f; \
        S[a][i] = p_; ls += p_; } while (0)
#define ATT_B4(a, i0) do { ATT_B(a, (i0)); ATT_B(a, (i0) + 1); ATT_B(a, (i0) + 2); ATT_B(a, (i0) + 3); } while (0)
#define ATT_PACK(a) do { _Pragma("unroll") for (int s2 = 0; s2 < 2; ++s2) { v4u w_ = {cvtpk(S[a][8 * s2 + 0], S[a][8 * s2 + 1]), cvtpk(S[a][8 * s2 + 2], S[a][8 * s2 + 3]), cvtpk(S[a][8 * s2 + 4], S[a][8 * s2 + 5]), cvtpk(S[a][8 * s2 + 6], S[a][8 * s2 + 7])}; \
        if (MASKED) { w_.x &= pmask; w_.y &= pmask; w_.z &= pmask; w_.w &= pmask; } \
        pf[a][s2] = __builtin_bit_cast(bf16x8, w_); } } while (0)
#define ATT_U(a) do { if (CMP) { float rq_[4]; _Pragma("unroll") for (int q = 0; q < 4; ++q) rq_[q] = xhalf(S[a][4 * q + 3]); \
        _Pragma("unroll") for (int q = 0; q < 4; ++q) { const float own_ = (S[a][4 * q] + S[a][4 * q + 1]) + (S[a][4 * q + 2] + S[a][4 * q + 3]); \
            const float prev_ = hh ? rq_[q] : (q > 0 ? rq_[q - 1] : carry); u[a][q] = own_ + prev_; } carry = rq_[3]; } } while (0)
#define ATT_VRD(m, a) vf[m] = *(const LAS bf16x8*)(Vb + (32 * ((m) & 1) + r) * 128 + (((4 * (a) + 2 * ((m) >> 1) + hh) ^ (r & 7)) * 16))
    const f32x16 zero = {0.f, 0.f, 0.f, 0.f, 0.f, 0.f, 0.f, 0.f, 0.f, 0.f, 0.f, 0.f, 0.f, 0.f, 0.f, 0.f};
#pragma unroll
    for (int kk = 0; kk < 4; ++kk) kf[0][kk] = *(const LAS bf16x8*)(Kb + r * 128 + (((2 * kk + hh) ^ (r & 7)) * 16));
    SBAR();
#define ATT_KRD(kk) kf[1][kk] = *(const LAS bf16x8*)(Kb + (32 + r) * 128 + (((2 * (kk) + hh) ^ (r & 7)) * 16))
    S[0] = __builtin_amdgcn_mfma_f32_32x32x16_bf16(kf[0][0], qf[0], zero, 0, 0, 0); ATT_KRD(0); SBAR();
    S[0] = __builtin_amdgcn_mfma_f32_32x32x16_bf16(kf[0][1], qf[1], S[0], 0, 0, 0); ATT_KRD(1); SBAR();
    S[0] = __builtin_amdgcn_mfma_f32_32x32x16_bf16(kf[0][2], qf[2], S[0], 0, 0, 0); ATT_KRD(2); SBAR();
    S[0] = __builtin_amdgcn_mfma_f32_32x32x16_bf16(kf[0][3], qf[3], S[0], 0, 0, 0); ATT_KRD(3); SBAR();
#undef ATT_KRD
    S[1] = __builtin_amdgcn_mfma_f32_32x32x16_bf16(kf[1][0], qf[0], zero, 0, 0, 0); ATT_VRD(0, 0); ATT_B4(0, 0); SBAR();
    S[1] = __builtin_amdgcn_mfma_f32_32x32x16_bf16(kf[1][1], qf[1], S[1], 0, 0, 0); ATT_VRD(1, 0); ATT_B4(0, 4); SBAR();
    S[1] = __builtin_amdgcn_mfma_f32_32x32x16_bf16(kf[1][2], qf[2], S[1], 0, 0, 0); ATT_VRD(2, 0); ATT_B4(0, 8); SBAR();
    S[1] = __builtin_amdgcn_mfma_f32_32x32x16_bf16(kf[1][3], qf[3], S[1], 0, 0, 0); ATT_VRD(3, 0); ATT_B4(0, 12); SBAR();
    ATT_U(0); ATT_PACK(0); SBAR();
    O[0] = __builtin_amdgcn_mfma_f32_32x32x16_bf16(vf[0], pf[0][0], O[0], 0, 0, 0); ATT_VRD(0, 1); ATT_B4(1, 0); SBAR();
    O[1] = __builtin_amdgcn_mfma_f32_32x32x16_bf16(vf[1], pf[0][0], O[1], 0, 0, 0); ATT_VRD(1, 1); ATT_B4(1, 4); SBAR();
    O[0] = __builtin_amdgcn_mfma_f32_32x32x16_bf16(vf[2], pf[0][1], O[0], 0, 0, 0); ATT_VRD(2, 1); ATT_B4(1, 8); SBAR();
    O[1] = __builtin_amdgcn_mfma_f32_32x32x16_bf16(vf[3], pf[0][1], O[1], 0, 0, 0); ATT_VRD(3, 1); ATT_B4(1, 12); SBAR();
    ATT_U(1); ATT_PACK(1); SBAR();
    O[0] = __builtin_amdgcn_mfma_f32_32x32x16_bf16(vf[0], pf[1][0], O[0], 0, 0, 0);
    O[1] = __builtin_amdgcn_mfma_f32_32x32x16_bf16(vf[1], pf[1][0], O[1], 0, 0, 0);
    O[0] = __builtin_amdgcn_mfma_f32_32x32x16_bf16(vf[2], pf[1][1], O[0], 0, 0, 0);
    O[1] = __builtin_amdgcn_mfma_f32_32x32x16_bf16(vf[3], pf[1][1], O[1], 0, 0, 0);
    l += (MASKED && !rowsel) ? 0.f : ls;
#undef ATT_B
#undef ATT_B4
#undef ATT_PACK
#undef ATT_U
#undef ATT_VRD
}
#undef SBAR
}

__device__ __forceinline__ void attn_unit(Frame& F, const Args& A, int bg, int c, size_t ydst_off, unsigned long long& tacc) {
    using namespace att;
    unsigned char* ws = A.ws;
    int tid = F.tid; asm volatile("" : "+v"(tid));
    const int lane = tid & 63, w = F.wave, r = lane & 31, hh = lane >> 5, hg = r >> 3, qi = r & 7;
    const int b = bg >> 1, g = bg & 1, h = g * 4 + hg;
    const int t = 64 * c + 8 * w + qi; const size_t tok = (size_t)b * SEQ + t;
    LAS unsigned char* L = F.lds + RING_OFF;
    const LAS float* tblh = (const LAS float*)(F.lds + TBL_OFF) + h * 132;
    const LAS float* trh = (const LAS float*)(L + OFF_TR) + h * TR_N;
    bf16* Y = (bf16*)(ws + WS_Y);
    bf16* yrow = Y + tok * DM + 512 + h * 64;
    if (DBG_T == 60) tacc -= TSTAMP();
    bf16x8 qf[4];
#pragma unroll
    for (int kk = 0; kk < 4; ++kk) qf[kk] = *(const bf16x8*)(yrow + 16 * kk + 8 * hh);
    const int nc = (c >> 4) + 1, ns = c + 1, w0 = c > 8 ? c - 8 : 0, nw = c - w0 + 1, ntile = nc + ns + nw;
    const int srow = tid >> 3, sch = (tid & 7) ^ (srow & 7);
    const unsigned ldsw = (unsigned)w * 1024u;
#define ATT_DMA(i) do { const int i_ = (i); const bf16* kp_; const bf16* vp_; size_t ldv_; \
        if (i_ < nc) { kp_ = (const bf16*)(ws + WS_KCMP) + ((size_t)bg * 256 + 64 * i_) * 64; vp_ = (const bf16*)(ws + WS_VCMPT) + (size_t)bg * 64 * 256 + 64 * i_; ldv_ = 256; } \
        else if (i_ < nc + ns) { const int j_ = i_ - nc; kp_ = (const bf16*)(ws + WS_KS) + ((size_t)bg * SEQ + 64 * j_) * 64; vp_ = (const bf16*)(ws + WS_VST) + (size_t)bg * 64 * SEQ + 64 * j_; ldv_ = SEQ; } \
        else { const int j_ = w0 + i_ - nc - ns; kp_ = (const bf16*)(ws + WS_KW) + ((size_t)bg * SEQ + 64 * j_) * 64; vp_ = (const bf16*)(ws + WS_VWT) + (size_t)bg * 64 * SEQ + 64 * j_; ldv_ = SEQ; } \
        const int sl_ = ((i_ >> 1) % 3) * 2 + (i_ & 1); \
        __builtin_amdgcn_global_load_lds((const unsigned*)(kp_ + srow * 64 + sch * 8), (LAS unsigned*)(L + OFF_KV + sl_ * 2 * TILEB + ldsw), 16, 0, 0); \
        __builtin_amdgcn_global_load_lds((const unsigned*)(vp_ + (size_t)srow * ldv_ + sch * 8), (LAS unsigned*)(L + OFF_KV + sl_ * 2 * TILEB + TILEB + ldsw), 16, 0, 0); } while (0)
#define ATT_WAITN(n) do { const int n_ = (n); if (n_ >= 2) asm volatile("s_waitcnt vmcnt(4) lgkmcnt(0)" ::: "memory"); else if (n_ == 1) asm volatile("s_waitcnt vmcnt(2) lgkmcnt(0)" ::: "memory"); \
        else asm volatile("s_waitcnt vmcnt(0) lgkmcnt(0)" ::: "memory"); } while (0)
#define ATT_NEXT(i) do { if (((i) & 1) == 0) { if ((i) + 4 < ntile) ATT_DMA((i) + 4); if ((i) + 5 < ntile) ATT_DMA((i) + 5); } if (DBG_T == 1) tacc -= TSTAMP(); } while (0)
#define ATT_FLIP(i) do { if (DBG_T == 1) tacc += TSTAMP(); if ((((i) & 1) == 1) || (i) + 1 == ntile) { if (DBG_T == 2) tacc -= TSTAMP(); \
        const int s2_ = ((i) | 1) + 3; ATT_WAITN(s2_ + 1 < ntile ? 2 : (s2_ < ntile ? 1 : 0)); \
        __builtin_amdgcn_s_barrier(); asm volatile("" ::: "memory"); if (DBG_T == 2) tacc += TSTAMP(); } } while (0)
    ATT_DMA(0); if (ntile > 1) ATT_DMA(1); if (ntile > 2) ATT_DMA(2); if (ntile > 3) ATT_DMA(3);
    ATT_WAITN(ntile > 3 ? 2 : (ntile > 2 ? 1 : 0));
    __builtin_amdgcn_s_barrier(); asm volatile("" ::: "memory");
    asm volatile("" : "+v"(qf[0]), "+v"(qf[1]), "+v"(qf[2]), "+v"(qf[3]));
    if (DBG_T == 60) tacc += TSTAMP();
    f32x16 out[2], O[2];
#pragma unroll
    for (int i = 0; i < 16; ++i) { out[0][i] = 0.f; out[1][i] = 0.f; O[0][i] = 0.f; O[1][i] = 0.f; }
    float l = 0.f, carry = 0.f, dummy_u[2][4];
    int it = 0;
    float u[4][2][4];
#pragma unroll
    for (int i = 0; i < 4; ++i)
#pragma unroll
        for (int a = 0; a < 2; ++a)
#pragma unroll
            for (int q = 0; q < 4; ++q) u[i][a][q] = 0.f;
#pragma unroll
    for (int i = 0; i < 4; ++i) {
        if (i < nc) {
            ATT_NEXT(it);
            const LAS unsigned char* Kb = L + OFF_KV + (((it >> 1) % 3) * 2 + (it & 1)) * 2 * TILEB; const LAS unsigned char* Vb = Kb + TILEB;
            const bool far = 64 * c >= 1024 * i + 1167;
            if (far) tile<FAR, true, false>(Kb, Vb, qf, true, trh, 0, O, l, u[i], carry, r, hh);
            else tile<NEARC, true, false>(Kb, Vb, qf, true, trh, TR_D0 - t + 31 + 16 * (64 * i + 4 * hh), O, l, u[i], carry, r, hh);
            ATT_FLIP(it); ++it;
        }
    }
    unsigned long long mask;
    if (DBG_T == 61) tacc -= TSTAMP();
    {
        const float g0 = ((const float*)(ws + WS_GATES))[tok * 24 + h]; const float lt = l + xhalf(l); const float linv = lt > 0.f ? __builtin_amdgcn_rcpf(lt) : 0.f; const float sc = g0 * linv;
#pragma unroll
        for (int i = 0; i < 16; ++i) { out[0][i] += sc * O[0][i]; out[1][i] += sc * O[1][i]; O[0][i] = 0.f; O[1][i] = 0.f; }
        LAS float* impw = (LAS float*)(L + OFF_IMP + w * 2048);
#pragma unroll
        for (int i = 0; i < 4; ++i)
#pragma unroll
            for (int a = 0; a < 2; ++a)
#pragma unroll
                for (int q = 0; q < 4; ++q) {
                    float x = u[i][a][q] * linv;
                    x += __builtin_bit_cast(float, __builtin_amdgcn_update_dpp(0, __builtin_bit_cast(int, x), 0x128, 0xf, 0xf, false));
                    { const unsigned xb = __builtin_bit_cast(unsigned, x); auto pr = __builtin_amdgcn_permlane16_swap(xb, xb, false, false);
                      const unsigned p0 = pr[0], p1 = pr[1];
                      x = __builtin_bit_cast(float, p0) + __builtin_bit_cast(float, p1); }
                    const int j = 8 * (2 * i + a) + 2 * q + hh;
                    const bool forced = (j == 0) || (j == c) || (j == c - 1);
                    x = (j <= c) ? (forced ? 1e6f : x) : -1.f;
                    const unsigned bits = (__builtin_bit_cast(unsigned, x) & ~63u) | (unsigned)(63 - j);
                    impw[qi * 64 + j] = __builtin_bit_cast(float, bits);
                }
        LDS_WAIT(); asm volatile("" ::: "memory");
        const int q2 = lane >> 3, part = lane & 7;
        const LAS float* iq = impw + q2 * 64;
        float mine[8]; int cnt[8];
        { const f32x4 m0 = *(const LAS f32x4*)(iq + 8 * part), m1 = *(const LAS f32x4*)(iq + 8 * part + 4);
#pragma unroll
          for (int i = 0; i < 4; ++i) { mine[i] = m0[i]; mine[4 + i] = m1[i]; cnt[i] = 0; cnt[4 + i] = 0; } }
        unsigned byte = 0xffu;
        if (c >= 16) {
#pragma unroll 1
            for (int k = 0; 4 * k <= c; ++k) { const f32x4 v = *(const LAS f32x4*)(iq + 4 * k);
#pragma unroll
                for (int e = 0; e < 4; ++e)
#pragma unroll
                    for (int i = 0; i < 8; ++i) cnt[i] += (v[e] > mine[i]) ? 1 : 0; }
            byte = 0;
#pragma unroll
            for (int i = 0; i < 8; ++i) byte |= (cnt[i] < 16) ? (1u << i) : 0u;
        }
        LAS unsigned char* mw = (LAS unsigned char*)(L + OFF_MSK + w * 64);
        mw[q2 * 8 + part] = (unsigned char)byte;
        LDS_WAIT(); asm volatile("" ::: "memory");
        mask = *(const LAS unsigned long long*)(mw + qi * 8);
        l = 0.f;
    }
    if (DBG_T == 61) tacc += TSTAMP();
    unsigned long long uni = 0;
#pragma unroll
    for (int q = 0; q < 8; ++q) { uni |= (unsigned long long)(unsigned)__builtin_amdgcn_readlane((int)(unsigned)mask, q) | ((unsigned long long)(unsigned)__builtin_amdgcn_readlane((int)(unsigned)(mask >> 32), q) << 32); }
#pragma unroll 1
    for (int j = 0; j <= c; ++j) {
        ATT_NEXT(it);
        if ((uni >> j) & 1ull) {
            const LAS unsigned char* Kb = L + OFF_KV + (((it >> 1) % 3) * 2 + (it & 1)) * 2 * TILEB; const LAS unsigned char* Vb = Kb + TILEB;
            const bool rs = (mask >> j) & 1ull;
            if (j <= c - 3) tile<FAR, false, true>(Kb, Vb, qf, rs, trh, 0, O, l, dummy_u, carry, r, hh);
            else tile<NEARS, false, true>(Kb, Vb, qf, rs, trh, TR_D0 - t + 64 * j + 4 * hh, O, l, dummy_u, carry, r, hh);
        }
        ATT_FLIP(it); ++it;
    }
    {
        const float g1 = ((const float*)(ws + WS_GATES))[tok * 24 + 8 + h]; const float lt = l + xhalf(l); const float sc = lt > 0.f ? g1 * __builtin_amdgcn_rcpf(lt) : 0.f;
#pragma unroll
        for (int i = 0; i < 16; ++i) { out[0][i] += sc * O[0][i]; out[1][i] += sc * O[1][i]; O[0][i] = 0.f; O[1][i] = 0.f; }
        l = 0.f;
    }
#pragma unroll 1
    for (int j = w0; j <= c; ++j) {
        ATT_NEXT(it);
        const LAS unsigned char* Kb = L + OFF_KV + (((it >> 1) % 3) * 2 + (it & 1)) * 2 * TILEB; const LAS unsigned char* Vb = Kb + TILEB;
        if (j <= c - 3 && j != c - 8) tile<FAR, false, false>(Kb, Vb, qf, true, trh, 0, O, l, dummy_u, carry, r, hh);
        else if (j == c - 8) tile<NEARW, false, false>(Kb, Vb, qf, true, trh, TR_D0 - t + 64 * j + 4 * hh, O, l, dummy_u, carry, r, hh);
        else tile<NEARS, false, false>(Kb, Vb, qf, true, trh, TR_D0 - t + 64 * j + 4 * hh, O, l, dummy_u, carry, r, hh);
        ATT_FLIP(it); ++it;
    }
    if (DBG_T == 50 || DBG_T == 51) {
        f32x16 Ox[2] = {O[0], O[1]}; float lx = 0.f;
        if (DBG_T == 50 || w < 4) {
            tacc -= TSTAMP();
#pragma unroll 1
            for (int rep = 0; rep < 128; ++rep) tile<FAR, false, true>(L + OFF_KV, L + OFF_KV + TILEB, qf, (mask >> (rep & 63)) & 1ull, trh, 0, Ox, lx, dummy_u, carry, r, hh);
            tacc += TSTAMP();
        }
        asm volatile("" :: "v"(Ox[0]), "v"(Ox[1]), "v"(lx));
    }
    {
        const float g2 = ((const float*)(ws + WS_GATES))[tok * 24 + 16 + h]; const float lt = l + xhalf(l); const float sc = lt > 0.f ? g2 * __builtin_amdgcn_rcpf(lt) : 0.f;
#pragma unroll
        for (int i = 0; i < 16; ++i) { out[0][i] += sc * O[0][i]; out[1][i] += sc * O[1][i]; }
    }
    if (DBG_T == 62) tacc -= TSTAMP();
    bf16* yout = (bf16*)(ws + WS_Y) + tok * DM + 512 + h * 64;
#pragma unroll
    for (int dt = 0; dt < 2; ++dt)
#pragma unroll
        for (int q = 0; q < 4; ++q) { v2u wv; wv.x = cvtpk(out[dt][4 * q], out[dt][4 * q + 1]); wv.y = cvtpk(out[dt][4 * q + 2], out[dt][4 * q + 3]);
            *(v2u*)((bf16*)((unsigned char*)yout + ydst_off) + 32 * dt + 8 * q + 4 * hh) = wv; }
    __syncthreads();
    if (DBG_T == 62) tacc += TSTAMP();
#undef ATT_DMA
#undef ATT_WAITN
#undef ATT_NEXT
#undef ATT_FLIP
}

__global__ void __launch_bounds__(NWAVES * 64, 2) mk_fwd(Args args) {
    extern __shared__ __attribute__((aligned(16))) unsigned char lds[];
    Frame F;
    F.lds = (LAS unsigned char*)lds;
    F.MISC = (volatile LAS unsigned*)(F.lds + MISC_OFF);
    F.tid = threadIdx.x; F.lane = F.tid & 63; F.wave = __builtin_amdgcn_readfirstlane(F.tid >> 6);
    F.G = gridDim.x; { const int bx = blockIdx.x; F.vcu = (F.G % 8 == 0) ? (bx % 8) * (F.G / 8) + bx / 8 : bx; }
    unsigned char* ws = args.ws;
    F.ctl = (gu32*)(ws + WS_CTL);
    for (int u = F.tid; u < (LDS_BYTES - LDSCTL_OFF) / 4; u += NWAVES * 64) ((LAS unsigned*)(F.lds + LDSCTL_OFF))[u] = 0u;
    __syncthreads();
    if (F.tid < 128) { const int n = F.tid; int bkt = n;
        if (n >= 16) { const float nf = (float)n; int large = 16 + (int)(logf(nf / 16.f) / logf(8.f) * 16.f); bkt = large < 31 ? large : 31; }
        ((LAS unsigned char*)(F.lds + TB_OFF))[n] = (unsigned char)bkt; }
    __syncthreads();
    for (int e = F.tid; e < 8 * 129; e += NWAVES * 64) { const int hh_ = e / 129, x = e % 129; const int bk = x < 128 ? ((LAS unsigned char*)(F.lds + TB_OFF))[x] : 31;
        ((LAS float*)(F.lds + TBL_OFF))[hh_ * 132 + x] = args.in[17][hh_ * 32 + bk] * 1.4426950408889634f; }
    __syncthreads();
    XcdBarrier bar; bar.bar = (unsigned*)(F.ctl + CW_BAR) + args.li * XCD_BAR_WORDS; bar.x = 0; bar.st = nullptr;
    if (N_LAUNCHES != PER_PHASE) bar = xcd_barrier_post((unsigned*)(F.ctl + CW_BAR) + args.li * XCD_BAR_WORDS, F.MISC + 8);
#define GRID_BAR() do { if (N_LAUNCHES != PER_PHASE) xcd_barrier(bar); } while (0)
    const int lo = args.ph_lo, hi = args.ph_hi;
#define IN(k) (lo <= (k) && (k) < hi)
#define BOTH(k) (IN(k) && IN((k) + 1))
    bf16* XB = (bf16*)(ws + WS_XB); bf16* ACT = (bf16*)(ws + WS_ACT); bf16* Y = (bf16*)(ws + WS_Y);
    float* SS0 = (float*)(ws + WS_SS0); float* SS1 = (float*)(ws + WS_SS1); float* SS2 = (float*)(ws + WS_SS2); float* SS3 = (float*)(ws + WS_SS3);

    unsigned long long tacc = 0;
#define PT0(k) do { if (DBG_T == 10 + (k)) tacc -= TSTAMP(); if (DBG_T == 30 + (k)) tacc += TSTAMP(); } while (0)
#define PT1(k) do { if (DBG_T == 10 + (k)) tacc += TSTAMP(); if (DBG_T == 31 + (k)) tacc -= TSTAMP(); } while (0)
    if (IN(0)) { PT0(0); NREP(0) p0_prologue(F, args); PT1(0); if (BOTH(0)) GRID_BAR(); }
    if (IN(1)) {
        PT0(1);
        unsigned long long cyc0 = 0; if (DBG_T == 80 || DBG_T == 81) cyc0 = (DBG_T == 80) ? __builtin_amdgcn_s_memtime() : TSTAMP();
        pg8::Gemm g{XB, (const bf16*)(ws + WS_WGU1), MTOK, NGU, DM, DM, DM}; pg8::StaticOrder S; S.init(MTOK, NGU, F.G, (int)blockIdx.x);
        EpiSwiGLU E{SS0, ACT};
        NREP(1) pg8::gemm_phase<EpiSwiGLU, pg8::StaticOrder, true, true>(F.lds + RING_OFF, g, S, E);
        PT1(1);
        if (DBG_T == 80) tacc = (__builtin_amdgcn_s_memtime() - cyc0) / 100;
        if (DBG_T == 81) tacc = (TSTAMP() - cyc0);
        if (BOTH(1)) GRID_BAR();
    }
    if (IN(2)) {
        PT0(2);
        pg8::Gemm g{ACT, (const bf16*)(ws + WS_WD1), MTOK, DM, DFF, DFF, DFF}; pg8::StaticOrder S; S.init(MTOK, DM, F.G, (int)blockIdx.x);
        EpiResid E{args.in[0], nullptr, nullptr, XB, SS1, 0.5f};
        NREP(2) { S.fixed = (DBG_FIX && rep_ == 0) ? 1 : 0; pg8::gemm_phase<EpiResid, pg8::StaticOrder, true, true>(F.lds + RING_OFF, g, S, E); }
        PT1(2);
        if (BOTH(2)) GRID_BAR();
    }
    if (IN(3)) {
        PT0(3);
        pg8::Gemm g{XB, (const bf16*)(ws + WS_WIN), MTOK, NIN, DM, DM, DM}; pg8::StaticOrder S; S.init(MTOK, NIN, F.G, (int)blockIdx.x);
        EpiMix E{SS1, ws, args.in[10], args.in[11]};
        NREP(3) pg8::gemm_phase<EpiMix, pg8::StaticOrder, true, true>(F.lds + RING_OFF, g, S, E);
        PT1(3);
        if (BOTH(3)) GRID_BAR();
    }
    if (IN(4)) {
        PT0(4);
        for (int u = F.vcu; u < 256; u += F.G) cmp_unit(F, args, u);
        for (int u = F.vcu; u < 256; u += F.G) gmlp_unit(F, args, u);
        PT1(4);
        if (BOTH(4)) GRID_BAR();
    }
    if (IN(5)) {
        PT0(5);
        if (DBG_T == 3) tacc -= TSTAMP();
        if (DBG_T == 63) tacc -= TSTAMP();
        {
            LAS float* TR = (LAS float*)(F.lds + RING_OFF + att::OFF_TR); const LAS float* tbl = (const LAS float*)(F.lds + TBL_OFF);
            for (int e = F.tid; e < 8 * att::TR_N; e += NWAVES * 64) { const int hh_ = e / att::TR_N, k = e % att::TR_N, dist = att::TR_D0 - k;
                TR[e] = dist < 0 ? att::NEGBIG : tbl[hh_ * 132 + (dist < 128 ? dist : 128)] - tbl[hh_ * 132 + 128]; }
            __syncthreads();
        }
        if (DBG_T == 63) tacc += TSTAMP();
#if DBG_REP == 5
#pragma unroll 1
        for (int n = F.vcu; n < NBG * 64; n += F.G) { const int v = n & 255, i = n >> 8, x = v >> 5, lv = v & 31; attn_unit(F, args, 2 * x + (i & 1), i < 2 ? 63 - lv : lv, (size_t)(300 - 120) * MiB, tacc); }
#endif
        if (F.G % 8 == 0) {
            const int x = (int)blockIdx.x & 7; gu32* head = F.ctl + CW_Q + 64 * x;
#pragma unroll 1
            for (;;) {
                if (F.tid == 0) F.MISC[0] = __hip_atomic_fetch_add(head, 1u, RLX_AGENT);
                __syncthreads(); const int u = (int)F.MISC[0]; __syncthreads();
                if (u >= 128) break;
                attn_unit(F, args, 2 * x + (u & 1), 63 - (u >> 1), (size_t)0, tacc);
            }
        } else {
#pragma unroll 1
            for (int n = (int)blockIdx.x; n < NBG * 64; n += F.G) attn_unit(F, args, n & 15, 63 - (n >> 4), (size_t)0, tacc);
        }
        if (DBG_T == 3) tacc += TSTAMP();
        PT1(5);
        if (BOTH(5)) GRID_BAR();
    }
    if (IN(6)) {
        PT0(6);
        pg8::Gemm g{Y, (const bf16*)(ws + WS_WOUT), MTOK, DM, DM, DM, DM}; pg8::StaticOrder S; S.init(MTOK, DM, F.G, (int)blockIdx.x);
        EpiResid E{nullptr, XB, nullptr, XB, SS2, 1.0f};
        pg8::gemm_phase<EpiResid, pg8::StaticOrder, true, true>(F.lds + RING_OFF, g, S, E);
        PT1(6);
        if (BOTH(6)) GRID_BAR();
    }
    if (IN(7)) {
        PT0(7);
        pg8::Gemm g{XB, (const bf16*)(ws + WS_WGU2), MTOK, NGU, DM, DM, DM}; pg8::StaticOrder S; S.init(MTOK, NGU, F.G, (int)blockIdx.x);
        EpiSwiGLU E{SS2, ACT};
        pg8::gemm_phase<EpiSwiGLU, pg8::StaticOrder, true, true>(F.lds + RING_OFF, g, S, E);
        PT1(7);
        if (BOTH(7)) GRID_BAR();
    }
    if (IN(8)) {
        PT0(8);
        pg8::Gemm g{ACT, (const bf16*)(ws + WS_WD2), MTOK, DM, DFF, DFF, DFF}; pg8::StaticOrder S; S.init(MTOK, DM, F.G, (int)blockIdx.x);
        EpiResid E{nullptr, XB, nullptr, XB, SS3, 0.5f};
        pg8::gemm_phase<EpiResid, pg8::StaticOrder, true, true>(F.lds + RING_OFF, g, S, E);
        PT1(8);
        if (BOTH(8)) GRID_BAR();
    }
    if (IN(9)) {
        PT0(9);
        int tid9 = threadIdx.x; asm volatile("" : "+v"(tid9)); const int lane9 = tid9 & 63;
        const int gw = F.vcu * NWAVES + F.wave, NGW = F.G * NWAVES; const float* gf = args.in[23];
        for (int m = gw; m < MTOK; m += NGW) {
            float s = (lane9 < 16) ? SS3[(size_t)m * 16 + lane9] : 0.f; s = wave_sum(s);
            const float ri = rsq_acc(s, 1.f / DM);
            const GAS v2u* xr = (const GAS v2u*)(XB + (size_t)m * DM) + lane9; GAS f32x4* orow = (GAS f32x4*)(args.out + (size_t)m * DM) + lane9;
#pragma unroll
            for (int j = 0; j < 4; ++j) { const v2u rb = xr[64 * j]; const f32x4 gg = *((const f32x4*)gf + lane9 + 64 * j);
                f32x4 v = {__builtin_bit_cast(float, rb.x << 16), __builtin_bit_cast(float, rb.x & 0xffff0000u), __builtin_bit_cast(float, rb.y << 16), __builtin_bit_cast(float, rb.y & 0xffff0000u)};
                orow[64 * j] = v * ri * gg; }
        }
        PT1(9);
    }
    if (DBG_T != 0) { __syncthreads(); if (F.lane == 0) { F.MISC[16 + 2 * F.wave] = (unsigned)tacc; F.MISC[17 + 2 * F.wave] = (unsigned)(tacc >> 32); } __syncthreads();
        if (blockIdx.x == 0 && F.tid == 0) { const unsigned long long tw = (unsigned long long)F.MISC[16 + 2 * (DBG_TW)] | ((unsigned long long)F.MISC[17 + 2 * (DBG_TW)] << 32);
            const unsigned long long t0 = TSTAMP(); while (TSTAMP() - t0 < 16ull * tw) __builtin_amdgcn_s_sleep(8); } }
#undef IN
#undef BOTH
#undef GRID_BAR
}

extern "C" void kernel_launch(void* const* d_in, const int* in_sizes, int n_in, void* d_out, int out_size, void* d_ws, size_t ws_size, hipStream_t stream) {
    static int grid = 0;
    if (grid == 0) {
        if (n_in != 24 || in_sizes[0] != MTOK * DM || out_size != MTOK * DM || ws_size < WS_END) { fprintf(stderr, "kernel_launch: unexpected shapes (n_in %d, in0 %d, out %d, ws %zu)\n", n_in, n_in > 0 ? in_sizes[0] : -1, out_size, ws_size); grid = -1; return; }
        int dev = 0, cus = 0, per_cu = 0;
        if (hipGetDevice(&dev) != hipSuccess || hipDeviceGetAttribute(&cus, hipDeviceAttributeMultiprocessorCount, dev) != hipSuccess) { grid = -1; return; }
        if (hipFuncSetAttribute((const void*)mk_fwd, hipFuncAttributeMaxDynamicSharedMemorySize, LDS_BYTES) != hipSuccess) { fprintf(stderr, "kernel_launch: hipFuncSetAttribute failed\n"); grid = -1; return; }
        if (hipOccupancyMaxActiveBlocksPerMultiprocessor(&per_cu, (const void*)mk_fwd, NWAVES * 64, LDS_BYTES) != hipSuccess || per_cu < 1) { fprintf(stderr, "kernel_launch: occupancy query says %d blocks per CU\n", per_cu); (void)hipGetLastError(); grid = -1; return; }
        grid = cus;
    }
    if (grid < 0) return;
    (void)hipMemsetAsync((char*)d_ws + WS_CTL, 0, CTL_ZERO_BYTES, stream);
    Args a{};
    for (int i = 0; i < 24; ++i) a.in[i] = (const float*)d_in[i];
    a.out = (float*)d_out; a.ws = (unsigned char*)d_ws;
    if (N_LAUNCHES == 1) {
        a.ph_lo = 0; a.ph_hi = PER_PHASE; a.li = 0;
        void* kargs[] = {&a};
        hipError_t e = hipLaunchCooperativeKernel((const void*)mk_fwd, dim3(grid), dim3(NWAVES * 64), kargs, LDS_BYTES, stream);
        if (e != hipSuccess) fprintf(stderr, "kernel_launch: cooperative launch failed: %s (grid %d)\n", hipGetErrorString(e), grid);
    } else {
        for (int li = 0; li < PER_PHASE; ++li) { a.ph_lo = li; a.ph_hi = li + 1; a.li = 0;
            hipLaunchKernelGGL(mk_fwd, dim3(grid), dim3(NWAVES * 64), LDS_BYTES, stream, a); }
    }
}
```
